# Optimizing an MI355X kernel written in HIP

```python
import math
import jax
import jax.numpy as jnp
from jax import lax
import numpy as np

D_MODEL = 1024
BATCH = 8
SEQ = 4096
DEPTH = 2

CHUNK = 64
N_META = 16
Q_BLOCK = 128
EPS = 1e-6
NEG_INF = -1e30

HEAD_DIM = 64
SB_HEADS = 8
MLA_HEADS = 8
MLA_NOPE = 64
MLA_ROPE = 32
MLA_V = 64
MLA_Q_RANK = 256
MLA_KV_RANK = 128
MLA_THETA = 10000.0
DIFF_HEADS = 4
DIFF_DIM = 64
FOX_HEADS = 8
ROPE_THETA = 500000.0
ROT_DIM = HEAD_DIM // 4
D_FF = 2816
N_EXPERTS = 8
TOP_K = 2
D_FF_EXPERT = 3584

SB_W = SB_HEADS * HEAD_DIM
EVEN_IN = 3 * SB_W + MLA_Q_RANK + MLA_KV_RANK + MLA_ROPE
EVEN_MIX = SB_W + MLA_HEADS * MLA_V
DIFF_W = DIFF_HEADS * 2 * DIFF_DIM
FOX_W = FOX_HEADS * HEAD_DIM
ODD_IN = 3 * DIFF_W + 3 * FOX_W + FOX_HEADS
ODD_MIX = DIFF_W + FOX_W

kernel_name = "hybrid_sb_mla_diff_fox_moe_stream"


def rmsnorm(x, g):
    xf = x.astype(jnp.float32)
    y = xf * lax.rsqrt(jnp.mean(xf * xf, axis=-1, keepdims=True) + EPS)
    return (y * g.astype(jnp.float32)).astype(x.dtype)


def rope(x, pos, rot_dim, theta):
    half = rot_dim // 2
    inv = theta ** (-jnp.arange(half, dtype=jnp.float32) * 2.0 / rot_dim)
    ang = pos.astype(jnp.float32)[:, None] * inv[None, :]
    cos = jnp.cos(ang).astype(x.dtype)
    sin = jnp.sin(ang).astype(x.dtype)
    x1 = x[..., :half]
    x2 = x[..., half:rot_dim]
    return jnp.concatenate([x1 * cos - x2 * sin, x2 * cos + x1 * sin, x[..., rot_dim:]], axis=-1)


def chunk_id(p):
    return jnp.where(p < N_META, 0, 1 + (p - N_META) // CHUNK)


def _blocks(t, axis):
    s = t.shape
    t = t.reshape(s[:axis] + (s[axis] // Q_BLOCK, Q_BLOCK) + s[axis + 1:])
    return jnp.moveaxis(t, axis, 0)


def _unblocks(o):
    nb, b, h, qb, d = o.shape
    return o.transpose(1, 0, 3, 2, 4).reshape(b, nb * qb, h * d)


def _starts(length):
    return jnp.arange(length // Q_BLOCK, dtype=jnp.int32) * Q_BLOCK


def swiglu(x, wg, wu, wd):
    return (jax.nn.silu(x @ wg) * (x @ wu)) @ wd


def stick_breaking(q, k, v, pos):
    scale = q.shape[-1] ** -0.5

    def blk(args):
        s0, q_i = args
        tq = s0 + jnp.arange(Q_BLOCK, dtype=jnp.int32)
        z = jnp.einsum('bhqd,bhkd->bhqk', q_i, k).astype(jnp.float32) * scale
        strict = pos[None, :] < tq[:, None]
        log_1mb = jnp.where(strict, jax.nn.log_sigmoid(-z), 0.0)
        between = lax.cumsum(log_1mb, axis=3, reverse=True) - log_1mb
        w = jnp.where(strict, jnp.exp(jax.nn.log_sigmoid(z) + between), 0.0)
        return jnp.einsum('bhqk,bhkd->bhqd', w.astype(v.dtype), v)

    return _unblocks(lax.map(blk, (_starts(q.shape[2]), _blocks(q, 2))))


def mla(c_q, c_kv, k_r, pos, g_q, w_uq, g_kv, w_ukv):
    b, length, _ = c_q.shape
    q = (rmsnorm(c_q, g_q) @ w_uq).reshape(b, length, MLA_HEADS, MLA_NOPE + MLA_ROPE).transpose(0, 2, 1, 3)
    q_nope = q[..., :MLA_NOPE]
    q_rope = rope(q[..., MLA_NOPE:], pos, MLA_ROPE, MLA_THETA)
    kv = (rmsnorm(c_kv, g_kv) @ w_ukv).reshape(b, length, MLA_HEADS, MLA_NOPE + MLA_V).transpose(0, 2, 1, 3)
    k_nope = kv[..., :MLA_NOPE]
    v = kv[..., MLA_NOPE:]
    k_rope = rope(k_r, pos, MLA_ROPE, MLA_THETA)
    scale = (MLA_NOPE + MLA_ROPE) ** -0.5
    kchunk = chunk_id(pos)

    def blk(args):
        s0, qn_i, qr_i = args
        tq = s0 + jnp.arange(Q_BLOCK, dtype=jnp.int32)
        s = (jnp.einsum('bhqd,bhkd->bhqk', qn_i, k_nope)
             + jnp.einsum('bhqr,bkr->bhqk', qr_i, k_rope)).astype(jnp.float32) * scale
        mask = kchunk[None, :] <= chunk_id(tq)[:, None]
        p = jax.nn.softmax(jnp.where(mask, s, NEG_INF), axis=-1)
        return jnp.einsum('bhqk,bhkd->bhqd', p.astype(v.dtype), v)

    return _unblocks(lax.map(blk, (_starts(length), _blocks(q_nope, 2), _blocks(q_rope, 2))))


def diff_attention(q, k, v, pos, lam, lam_init, g_sub):
    b, h, _, length, d = q.shape
    q = rope(q, pos, ROT_DIM, ROPE_THETA)
    k = rope(k, pos, ROT_DIM, ROPE_THETA)
    scale = d ** -0.5
    kchunk = chunk_id(pos)

    def blk(args):
        s0, q_i = args
        tq = s0 + jnp.arange(Q_BLOCK, dtype=jnp.int32)
        s = jnp.einsum('bhmqd,bhmkd->bhmqk', q_i, k).astype(jnp.float32) * scale
        mask = kchunk[None, :] <= chunk_id(tq)[:, None]
        p = jax.nn.softmax(jnp.where(mask, s, NEG_INF), axis=-1)
        w = p[:, :, 0] - lam * p[:, :, 1]
        return jnp.einsum('bhqk,bhkd->bhqd', w.astype(v.dtype), v)

    o = _unblocks(lax.map(blk, (_starts(length), _blocks(q, 3))))
    o = rmsnorm(o.reshape(b, length, h, 2 * d), g_sub) * (1.0 - lam_init)
    return o.reshape(b, length, h * 2 * d)


def forgetting_attention(q, k, v, f_logit, pos):
    length = q.shape[2]
    c = jnp.cumsum(jax.nn.log_sigmoid(f_logit.astype(jnp.float32)), axis=1).transpose(0, 2, 1)
    scale = q.shape[-1] ** -0.5

    def blk(args):
        s0, q_i, cq_i = args
        tq = s0 + jnp.arange(Q_BLOCK, dtype=jnp.int32)
        s = jnp.einsum('bhqd,bhkd->bhqk', q_i, k).astype(jnp.float32) * scale
        s = s + (cq_i[..., :, None] - c[..., None, :])
        mask = pos[None, :] <= tq[:, None]
        p = jax.nn.softmax(jnp.where(mask, s, NEG_INF), axis=-1)
        return jnp.einsum('bhqk,bhkd->bhqd', p.astype(v.dtype), v)

    return _unblocks(lax.map(blk, (_starts(length), _blocks(q, 2), _blocks(c, 2))))


def even_mixer(hn, pos, w_in, g_q, w_uq, g_kv, w_ukv, w_out):
    b, length, _ = hn.shape
    proj = hn @ w_in
    sb = proj[..., :3 * SB_W].reshape(b, length, 3, SB_HEADS, HEAD_DIM).transpose(2, 0, 3, 1, 4)
    a_out = stick_breaking(sb[0], sb[1], sb[2], pos)
    off = 3 * SB_W
    c_q = proj[..., off:off + MLA_Q_RANK]
    off += MLA_Q_RANK
    c_kv = proj[..., off:off + MLA_KV_RANK]
    off += MLA_KV_RANK
    k_r = proj[..., off:off + MLA_ROPE]
    b_out = mla(c_q, c_kv, k_r, pos, g_q, w_uq, g_kv, w_ukv)
    return jnp.concatenate([a_out, b_out], axis=-1) @ w_out


def odd_mixer(hn, pos, w_in, b_forget, lq1, lk1, lq2, lk2, g_sub, w_out, lam_init):
    b, length, _ = hn.shape
    proj = hn @ w_in
    dq = proj[..., :DIFF_W].reshape(b, length, DIFF_HEADS, 2, DIFF_DIM).transpose(0, 2, 3, 1, 4)
    dk = proj[..., DIFF_W:2 * DIFF_W].reshape(b, length, DIFF_HEADS, 2, DIFF_DIM).transpose(0, 2, 3, 1, 4)
    dv = proj[..., 2 * DIFF_W:3 * DIFF_W].reshape(b, length, DIFF_HEADS, 2 * DIFF_DIM).transpose(0, 2, 1, 3)
    lam = (jnp.exp(jnp.sum(lq1.astype(jnp.float32) * lk1.astype(jnp.float32)))
           - jnp.exp(jnp.sum(lq2.astype(jnp.float32) * lk2.astype(jnp.float32))) + lam_init)
    c_out = diff_attention(dq, dk, dv, pos, lam, lam_init, g_sub)
    off = 3 * DIFF_W
    fx = proj[..., off:off + 3 * FOX_W].reshape(b, length, 3, FOX_HEADS, HEAD_DIM).transpose(2, 0, 3, 1, 4)
    f_logit = proj[..., off + 3 * FOX_W:] + b_forget
    d_out = forgetting_attention(fx[0], fx[1], fx[2], f_logit, pos)
    return jnp.concatenate([c_out, d_out], axis=-1) @ w_out


def moe_ffn(hn, w_router, wg, wu, wd):
    logits = (hn @ w_router).astype(jnp.float32)
    top_vals, top_idx = lax.top_k(logits, TOP_K)
    gates = jax.nn.softmax(top_vals, axis=-1)
    dense_gate = jnp.einsum('blk,blke->ble', gates, jax.nn.one_hot(top_idx, N_EXPERTS, dtype=jnp.float32))
    y = jnp.zeros_like(hn)
    for e in range(N_EXPERTS):
        y = y + dense_gate[..., e:e + 1].astype(hn.dtype) * swiglu(hn, wg[e], wu[e], wd[e])
    return y


def setup_inputs(seed: int = 0) -> dict:
    key = jax.random.key(seed)
    ks = iter(jax.random.split(key, 48))
    ne = (DEPTH + 1) // 2
    no = DEPTH // 2

    def nrm(shape, scale):
        return jax.random.normal(next(ks), shape, jnp.float32) * scale

    def gain(shape):
        return 1.0 + nrm(shape, 0.02)

    d = D_MODEL
    b_forget = jnp.linspace(1.0, 6.0, FOX_HEADS, dtype=jnp.float32)[None, :] + nrm((no, FOX_HEADS), 0.1)
    return {
        "x": nrm((BATCH, SEQ, d), 1.0),
        "meta_tokens": nrm((N_META, d), 1.0),
        "ln_mix_e": gain((ne, d)),
        "w_in_e": nrm((ne, d, EVEN_IN), d ** -0.5),
        "ln_mla_q_e": gain((ne, MLA_Q_RANK)),
        "w_mla_uq_e": nrm((ne, MLA_Q_RANK, MLA_HEADS * (MLA_NOPE + MLA_ROPE)), MLA_Q_RANK ** -0.5),
        "ln_mla_kv_e": gain((ne, MLA_KV_RANK)),
        "w_mla_ukv_e": nrm((ne, MLA_KV_RANK, MLA_HEADS * (MLA_NOPE + MLA_V)), MLA_KV_RANK ** -0.5),
        "w_out_e": nrm((ne, EVEN_MIX, d), EVEN_MIX ** -0.5),
        "ln_ffn_e": gain((ne, d)),
        "w_ffn_gate_e": nrm((ne, d, D_FF), d ** -0.5),
        "w_ffn_up_e": nrm((ne, d, D_FF), d ** -0.5),
        "w_ffn_down_e": nrm((ne, D_FF, d), D_FF ** -0.5),
        "ln_mix_o": gain((no, d)),
        "w_in_o": nrm((no, d, ODD_IN), d ** -0.5),
        "b_forget_o": b_forget,
        "diff_lq1_o": nrm((no, DIFF_DIM), 0.1),
        "diff_lk1_o": nrm((no, DIFF_DIM), 0.1),
        "diff_lq2_o": nrm((no, DIFF_DIM), 0.1),
        "diff_lk2_o": nrm((no, DIFF_DIM), 0.1),
        "diff_subln_o": gain((no, 2 * DIFF_DIM)),
        "w_out_o": nrm((no, ODD_MIX, d), ODD_MIX ** -0.5),
        "ln_ffn_o": gain((no, d)),
        "w_router_o": nrm((no, d, N_EXPERTS), d ** -0.5),
        "w_moe_gate_o": nrm((no, N_EXPERTS, d, D_FF_EXPERT), d ** -0.5),
        "w_moe_up_o": nrm((no, N_EXPERTS, d, D_FF_EXPERT), d ** -0.5),
        "w_moe_down_o": nrm((no, N_EXPERTS, D_FF_EXPERT, d), D_FF_EXPERT ** -0.5),
        "ln_final": gain((d,)),
    }


def reference(x, meta_tokens, ln_mix_e, w_in_e, ln_mla_q_e, w_mla_uq_e, ln_mla_kv_e, w_mla_ukv_e,
              w_out_e, ln_ffn_e, w_ffn_gate_e, w_ffn_up_e, w_ffn_down_e, ln_mix_o, w_in_o, b_forget_o,
              diff_lq1_o, diff_lk1_o, diff_lq2_o, diff_lk2_o, diff_subln_o, w_out_o, ln_ffn_o,
              w_router_o, w_moe_gate_o, w_moe_up_o, w_moe_down_o, ln_final):
    b, seq, d = x.shape
    total = seq + N_META
    length = ((total + Q_BLOCK - 1) // Q_BLOCK) * Q_BLOCK
    meta = jnp.broadcast_to(meta_tokens.astype(x.dtype)[None], (b, N_META, d))
    h = jnp.concatenate([meta, x, jnp.zeros((b, length - total, d), x.dtype)], axis=1)
    pos = jnp.arange(length, dtype=jnp.int32)

    for i in range(DEPTH):
        j = i // 2
        if i % 2 == 0:
            hn = rmsnorm(h, ln_mix_e[j])
            h = h + even_mixer(hn, pos, w_in_e[j], ln_mla_q_e[j], w_mla_uq_e[j], ln_mla_kv_e[j],
                               w_mla_ukv_e[j], w_out_e[j])
            h = h + swiglu(rmsnorm(h, ln_ffn_e[j]), w_ffn_gate_e[j], w_ffn_up_e[j], w_ffn_down_e[j])
        else:
            lam_init = 0.8 - 0.6 * math.exp(-0.3 * i)
            hn = rmsnorm(h, ln_mix_o[j])
            h = h + odd_mixer(hn, pos, w_in_o[j], b_forget_o[j], diff_lq1_o[j], diff_lk1_o[j],
                              diff_lq2_o[j], diff_lk2_o[j], diff_subln_o[j], w_out_o[j], lam_init)
            h = h + moe_ffn(rmsnorm(h, ln_ffn_o[j]), w_router_o[j], w_moe_gate_o[j],
                            w_moe_up_o[j], w_moe_down_o[j])

    h = rmsnorm(h, ln_final)
    return h[:, N_META:N_META + seq]
```

```cpp
#include <hip/hip_runtime.h>
#include <cstdio>
#include <cstdint>
#include <cmath>
namespace pg8 {
#define PG8_LAS __attribute__((address_space(3)))
typedef unsigned short bf16_t;
typedef short bf16x8 __attribute__((ext_vector_type(8)));
typedef float f32x4 __attribute__((ext_vector_type(4)));
typedef unsigned u32x4 __attribute__((ext_vector_type(4)));
constexpr int BM = 256, BK = 64, HALF = 128, HTB = HALF * BK * 2  , STAGE_BYTES = 8 * HTB, NXCD = 8, WGM = 8;

__host__ __device__ __forceinline__ int lds_byte(int r, int c) { const int st = (r >> 4) * 2 + (c >> 5), rr = r & 15, cc = c & 31, ob = rr * 64 + cc * 2; return st * 1024 + (ob ^ (((ob >> 9) & 1) << 5)); }
__host__ __device__ __forceinline__ void stage_rc(int b, int& R, int& C) { const int st = b / 1024, sb = b % 1024, swz = sb ^ (((sb >> 9) & 1) << 5); R = (st >> 1) * 16 + swz / 64; C = (st & 1) * 32 + (swz % 64) / 2; }
__host__ __device__ __forceinline__ int perm32(int rho) { const int n = rho >> 4, i = rho & 15; return 8 * (i >> 2) + 4 * n + (i & 3); }

struct Unit { int pm, pn; };
struct Gemm { const bf16_t* A; const bf16_t* Bt; int M, N, K; };

struct StaticOrder {
    int nM, nN, nwg, G, c;
    __host__ __device__ void init(int M, int N, int G_, int c_) { nM = M / BM; nN = N / BM; nwg = nM * nN; G = G_; c = c_; }
    __host__ __device__ bool next(int i, Unit& u) const {
        const long L = (long)i * G + c; if (L >= nwg) return false;
        int wgid = (int)L; { const int q = nwg / NXCD, r = nwg % NXCD, xcd = wgid % NXCD, off = wgid / NXCD; wgid = (xcd < r ? xcd * (q + 1) : r * (q + 1) + (xcd - r) * q) + off; }
        const int nig = WGM * nN, gid = wgid / nig, fm = gid * WGM, gsz = (nM - fm) < WGM ? (nM - fm) : WGM;
        u.pm = fm + ((wgid % nig) % gsz); u.pn = (wgid % nig) / gsz; return true;
    }
    __device__ __forceinline__ void a_ready(const Unit&) const {}
    __device__ __forceinline__ void done(const Unit&) const {}
};

__device__ __forceinline__ unsigned cvt_pk_bf16(float lo, float hi) { unsigned r; asm volatile("v_cvt_pk_bf16_f32 %0, %1, %2" : "=v"(r) : "v"(lo), "v"(hi)); return r; }
typedef float f32x2 __attribute__((ext_vector_type(2)));
template <class Epi, class Sched, bool ALIGN_EPI = false, bool SP2 = false>
__device__ __forceinline__ void gemm_phase(PG8_LAS unsigned char* lds, const Gemm g, const Sched& S, const Epi& E) {
    const int tid = threadIdx.x, wid = __builtin_amdgcn_readfirstlane(tid >> 6), lane = tid & 63, wr = wid >> 2, wc = wid & 3, fr = lane & 15, fq = lane >> 4;
    const int K = g.K, nt = K / BK;
    unsigned voffA[2], voffB[2];
#pragma unroll
    for (int i = 0; i < 2; ++i) { int R, C; stage_rc(tid * 16 + i * 8192, R, C); const int Rb = Epi::PERM ? ((R & ~31) + perm32(R & 31)) : R;
        voffA[i] = (unsigned)(R * K + C) * 2u; voffB[i] = (unsigned)(Rb * K + C) * 2u; }
    const size_t kstep = (size_t)(BK * 2);
    const size_t hstep = (size_t)HALF * K * 2;
    const size_t tstep = 2 * hstep;
    const unsigned ldsw = (unsigned)wid * 1024u;
    const int aoff = lds_byte(wr * 64 + fr, fq * 8), boff = lds_byte(wc * 32 + fr, fq * 8);
#define PG8_SA(b, h) (((b) * 2 + (h)) * HTB)
#define PG8_SB(b, h) ((4 + (b) * 2 + (h)) * HTB)
#define PG8_STAGE(bufoff, gbase, voff) do { _Pragma("unroll") for (int _i = 0; _i < 2; ++_i) \
        __builtin_amdgcn_global_load_lds((const unsigned*)((const char*)(gbase) + (voff)[_i]), (PG8_LAS unsigned*)(lds + (bufoff) + ldsw + _i * 8192), 16, 0, 0); } while (0)
#define PG8_LDA(dst, b, h) do { _Pragma("unroll") for (int m = 0; m < 4; ++m) _Pragma("unroll") for (int k = 0; k < 2; ++k) dst[m][k] = *(const PG8_LAS bf16x8*)(lds + PG8_SA(b, h) + aoff + m * 2048 + k * 1024); } while (0)
#define PG8_LDB(dst, b, h) do { _Pragma("unroll") for (int n = 0; n < 2; ++n) _Pragma("unroll") for (int k = 0; k < 2; ++k) dst[n][k] = *(const PG8_LAS bf16x8*)(lds + PG8_SB(b, h) + boff + n * 2048 + k * 1024); } while (0)
#define PG8_MMA(ai, bj, At, Bt) do { __builtin_amdgcn_s_setprio(1); _Pragma("unroll") for (int m = 0; m < 4; ++m) _Pragma("unroll") for (int n = 0; n < 2; ++n) _Pragma("unroll") for (int k = 0; k < 2; ++k) \
        acc[ai][bj][m][n] = __builtin_amdgcn_mfma_f32_16x16x32_bf16(Bt[n][k], At[m][k], acc[ai][bj][m][n], 0, 0, 0); __builtin_amdgcn_s_setprio(0); } while (0)
#define PG8_WAIT_V(n) asm volatile("s_waitcnt vmcnt(" #n ")" ::: "memory")
#define PG8_WAIT_L(n) asm volatile("s_waitcnt lgkmcnt(" #n ")" ::: "memory")
#define PG8_BAR __builtin_amdgcn_s_barrier()
#define PG8_SCHED __builtin_amdgcn_sched_barrier(0)
    Unit cur, nxt; int ui = 0;
    if (!S.next(0, cur)) return;
    f32x4 acc[2][2][4][2];
#pragma unroll
    for (int a = 0; a < 2; ++a)
#pragma unroll
        for (int b = 0; b < 2; ++b)
#pragma unroll
            for (int m = 0; m < 4; ++m)
#pragma unroll
                for (int n = 0; n < 2; ++n) acc[a][b][m][n] = (f32x4){0.f, 0.f, 0.f, 0.f};
    bf16x8 At[4][2], B0[2][2], B1[2][2];
    const char* cA = (const char*)g.A + (size_t)cur.pm * tstep; const char* cB = (const char*)g.Bt + (size_t)cur.pn * tstep;
    S.a_ready(cur);
    if constexpr (SP2) {
        PG8_STAGE(PG8_SB(0, 0), cB, voffB); PG8_STAGE(PG8_SB(0, 1), cB + hstep, voffB); PG8_STAGE(PG8_SA(0, 0), cA, voffA); PG8_STAGE(PG8_SA(0, 1), cA + hstep, voffA);
        if (wr == 1) PG8_BAR;
        PG8_WAIT_V(2); PG8_BAR;
        PG8_STAGE(PG8_SB(1, 0), cB + kstep, voffB); PG8_STAGE(PG8_SA(1, 0), cA + kstep, voffA); PG8_STAGE(PG8_SB(1, 1), cB + hstep + kstep, voffB);
        PG8_WAIT_V(6); PG8_BAR;
    } else {
        PG8_STAGE(PG8_SB(0, 0), cB, voffB); PG8_STAGE(PG8_SA(0, 0), cA, voffA); PG8_STAGE(PG8_SB(0, 1), cB + hstep, voffB); PG8_STAGE(PG8_SA(0, 1), cA + hstep, voffA);
        if (wr == 1) PG8_BAR;
        PG8_WAIT_V(4); PG8_BAR;
        PG8_STAGE(PG8_SB(1, 0), cB + kstep, voffB); PG8_STAGE(PG8_SA(1, 0), cA + kstep, voffA); PG8_STAGE(PG8_SB(1, 1), cB + hstep + kstep, voffB);
        PG8_WAIT_V(6); PG8_BAR;
    }
    for (;;) {
        const bool has_next = S.next(ui + 1, nxt);
        const char* nA = has_next ? (const char*)g.A + (size_t)nxt.pm * tstep : cA; const char* nB = has_next ? (const char*)g.Bt + (size_t)nxt.pn * tstep : cB;
        for (int t = 0; t < nt; t += 2) {
            const bool last = (t == nt - 2);
            const char* a1 = cA + (size_t)(t + 1) * kstep;
            const char* a2 = last ? nA : cA + (size_t)(t + 2) * kstep; const char* b2 = last ? nB : cB + (size_t)(t + 2) * kstep;
            const char* a3 = a2 + kstep; const char* b3 = b2 + kstep;
            if (last && has_next) S.a_ready(nxt);
            if constexpr (SP2) {
            PG8_LDB(B0, 0, 0); PG8_LDB(B1, 0, 1); PG8_SCHED; PG8_LDA(At, 0, 0); PG8_STAGE(PG8_SA(1, 1), a1 + hstep, voffA);
            PG8_WAIT_V(8); PG8_WAIT_L(0); PG8_BAR; PG8_MMA(0, 0, At, B0); PG8_MMA(0, 1, At, B1); PG8_BAR; PG8_SCHED;
            PG8_LDA(At, 0, 1); PG8_STAGE(PG8_SB(0, 0), b2, voffB); PG8_STAGE(PG8_SB(0, 1), b2 + hstep, voffB); PG8_STAGE(PG8_SA(0, 0), a2, voffA);
            PG8_WAIT_V(8); PG8_WAIT_L(0); PG8_BAR; PG8_MMA(1, 0, At, B0); PG8_MMA(1, 1, At, B1); PG8_BAR; PG8_SCHED;
            PG8_LDB(B0, 1, 0); PG8_LDB(B1, 1, 1); PG8_SCHED; PG8_LDA(At, 1, 0); PG8_STAGE(PG8_SA(0, 1), a2 + hstep, voffA);
            PG8_WAIT_V(8); PG8_WAIT_L(0); PG8_BAR; PG8_MMA(0, 0, At, B0); PG8_MMA(0, 1, At, B1); PG8_BAR; PG8_SCHED;
            PG8_LDA(At, 1, 1); PG8_STAGE(PG8_SB(1, 0), b3, voffB); PG8_STAGE(PG8_SB(1, 1), b3 + hstep, voffB); PG8_STAGE(PG8_SA(1, 0), a3, voffA);
            PG8_WAIT_V(8); PG8_WAIT_L(0); PG8_BAR; PG8_MMA(1, 0, At, B0); PG8_MMA(1, 1, At, B1); PG8_BAR; PG8_SCHED;
            } else {
            PG8_LDB(B0, 0, 0); PG8_SCHED; PG8_LDA(At, 0, 0); PG8_STAGE(PG8_SA(1, 1), a1 + hstep, voffA);
            PG8_WAIT_L(8); PG8_BAR; PG8_WAIT_L(0); PG8_MMA(0, 0, At, B0); PG8_BAR; PG8_SCHED;
            PG8_LDB(B1, 0, 1); PG8_STAGE(PG8_SB(0, 0), b2, voffB);
            PG8_BAR; PG8_WAIT_L(0); PG8_MMA(0, 1, At, B1); PG8_BAR;
            PG8_LDA(At, 0, 1); PG8_STAGE(PG8_SA(0, 0), a2, voffA);
            PG8_BAR; PG8_WAIT_L(0); PG8_MMA(1, 0, At, B0); PG8_BAR; PG8_SCHED;
            PG8_STAGE(PG8_SB(0, 1), b2 + hstep, voffB);
            PG8_WAIT_V(6); PG8_BAR; PG8_MMA(1, 1, At, B1); PG8_BAR;
            PG8_LDB(B0, 1, 0); PG8_SCHED; PG8_LDA(At, 1, 0); PG8_STAGE(PG8_SA(0, 1), a2 + hstep, voffA);
            PG8_WAIT_L(8); PG8_BAR; PG8_WAIT_L(0); PG8_MMA(0, 0, At, B0); PG8_BAR; PG8_SCHED;
            PG8_LDB(B1, 1, 1); PG8_STAGE(PG8_SB(1, 0), b3, voffB);
            PG8_BAR; PG8_WAIT_L(0); PG8_MMA(0, 1, At, B1); PG8_BAR;
            PG8_LDA(At, 1, 1); PG8_STAGE(PG8_SA(1, 0), a3, voffA);
            PG8_BAR; PG8_WAIT_L(0); PG8_MMA(1, 0, At, B0); PG8_BAR; PG8_SCHED;
            PG8_STAGE(PG8_SB(1, 1), b3 + hstep, voffB);
            PG8_WAIT_V(6); PG8_BAR; PG8_MMA(1, 1, At, B1); PG8_BAR;
            }
        }
        if constexpr (ALIGN_EPI) { if (wr == 0) PG8_BAR; }
        if constexpr (!Epi::AFTER_DRAIN) { E(acc, cur, wr, wc, fr, fq); S.done(cur); }
        if (!has_next) break;
#pragma unroll
        for (int a = 0; a < 2; ++a)
#pragma unroll
            for (int b = 0; b < 2; ++b)
#pragma unroll
                for (int m = 0; m < 4; ++m)
#pragma unroll
                    for (int n = 0; n < 2; ++n) acc[a][b][m][n] = (f32x4){0.f, 0.f, 0.f, 0.f};
        cur = nxt; cA = nA; cB = nB; ++ui;
        if constexpr (ALIGN_EPI) { if (wr == 1) PG8_BAR; }
    }
    PG8_WAIT_V(0);
    if constexpr (!ALIGN_EPI) { if (wr == 0) PG8_BAR; }
    PG8_BAR;
    if constexpr (Epi::AFTER_DRAIN) { E.fused(acc, cur, wr, wc, fr, fq, lds, wid, lane); S.done(cur); }
#undef PG8_SA
#undef PG8_SB
#undef PG8_STAGE
#undef PG8_LDA
#undef PG8_LDB
#undef PG8_MMA
#undef PG8_WAIT_V
#undef PG8_WAIT_L
#undef PG8_BAR
#undef PG8_SCHED
}
typedef float f32x2e __attribute__((ext_vector_type(2))); typedef __bf16 bf16x2e __attribute__((ext_vector_type(2)));
__device__ __forceinline__ unsigned pk2bf(float lo, float hi) { f32x2e v = {lo, hi}; bf16x2e b = __builtin_convertvector(v, bf16x2e); return __builtin_bit_cast(unsigned, b); }
__device__ __forceinline__ u32x4 pack8(const f32x4 v0, const f32x4 v1) { u32x4 w; w.x = pk2bf(v0[0], v0[1]); w.y = pk2bf(v0[2], v0[3]); w.z = pk2bf(v1[0], v1[1]); w.w = pk2bf(v1[2], v1[3]); return w; }
__device__ __forceinline__ int row_pos(int row) { return row < 32768 ? 16 + (row & 4095) : row - 32768; }

struct EpiIn0 { static constexpr bool PERM = true, AFTER_DRAIN = false;
    bf16_t* sb; bf16_t* cm;
    __device__ __forceinline__ void operator()(const f32x4 (&acc)[2][2][4][2], const Unit& u, int wr, int wc, int fr, int fq) const {
        const int row0 = u.pm * BM + wr * 64 + fr;
        bf16_t* base; int ldc, colt;
        if (u.pn < 6) { base = sb; ldc = 1536; colt = u.pn * 256; } else { base = cm; ldc = 512; colt = (u.pn - 6) * 256; }
        const int col0 = colt + wc * 32 + 8 * fq;
#pragma unroll
        for (int ai = 0; ai < 2; ++ai)
#pragma unroll
            for (int m = 0; m < 4; ++m) { bf16_t* rowp = base + (size_t)(row0 + ai * HALF + m * 16) * ldc + col0;
#pragma unroll
                for (int bj = 0; bj < 2; ++bj) *(u32x4*)(rowp + bj * HALF) = pack8(acc[ai][bj][m][0], acc[ai][bj][m][1]); }
    }
};
struct EpiPlain { static constexpr bool PERM = true, AFTER_DRAIN = false;
    bf16_t* O; int ldc; int nmod;
    __device__ __forceinline__ void operator()(const f32x4 (&acc)[2][2][4][2], const Unit& u, int wr, int wc, int fr, int fq) const {
        const int row0 = u.pm * BM + wr * 64 + fr; const int col0 = (u.pn % nmod) * 256 + wc * 32 + 8 * fq;
#pragma unroll
        for (int ai = 0; ai < 2; ++ai)
#pragma unroll
            for (int m = 0; m < 4; ++m) { bf16_t* rowp = O + (size_t)(row0 + ai * HALF + m * 16) * ldc + col0;
#pragma unroll
                for (int bj = 0; bj < 2; ++bj) *(u32x4*)(rowp + bj * HALF) = pack8(acc[ai][bj][m][0], acc[ai][bj][m][1]); }
    }
};
struct EpiUqkv { static constexpr bool PERM = true, AFTER_DRAIN = false;
    bf16_t *q, *kc, *vc; const float* cosM; const float* sinM;
    __device__ __forceinline__ void operator()(const f32x4 (&acc)[2][2][4][2], const Unit& u, int wr, int wc, int fr, int fq) const {
        const int row0 = u.pm * BM + wr * 64 + fr;
#pragma unroll
        for (int bj = 0; bj < 2; ++bj) {
            if (u.pn < 3) {
                const int gidx = 8 * u.pn + 4 * bj + wc; const bool rope = (gidx % 3) == 2; const int col = 32 * gidx + 8 * fq;
#pragma unroll
                for (int ai = 0; ai < 2; ++ai)
#pragma unroll
                    for (int m = 0; m < 4; ++m) { const int row = row0 + ai * HALF + m * 16; f32x4 v0 = acc[ai][bj][m][0], v1 = acc[ai][bj][m][1];
                        if (rope) { const int pos = row_pos(row); const float* cp = cosM + pos * 16 + 8 * (fq & 1); const float* sp = sinM + pos * 16 + 8 * (fq & 1);
                            const f32x4 c0 = *(const f32x4*)cp, c1 = *(const f32x4*)(cp + 4), s0 = *(const f32x4*)sp, s1 = *(const f32x4*)(sp + 4);
#pragma unroll
                            for (int e = 0; e < 4; ++e) { const float o0 = __shfl_xor(v0[e], 32), o1 = __shfl_xor(v1[e], 32);
                                v0[e] = (fq < 2) ? v0[e] * c0[e] - o0 * s0[e] : v0[e] * c0[e] + o0 * s0[e];
                                v1[e] = (fq < 2) ? v1[e] * c1[e] - o1 * s1[e] : v1[e] * c1[e] + o1 * s1[e]; } }
                        *(u32x4*)(q + (size_t)row * 768 + col) = pack8(v0, v1); }
            } else {
                const int head = 2 * (u.pn - 3) + bj, within = 32 * wc + 8 * fq; bf16_t* base; int ldc, c;
                if (wc < 2) { base = kc; ldc = 768; c = head * 96 + within; } else { base = vc; ldc = 512; c = head * 64 + within - 64; }
#pragma unroll
                for (int ai = 0; ai < 2; ++ai)
#pragma unroll
                    for (int m = 0; m < 4; ++m) { const int row = row0 + ai * HALF + m * 16; *(u32x4*)(base + (size_t)row * ldc + c) = pack8(acc[ai][bj][m][0], acc[ai][bj][m][1]); }
            }
        }
    }
};
struct EpiIn1 { static constexpr bool PERM = true, AFTER_DRAIN = false;
    bf16_t* o; const float* cosD; const float* sinD;
    __device__ __forceinline__ void operator()(const f32x4 (&acc)[2][2][4][2], const Unit& u, int wr, int wc, int fr, int fq) const {
        const int row0 = u.pm * BM + wr * 64 + fr; const int col0 = u.pn * 256 + wc * 32 + 8 * fq; const bool ropew = (u.pn < 4) && ((wc & 1) == 0);
#pragma unroll
        for (int ai = 0; ai < 2; ++ai)
#pragma unroll
            for (int m = 0; m < 4; ++m) { const int row = row0 + ai * HALF + m * 16; bf16_t* rowp = o + (size_t)row * 3072 + col0;
                f32x4 c0 = {1.f, 1.f, 1.f, 1.f}, c1 = c0, s0 = {0.f, 0.f, 0.f, 0.f}, s1 = s0;
                if (ropew) { const int pos = row_pos(row); c0 = *(const f32x4*)(cosD + pos * 8); c1 = *(const f32x4*)(cosD + pos * 8 + 4); s0 = *(const f32x4*)(sinD + pos * 8); s1 = *(const f32x4*)(sinD + pos * 8 + 4); }
#pragma unroll
                for (int bj = 0; bj < 2; ++bj) { f32x4 v0 = acc[ai][bj][m][0], v1 = acc[ai][bj][m][1];
                    if (ropew) {
#pragma unroll
                        for (int e = 0; e < 4; ++e) { const float o0 = __shfl_xor(v0[e], 16), o1 = __shfl_xor(v1[e], 16);
                            if (fq == 0) { v0[e] = v0[e] * c0[e] - o0 * s0[e]; v1[e] = v1[e] * c1[e] - o1 * s1[e]; }
                            else if (fq == 1) { v0[e] = v0[e] * c0[e] + o0 * s0[e]; v1[e] = v1[e] * c1[e] + o1 * s1[e]; } } }
                    *(u32x4*)(rowp + bj * HALF) = pack8(v0, v1); } }
    }
};
struct EpiResid { static constexpr bool PERM = false, AFTER_DRAIN = false;
    const float* rr; float* dr; const float* rm; float* dm;
    __device__ __forceinline__ void operator()(const f32x4 (&acc)[2][2][4][2], const Unit& u, int wr, int wc, int fr, int fq) const {
        const int col0 = u.pn * BM + wc * 32 + 4 * fq;
#pragma unroll
        for (int ai = 0; ai < 2; ++ai)
#pragma unroll
            for (int m = 0; m < 4; ++m) { const int rl = ai * HALF + wr * 64 + m * 16 + fr; const float* rp; float* dp; bool ok = true;
                if (u.pm < 128) { const size_t off = (size_t)(u.pm * BM + rl) * 1024; rp = rr + off; dp = dr + off; } else { ok = rl < 16; rp = rm + (size_t)rl * 1024; dp = dm + (size_t)rl * 1024; }
                if (ok) {
#pragma unroll
                    for (int bj = 0; bj < 2; ++bj)
#pragma unroll
                        for (int n = 0; n < 2; ++n) { const int c = col0 + bj * HALF + n * 16; *(f32x4*)(dp + c) = *(const f32x4*)(rp + c) + acc[ai][bj][m][n]; } } }
    }
};
struct EpiSwiglu { static constexpr bool PERM = true, AFTER_DRAIN = false;
    bf16_t* O; int ldc; int nmod;
    __device__ __forceinline__ void operator()(const f32x4 (&acc)[2][2][4][2], const Unit& u, int wr, int wc, int fr, int fq) const {
        const int row0 = u.pm * BM + wr * 64 + fr; const int col0 = (u.pn % nmod) * 128 + wc * 32 + 8 * fq;
#pragma unroll
        for (int ai = 0; ai < 2; ++ai)
#pragma unroll
            for (int m = 0; m < 4; ++m) { f32x4 a[2];
#pragma unroll
                for (int n = 0; n < 2; ++n)
#pragma unroll
                    for (int e = 0; e < 4; ++e) { const float g = acc[ai][0][m][n][e], up = acc[ai][1][m][n][e]; a[n][e] = g * __builtin_amdgcn_rcpf(1.f + __builtin_amdgcn_exp2f(-1.4426950408889634f * g)) * up; }
                *(u32x4*)(O + (size_t)(row0 + ai * HALF + m * 16) * ldc + col0) = pack8(a[0], a[1]); }
    }
};
struct MoeOrder { StaticOrder so; int tb1, tb2, tb3, tb4, tb5, tb6, tb7; int t0; int nper;
    __device__ __forceinline__ bool next(int i, Unit& u) const { if (!so.next(i, u)) return false; const int T = t0 + u.pm;
        const int e = (T >= tb1) + (T >= tb2) + (T >= tb3) + (T >= tb4) + (T >= tb5) + (T >= tb6) + (T >= tb7); u.pn += e * nper; return true; }
    __device__ __forceinline__ void a_ready(const Unit&) const {}
    __device__ __forceinline__ void done(const Unit&) const {}
};
}
#define GAS __attribute__((address_space(1)))
#define LAS __attribute__((address_space(3)))
typedef unsigned short bf16;
typedef unsigned v4u __attribute__((ext_vector_type(4)));
typedef float f32x4 __attribute__((ext_vector_type(4)));
typedef short bf16x8 __attribute__((ext_vector_type(8)));
typedef GAS unsigned gu32;
typedef GAS unsigned long long gu64;
#define RLX_AGENT __ATOMIC_RELAXED, __HIP_MEMORY_SCOPE_AGENT
#define LDS_WAIT() asm volatile("s_waitcnt lgkmcnt(0)" ::: "memory")
#define VM_WAIT() asm volatile("s_waitcnt vmcnt(0)" ::: "memory")
__device__ __forceinline__ unsigned long long rt() { return __builtin_amdgcn_s_memrealtime(); }
__device__ __forceinline__ unsigned f2bf(float f) { unsigned u = __builtin_bit_cast(unsigned, f); return (u + 0x7fffu + ((u >> 16) & 1u)) >> 16; }
__device__ __forceinline__ unsigned pk2(float lo, float hi) { return f2bf(lo) | (f2bf(hi) << 16); }

#define XB_TMO      128
#define XB_XCNT(j)  (256  + 64 * (j))
#define XB_XSUB(j)  (1280 + 64 * (j))
#define XB_XGEN(j)  (2304 + 64 * (j))
#define XB_TOP      3328
#define XB_TOPGEN   3392
#define XCD_BAR_WORDS 3456
#define XB_SPIN_CAP (1u << 18)

__device__ __forceinline__ unsigned xb_ld(unsigned* p)              { return __hip_atomic_load(p, __ATOMIC_RELAXED, __HIP_MEMORY_SCOPE_AGENT); }
__device__ __forceinline__ unsigned xb_add(unsigned* p, unsigned v) { return __hip_atomic_fetch_add(p, v, __ATOMIC_RELAXED, __HIP_MEMORY_SCOPE_AGENT); }
__device__ __forceinline__ unsigned xb_xcc_id() { return (unsigned)__builtin_amdgcn_s_getreg((3 << 11) | 20) & 0xFu; }
#define XB_SPIN(cond, bar) do { unsigned _sp = 0; while (cond) { __builtin_amdgcn_s_sleep(1); \
    if ((++_sp & 255u) == 0u) { if (xb_ld(&(bar)[XB_TMO])) break; if (_sp > XB_SPIN_CAP) { atomicAdd(&(bar)[XB_TMO], 1u); break; } } } } while (0)

struct XcdBarrier {
    unsigned* bar; unsigned x;
    volatile LAS unsigned* st;
};

__device__ __forceinline__ XcdBarrier xcd_barrier_post(unsigned* bar, volatile LAS unsigned* st) {
    XcdBarrier b; b.bar = bar; b.x = xb_xcc_id(); b.st = st;
    if (threadIdx.x == 0) (void)xb_add(&bar[XB_XCNT(b.x)], 1u);
    return b;
}
__device__ __forceinline__ void xcd_barrier_complete(unsigned* bar, unsigned x, unsigned& nloc, unsigned& nx) {
    const unsigned G = gridDim.x * gridDim.y * gridDim.z;
    unsigned sum, cnt, mine, sp = 0u;
    for (;;) {
        sum = 0u; cnt = 0u; mine = 0u;
#pragma unroll
        for (unsigned j = 0; j < 16; ++j) { const unsigned c = xb_ld(&bar[XB_XCNT(j)]); sum += c; cnt += (c > 0u) ? 1u : 0u; mine = (j == x) ? c : mine; }
        if (sum == G) break;
        __builtin_amdgcn_s_sleep(1);
        if ((++sp & 255u) == 0u) { if (xb_ld(&bar[XB_TMO])) break; if (sp > XB_SPIN_CAP) { atomicAdd(&bar[XB_TMO], 1u); break; } }
    }
    nloc = mine > 0u ? mine : 1u; nx = cnt > 0u ? cnt : 1u;
}

__device__ __forceinline__ void xcd_barrier(const XcdBarrier& b) {
    asm volatile("s_waitcnt vmcnt(0)" ::: "memory");
    __syncthreads();
    if (threadIdx.x == 0) {
        unsigned* bar = b.bar;
        __builtin_amdgcn_s_waitcnt(0);
        unsigned nloc = b.st[0], nx = b.st[1];
        if (nloc == 0u) { xcd_barrier_complete(bar, b.x, nloc, nx); b.st[0] = nloc; b.st[1] = nx; }
        const unsigned old = xb_add(&bar[XB_XSUB(b.x)], 1u);
        const unsigned gen = old / nloc;
        if (old + 1u == (gen + 1u) * nloc) {
            __builtin_amdgcn_fence(__ATOMIC_RELEASE, "agent");
            asm volatile("s_waitcnt vmcnt(0)" ::: "memory");
            const unsigned og = xb_add(&bar[XB_TOP], 1u);
            const unsigned tg = og / nx;
            if (og + 1u == (tg + 1u) * nx) xb_add(&bar[XB_TOPGEN], 1u);
            else XB_SPIN(xb_ld(&bar[XB_TOPGEN]) == tg, bar);
            __builtin_amdgcn_fence(__ATOMIC_ACQUIRE, "agent");
            xb_add(&bar[XB_XGEN(b.x)], 1u);
            asm volatile("s_waitcnt vmcnt(0)" ::: "memory");
        } else {
            XB_SPIN(xb_ld(&bar[XB_XGEN(b.x)]) == gen, bar);
            __builtin_amdgcn_fence(__ATOMIC_ACQUIRE, "agent");
            asm volatile("s_waitcnt vmcnt(0)" ::: "memory");
        }
    }
    __syncthreads();
}
typedef unsigned short bf16;
typedef unsigned v4u __attribute__((ext_vector_type(4)));
typedef unsigned v2u __attribute__((ext_vector_type(2)));
typedef float f32x4 __attribute__((ext_vector_type(4)));
typedef float f32x16 __attribute__((ext_vector_type(16)));
typedef short bf16x8 __attribute__((ext_vector_type(8)));
typedef short s16x4 __attribute__((ext_vector_type(4)));
using pg8::pk2bf;
using pg8::row_pos;

constexpr int NWAVES = 8;
constexpr int DM = 1024, NB = 8, SEQ = 4096, NTOK = NB * SEQ  , MR = NTOK + 256  , META0 = NTOK;
constexpr float EPS = 1e-6f, LOG2E = 1.4426950408889634f, LN2 = 0.6931471805599453f;
constexpr int DFF = 2816, DFE = 3584, NEXP = 8;
constexpr int MOE_ROWS = 264 * 256, MOE_CT = 88  , MOE_NCHUNK = 3;

constexpr size_t MiB = 1u << 20;
constexpr size_t WS_CTL = 0, CTL_ZERO_BYTES = 1 * MiB;
constexpr int CW_BAR = 4096;
constexpr int CW_CNT = 16384;
constexpr size_t WS_COSM = 1 * MiB, WS_SINM = WS_COSM + 4352 * 16 * 4, WS_COSD = WS_SINM + 4352 * 16 * 4, WS_SIND = WS_COSD + 4352 * 8 * 4;
constexpr size_t WS_HMETA = 2 * MiB;
constexpr size_t WS_CFOX = 3 * MiB;
constexpr size_t WS_CMETA = 4 * MiB;
constexpr size_t WS_LF = 4 * MiB + 65536;
constexpr size_t WS_TOK = 6 * MiB;
constexpr size_t WS_WIN0 = 8 * MiB, WS_WUQKV = 12 * MiB, WS_WOUT0 = 13 * MiB + 512 * 1024, WS_WGU0 = 15 * MiB + 512 * 1024, WS_WDN0 = 26 * MiB + 512 * 1024, WS_WIN1 = 32 * MiB, WS_WOUT1 = 38 * MiB;
constexpr size_t WS_HN = 40 * MiB;
constexpr size_t WS_R = 104 * MiB + 512 * 1024;
constexpr size_t WS_SB = WS_R, WS_CM = WS_SB + (size_t)MR * 1536 * 2, WS_CQKV = WS_CM + (size_t)MR * 512 * 2;
constexpr size_t WS_ACT0 = WS_R, WS_PROJ1 = WS_R;
constexpr size_t WS_XS = 226 * MiB;
constexpr size_t WS_ACTC = 40 * MiB;
constexpr size_t WS_WM = 358 * MiB, WS_WMG = WS_WM, WS_WMD = WS_WM + (size_t)NEXP * 7168 * 1024 * 2;
constexpr size_t WS_QMLA = WS_WM, WS_KC = 407 * MiB, WS_VC = 456 * MiB;
constexpr size_t WS_END = 526 * MiB;
static_assert(WS_CQKV + (size_t)MR * 384 * 2 <= WS_WM && WS_ACT0 + (size_t)MR * DFF * 2 <= WS_WM && WS_PROJ1 + (size_t)MR * 3072 * 2 <= WS_WM, "R region");
static_assert(WS_XS + (size_t)MOE_ROWS * 1024 * 2 <= WS_WM && WS_ACTC + (size_t)MOE_CT * 256 * DFE * 2 <= WS_XS, "MoE buffers");
static_assert(WS_QMLA + (size_t)MR * 768 * 2 <= WS_KC && WS_KC + (size_t)MR * 768 * 2 <= WS_VC && WS_VC + (size_t)MR * 512 * 2 <= WS_END && WS_WMD + (size_t)NEXP * 1024 * DFE * 2 <= WS_END, "tail region");
static_assert(WS_WOUT1 + 2 * MiB <= WS_HN && WS_HN + (size_t)MR * 1024 * 2 <= WS_R && WS_SIND + 4352 * 8 * 4 <= WS_HMETA && WS_LF + (size_t)MR * 32 <= WS_TOK, "head region");

constexpr int RING_OFF = 0, RING_BYTES = 131072, LDSCTL_OFF = RING_BYTES, MISC_OFF = LDSCTL_OFF + 320, LDS_BYTES = 147456;

__device__ __forceinline__ float wave_sum(float v) {
#pragma unroll
    for (int o = 1; o < 64; o <<= 1) v += __shfl_xor(v, o);
    return v;
}
__device__ __forceinline__ float bf2f(unsigned b) { return __uint_as_float(b << 16); }
#define LDS_WAIT() asm volatile("s_waitcnt lgkmcnt(0)" ::: "memory")

struct Frame {
    LAS unsigned char* lds;
    unsigned* ctl;
    unsigned char* ws;
    int tid, lane, wave, vcu, G;
};

__device__ __forceinline__ void tr_item(const float* W, int ldw, int ncol0, bf16* WT, int Kd, int koff, int drow0, float scale, LAS float* scr, int k0, int n0, int lane) {
#pragma unroll 8
    for (int i = 0; i < 32; ++i) { const int kk = 2 * i + (lane >> 5); scr[kk * 33 + (lane & 31)] = W[(size_t)(k0 + kk) * ldw + ncol0 + n0 + (lane & 31)] * scale; }
    LDS_WAIT(); asm volatile("" ::: "memory");
    const int c = lane & 7;
#pragma unroll
    for (int j = 0; j < 4; ++j) { const int n = (lane >> 3) + 8 * j; const LAS float* s = scr + (8 * c) * 33 + n;
        v4u o; o.x = pk2bf(s[0 * 33], s[1 * 33]); o.y = pk2bf(s[2 * 33], s[3 * 33]); o.z = pk2bf(s[4 * 33], s[5 * 33]); o.w = pk2bf(s[6 * 33], s[7 * 33]);
        *(GAS v4u*)(WT + (size_t)(drow0 + n) * Kd + koff + k0 + 8 * c) = o; }
    LDS_WAIT(); asm volatile("" ::: "memory");
}
template <int MAP> __device__ __forceinline__ void tr_job(int it, const float* W, int K, int ldw, int c0, int nc, bf16* WT, int Kd, int koff, int rbase, float scale, LAS float* scr, int lane) {
    const int nblk = nc / 32, kb = it / nblk, nb = it % nblk, n0 = nb * 32;
    const int drow0 = MAP == 0 ? rbase + n0 : rbase + 256 * (n0 / 128) + (n0 % 128);
    tr_item(W, ldw, c0, WT, Kd, koff, drow0, scale, scr, kb * 64, n0, lane);
}

__device__ __forceinline__ void rms_row(const float* xrow, const float* g, bf16* orow, int lane, f32x4 (&v)[4]) {
    const GAS f32x4* xr = (const GAS f32x4*)xrow + lane; float s = 0.f;
#pragma unroll
    for (int j = 0; j < 4; ++j) { v[j] = xr[64 * j]; s += (v[j].x * v[j].x + v[j].y * v[j].y) + (v[j].z * v[j].z + v[j].w * v[j].w); }
    const float rstd = 1.f / sqrtf(wave_sum(s) * (1.f / 1024.f) + EPS);
    GAS v2u* o8 = (GAS v2u*)orow + lane;
#pragma unroll
    for (int j = 0; j < 4; ++j) { const f32x4 gg = *((const GAS f32x4*)g + lane + 64 * j); v[j] = v[j] * rstd * gg; v2u w; w.x = pk2bf(v[j].x, v[j].y); w.y = pk2bf(v[j].z, v[j].w); o8[64 * j] = w; }
}
__device__ __forceinline__ void zero_row(bf16* orow, int lane) {
    GAS v2u* o8 = (GAS v2u*)orow + lane; const v2u z = {0u, 0u};
#pragma unroll
    for (int j = 0; j < 4; ++j) o8[64 * j] = z;
}
__device__ __forceinline__ void row_dot8(const f32x4 (&v)[4], const LAS float* wl, int lane, float (&d)[8]) {
#pragma unroll
    for (int e = 0; e < 8; ++e) d[e] = 0.f;
#pragma unroll
    for (int j = 0; j < 4; ++j)
#pragma unroll
        for (int t = 0; t < 4; ++t) { const int c = 4 * lane + 256 * j + t; const LAS f32x4* wp = (const LAS f32x4*)(wl + c * 8); const f32x4 w0 = wp[0], w1 = wp[1]; const float x = v[j][t];
            d[0] += x * w0.x; d[1] += x * w0.y; d[2] += x * w0.z; d[3] += x * w0.w; d[4] += x * w1.x; d[5] += x * w1.y; d[6] += x * w1.z; d[7] += x * w1.w; }
#pragma unroll
    for (int e = 0; e < 8; ++e) d[e] = wave_sum(d[e]);
}

#define MFMA32(a, b, c) __builtin_amdgcn_mfma_f32_32x32x16_bf16((a), (b), (c), 0, 0, 0)
typedef short v4i16_t __attribute__((ext_vector_type(4)));
__device__ __forceinline__ s16x4 vtr(const LAS unsigned char* p) { return __builtin_bit_cast(s16x4, __builtin_amdgcn_ds_read_tr16_b64_v4i16((LAS v4i16_t*)p)); }
__device__ __forceinline__ int crow(int r, int hi) { return (r & 3) + 8 * (r >> 2) + 4 * hi; }
__device__ __forceinline__ int chunk_of(int p) { return p < 16 ? 0 : 1 + ((p - 16) >> 6); }
constexpr int KPOS_BAD = 1 << 29;

template <int DQK, int DV, bool CAUSAL, bool BIAS>
__device__ __forceinline__ void attn_pass(LAS unsigned char* lds, const bf16* qrow, const bf16* Kg, int kpitch, const bf16* Vg, int vpitch, int kv_row0, int NT,
                                          int qp, int qp_lo, int qp_hi, const float* cb_real, const float* cb_meta, f32x16 (&o)[DV / 32], float& linv) {
    constexpr int KP = DQK * 2 + 16, VP = DV * 2 + 64, KPC = DQK / 8, VPC = DV / 8, NK = (64 * KPC + 511) / 512, NV = (64 * VPC) / 512, NS = DQK / 16, ND = DV / 32;
    constexpr int OFF_V = 64 * KP, OFF_B = OFF_V + 64 * VP, STG = OFF_B + 256;
    const int tid = threadIdx.x, lane = tid & 63, r = lane & 31, h = lane >> 5;
    bf16x8 qf[NS];
#pragma unroll
    for (int st = 0; st < NS; ++st) qf[st] = *(const GAS bf16x8*)(qrow + st * 16 + h * 8);
#pragma unroll
    for (int dt = 0; dt < ND; ++dt)
#pragma unroll
        for (int i = 0; i < 16; ++i) o[dt][i] = 0.f;
    float m_run = -INFINITY, l_run = 0.f;
    const int cq = chunk_of(qp), cq_lo = chunk_of(qp_lo), cq_hi = chunk_of(qp_hi);
    v4u kreg[NK], vreg[NV]; float breg = 0.f;
#define ATT_LOAD(t) do { const int rowb_ = (t) == 0 ? META0 : kv_row0 + 64 * ((t) - 1); \
        _Pragma("unroll") for (int j_ = 0; j_ < NK; ++j_) { const int p_ = tid + 512 * j_; if (p_ < 64 * KPC) { const int key_ = p_ / KPC, pc_ = p_ % KPC; kreg[j_] = *(const GAS v4u*)(Kg + (size_t)(rowb_ + key_) * kpitch + pc_ * 8); } } \
        _Pragma("unroll") for (int j_ = 0; j_ < NV; ++j_) { const int p_ = tid + 512 * j_; const int key_ = p_ / VPC, pc_ = p_ % VPC; vreg[j_] = *(const GAS v4u*)(Vg + (size_t)(rowb_ + key_) * vpitch + pc_ * 8); } \
        if (BIAS) { if (tid < 64) breg = (t) == 0 ? (tid < 16 ? cb_meta[tid] : 0.f) : cb_real[64 * ((t) - 1) + tid]; } } while (0)
#define ATT_STORE(buf) do { LAS unsigned char* sb_ = lds + (buf) * STG; \
        _Pragma("unroll") for (int j_ = 0; j_ < NK; ++j_) { const int p_ = tid + 512 * j_; if (p_ < 64 * KPC) { const int key_ = p_ / KPC, pc_ = p_ % KPC; *(LAS v4u*)(sb_ + key_ * KP + pc_ * 16) = kreg[j_]; } } \
        _Pragma("unroll") for (int j_ = 0; j_ < NV; ++j_) { const int p_ = tid + 512 * j_; const int key_ = p_ / VPC, pc_ = p_ % VPC; *(LAS v4u*)(sb_ + OFF_V + key_ * VP + pc_ * 16) = vreg[j_]; } \
        if (BIAS) { if (tid < 64) *(LAS float*)(sb_ + OFF_B + tid * 4) = -breg; } } while (0)
    ATT_LOAD(0); ATT_STORE(0); __syncthreads();
    const int q4 = (lane & 15) >> 2, p4 = lane & 3, blk = (lane >> 4) & 1;
    for (int t = 0; t <= NT; ++t) {
        if (t < NT) ATT_LOAD(t + 1);
        int status;
        if (t == 0) status = 2;
        else if (CAUSAL) { const int kp_lo = 16 + 64 * (t - 1), kp_hi = kp_lo + 63; status = kp_lo > qp_hi ? 0 : (kp_hi <= qp_lo ? 1 : 2); }
        else { status = t > cq_hi ? 0 : (t <= cq_lo ? 1 : 2); }
        if (status != 0) {
            const LAS unsigned char* sb = lds + (t & 1) * STG;
            f32x16 s0, s1;
#pragma unroll
            for (int i = 0; i < 16; ++i) { s0[i] = 0.f; s1[i] = 0.f; }
#pragma unroll
            for (int st = 0; st < NS; ++st) { const bf16x8 k0 = *(const LAS bf16x8*)(sb + r * KP + st * 32 + h * 16), k1 = *(const LAS bf16x8*)(sb + (32 + r) * KP + st * 32 + h * 16);
                s0 = MFMA32(k0, qf[st], s0); s1 = MFMA32(k1, qf[st], s1); }
            if (BIAS) {
#pragma unroll
                for (int g = 0; g < 4; ++g) { const f32x4 b0 = *(const LAS f32x4*)(sb + OFF_B + (8 * g + 4 * h) * 4), b1 = *(const LAS f32x4*)(sb + OFF_B + (32 + 8 * g + 4 * h) * 4);
#pragma unroll
                    for (int e = 0; e < 4; ++e) { s0[4 * g + e] += b0[e]; s1[4 * g + e] += b1[e]; } }
            }
            if (status == 2) {
#pragma unroll
                for (int i = 0; i < 16; ++i) { const int k0 = crow(i, h), k1 = 32 + k0;
                    const int kp0 = t == 0 ? (k0 < 16 ? k0 : KPOS_BAD) : 16 + 64 * (t - 1) + k0, kp1 = t == 0 ? KPOS_BAD : 16 + 64 * (t - 1) + k1;
                    const bool v0 = CAUSAL ? (kp0 <= qp) : (kp0 < KPOS_BAD && chunk_of(kp0) <= cq), v1 = CAUSAL ? (kp1 <= qp) : (kp1 < KPOS_BAD && chunk_of(kp1) <= cq);
                    if (!v0) s0[i] = -INFINITY; if (!v1) s1[i] = -INFINITY; }
            }
            float mx = fmaxf(s0[0], s1[0]);
#pragma unroll
            for (int i = 1; i < 16; ++i) mx = fmaxf(mx, fmaxf(s0[i], s1[i]));
            mx = fmaxf(mx, __shfl_xor(mx, 32));
            const float m_new = fmaxf(m_run, mx), mref = (m_new == -INFINITY) ? 0.f : m_new;
            const float alpha = __builtin_amdgcn_exp2f(m_run - mref);
            float psum = 0.f;
#pragma unroll
            for (int i = 0; i < 16; ++i) { s0[i] = __builtin_amdgcn_exp2f(s0[i] - mref); s1[i] = __builtin_amdgcn_exp2f(s1[i] - mref); psum += s0[i] + s1[i]; }
            l_run = l_run * alpha + psum; m_run = m_new;
#pragma unroll
            for (int dt = 0; dt < ND; ++dt)
#pragma unroll
                for (int i = 0; i < 16; ++i) o[dt][i] *= alpha;
            bf16x8 pf[4];
            { v4u w;
              w.x = pk2bf(s0[0], s0[1]); w.y = pk2bf(s0[2], s0[3]); w.z = pk2bf(s0[4], s0[5]); w.w = pk2bf(s0[6], s0[7]); pf[0] = __builtin_bit_cast(bf16x8, w);
              w.x = pk2bf(s0[8], s0[9]); w.y = pk2bf(s0[10], s0[11]); w.z = pk2bf(s0[12], s0[13]); w.w = pk2bf(s0[14], s0[15]); pf[1] = __builtin_bit_cast(bf16x8, w);
              w.x = pk2bf(s1[0], s1[1]); w.y = pk2bf(s1[2], s1[3]); w.z = pk2bf(s1[4], s1[5]); w.w = pk2bf(s1[6], s1[7]); pf[2] = __builtin_bit_cast(bf16x8, w);
              w.x = pk2bf(s1[8], s1[9]); w.y = pk2bf(s1[10], s1[11]); w.z = pk2bf(s1[12], s1[13]); w.w = pk2bf(s1[14], s1[15]); pf[3] = __builtin_bit_cast(bf16x8, w); }
#pragma unroll
            for (int dt = 0; dt < ND; ++dt)
#pragma unroll
                for (int ks = 0; ks < 4; ++ks) { const LAS unsigned char* vp = sb + OFF_V + (16 * ks + 4 * h + q4) * VP + (32 * dt + 16 * blk) * 2 + 8 * p4;
                    const s16x4 lo = vtr(vp), hi = vtr(vp + 8 * VP);
                    const bf16x8 vf = {lo[0], lo[1], lo[2], lo[3], hi[0], hi[1], hi[2], hi[3]};
                    o[dt] = MFMA32(vf, pf[ks], o[dt]); if (ND > 2 && ks == 3) __builtin_amdgcn_sched_barrier(0); }
        }
        if (t < NT) ATT_STORE((t + 1) & 1);
        __syncthreads();
    }
#undef ATT_LOAD
#undef ATT_STORE
    const float lt = l_run + __shfl_xor(l_run, 32);
    linv = 1.f / lt;
}

template <int DV> __device__ __forceinline__ void attn_store(const f32x16 (&o)[DV / 32], float linv, bf16* out_row, int h, bool ok) {
    if (!ok) return;
#pragma unroll
    for (int dt = 0; dt < DV / 32; ++dt)
#pragma unroll
        for (int g = 0; g < 4; ++g) { v2u w; w.x = pk2bf(o[dt][4 * g] * linv, o[dt][4 * g + 1] * linv); w.y = pk2bf(o[dt][4 * g + 2] * linv, o[dt][4 * g + 3] * linv);
            *(GAS v2u*)(out_row + 32 * dt + 8 * g + 4 * h) = w; }
}

__device__ __forceinline__ void sb_unit(LAS unsigned char* wl  , const bf16* Qg, const bf16* Kg, const bf16* Vg  ,
                                        int q_row0, int qp0, int ktop  , int kv_row0, bf16* out  , int nvalid_q, int lane) {
    constexpr int VP = 192, PITCH = 1536;
    const int r = lane & 31, h = lane >> 5, q4 = (lane & 15) >> 2, p4 = lane & 3, blk = (lane >> 4) & 1;
    const int qp = qp0 + r;
    bf16x8 qf[4];
#pragma unroll
    for (int st = 0; st < 4; ++st) qf[st] = *(const GAS bf16x8*)(Qg + (size_t)(q_row0 + r) * PITCH + st * 16 + h * 8);
    f32x16 o[2];
#pragma unroll
    for (int dt = 0; dt < 2; ++dt)
#pragma unroll
        for (int i = 0; i < 16; ++i) o[dt][i] = 0.f;
    float carry = 0.f;
    for (int tile = ktop; tile >= -1; --tile) {
        const int rowb = tile >= 0 ? kv_row0 + 32 * tile : META0, kp0 = tile >= 0 ? 16 + 32 * tile : 0, nval = tile >= 0 ? 32 : 16;
        bf16x8 kf[4];
#pragma unroll
        for (int st = 0; st < 4; ++st) kf[st] = *(const GAS bf16x8*)(Kg + (size_t)(rowb + r) * PITCH + st * 16 + h * 8);
        v4u vr[4];
#pragma unroll
        for (int j = 0; j < 4; ++j) { const int p = lane + 64 * j; vr[j] = *(const GAS v4u*)(Vg + (size_t)(rowb + (p >> 3)) * PITCH + (p & 7) * 8); }
        asm volatile("" ::: "memory");
#pragma unroll
        for (int j = 0; j < 4; ++j) { const int p = lane + 64 * j; *(LAS v4u*)(wl + (p >> 3) * VP + (p & 7) * 16) = vr[j]; }
        f32x16 z;
#pragma unroll
        for (int i = 0; i < 16; ++i) z[i] = 0.f;
#pragma unroll
        for (int st = 0; st < 4; ++st) z = MFMA32(kf[st], qf[st], z);
        float L[16]; bool vis[16];
#pragma unroll
        for (int i = 0; i < 16; ++i) { const int k = crow(i, h); vis[i] = (k < nval) && (kp0 + k < qp);
            const float a = fabsf(z[i]); const float sp = fmaxf(z[i], 0.f) + LN2 * __builtin_amdgcn_logf(1.f + __builtin_amdgcn_exp2f(-a * LOG2E));
            L[i] = vis[i] ? -sp : 0.f; }
        float G[4], PG[4];
#pragma unroll
        for (int g = 0; g < 4; ++g) { G[g] = (L[4 * g] + L[4 * g + 1]) + (L[4 * g + 2] + L[4 * g + 3]); PG[g] = __shfl_xor(G[g], 32); }
        float after[4]; float acc = 0.f;
#pragma unroll
        for (int g = 3; g >= 0; --g) { after[g] = acc + (h == 0 ? PG[g] : 0.f); acc += G[g] + PG[g]; }
        float w[16];
#pragma unroll
        for (int g = 0; g < 4; ++g) { float suf = 0.f;
#pragma unroll
            for (int e = 3; e >= 0; --e) { const int i = 4 * g + e; const float btw = carry + after[g] + suf; suf += L[i];
                w[i] = vis[i] ? __builtin_amdgcn_exp2f((z[i] + L[i] + btw) * LOG2E) : 0.f; } }
        carry += acc;
        bf16x8 pf[2];
        { v4u x;
          x.x = pk2bf(w[0], w[1]); x.y = pk2bf(w[2], w[3]); x.z = pk2bf(w[4], w[5]); x.w = pk2bf(w[6], w[7]); pf[0] = __builtin_bit_cast(bf16x8, x);
          x.x = pk2bf(w[8], w[9]); x.y = pk2bf(w[10], w[11]); x.z = pk2bf(w[12], w[13]); x.w = pk2bf(w[14], w[15]); pf[1] = __builtin_bit_cast(bf16x8, x); }
        LDS_WAIT(); asm volatile("" ::: "memory");
#pragma unroll
        for (int dt = 0; dt < 2; ++dt)
#pragma unroll
            for (int ks = 0; ks < 2; ++ks) { const LAS unsigned char* vp = wl + (16 * ks + 4 * h + q4) * VP + (32 * dt + 16 * blk) * 2 + 8 * p4;
                const s16x4 lo = vtr(vp), hi = vtr(vp + 8 * VP);
                const bf16x8 vf = {lo[0], lo[1], lo[2], lo[3], hi[0], hi[1], hi[2], hi[3]};
                o[dt] = MFMA32(vf, pf[ks], o[dt]); }
        LDS_WAIT(); asm volatile("" ::: "memory");
        if (__all(carry < -104.f)) break;
    }
    attn_store<64>(o, 1.f, out + (size_t)(q_row0 + r) * 1024, h, r < nvalid_q);
}
struct Args { const float* in[28]; float* out; unsigned char* ws; int lo, hi, clo, chi; };
enum { I_X = 0, I_META, I_LN_MIX_E, I_W_IN_E, I_LN_Q, I_W_UQ, I_LN_KV, I_W_UKV, I_W_OUT_E, I_LN_FFN_E, I_W_GATE_E, I_W_UP_E, I_W_DOWN_E, I_LN_MIX_O, I_W_IN_O, I_B_FORGET,
       I_LQ1, I_LK1, I_LQ2, I_LK2, I_SUBLN, I_W_OUT_O, I_LN_FFN_O, I_W_ROUTER, I_W_MGATE, I_W_MUP, I_W_MDOWN, I_LN_FINAL };
constexpr int N_PHASES = 18;
constexpr float LAM_INIT = 0.35550906759096927f;
constexpr float SC_MLA = 0.10206207261596575f * LOG2E, SC_64 = 0.125f * LOG2E;

typedef const __attribute__((address_space(4))) Args* CArgs;
__device__ __forceinline__ CArgs fresh_args() { CArgs p = (CArgs)__builtin_amdgcn_kernarg_segment_ptr(); asm volatile("" : "+s"(p)); return p; }
#define PH() CArgs A = fresh_args(); unsigned char* const ws = A->ws; int tid = threadIdx.x; asm volatile("" : "+v"(tid)); \
    const int lane = tid & 63, wave = __builtin_amdgcn_readfirstlane(tid >> 6); const int G = gridDim.x, bx = blockIdx.x, vcu = (G % 8 == 0) ? (bx % 8) * (G / 8) + bx / 8 : bx; \
    const int gw = vcu * NWAVES + wave, NGW = G * NWAVES, gt = vcu * 512 + tid, NGT = G * 512; LAS unsigned char* const lds = (LAS unsigned char*)lds_raw; \
    bf16* const HN = (bf16*)(ws + WS_HN); float* const HMETA = (float*)(ws + WS_HMETA); \
    (void)lane; (void)wave; (void)gw; (void)NGW; (void)gt; (void)NGT; (void)lds; (void)HN; (void)HMETA; (void)vcu
#define PH_TABLES() const float* cosM = (const float*)(ws + WS_COSM); const float* sinM = (const float*)(ws + WS_SINM); const float* cosD = (const float*)(ws + WS_COSD); const float* sinD = (const float*)(ws + WS_SIND); \
    (void)cosM; (void)sinM; (void)cosD; (void)sinD

__global__ void __launch_bounds__(NWAVES * 64, 2) hybrid_fwd(Args a_unused) {
    extern __shared__ __attribute__((aligned(16))) unsigned char lds_raw[];
    int lo, hi;
    XcdBarrier bar;
    { CArgs A = fresh_args(); lo = A->lo; hi = A->hi;
      LAS unsigned char* const lds = (LAS unsigned char*)lds_raw;
      for (int u = threadIdx.x; u < (LDS_BYTES - LDSCTL_OFF) / 4; u += NWAVES * 64) ((LAS unsigned*)(lds + LDSCTL_OFF))[u] = 0u;
      __syncthreads();
      bar = xcd_barrier_post((unsigned*)(A->ws + WS_CTL) + CW_BAR, (volatile LAS unsigned*)(lds + MISC_OFF) + 8); }
#ifndef PHMASK
#define PHMASK 0xFFFFFFFFu
#endif
#define IN(k) (((PHMASK >> (k)) & 1u) && lo <= (k) && (k) < hi)
#define SEAM(k) do { if (IN(k) && IN((k) + 1)) xcd_barrier(bar); } while (0)

    if (IN(0)) { PH();
        LAS float* scr = (LAS float*)(lds + wave * 16384);
        constexpr int C0 = 256, C1 = C0 + 720, C2 = C1 + 96, C3 = C2 + 64, C4 = C3 + 512, C5 = C4 + 1408, C6 = C5 + 1408, C7 = C6 + 1408, C8 = C7 + 256, C9 = C8 + 512, C10 = C9 + 256, C11 = C10 + 512, C12 = C11 + 512;
        for (int it = gw; it < C12; it += NGW) {
            if (it < C0) tr_job<0>(it, A->in[I_W_IN_E], 1024, 1952, 0, 512, (bf16*)(ws + WS_WIN0), 1024, 0, 0, 0.125f, scr, lane);
            else if (it < C1) tr_job<0>(it - C0, A->in[I_W_IN_E], 1024, 1952, 512, 1440, (bf16*)(ws + WS_WIN0), 1024, 0, 512, 1.f, scr, lane);
            else if (it < C2) tr_job<0>(it - C1, A->in[I_W_UQ], 256, 768, 0, 768, (bf16*)(ws + WS_WUQKV), 384, 0, 0, SC_MLA, scr, lane);
            else if (it < C3) tr_job<0>(it - C2, A->in[I_W_UKV], 128, 1024, 0, 1024, (bf16*)(ws + WS_WUQKV), 384, 256, 768, 1.f, scr, lane);
            else if (it < C4) tr_job<0>(it - C3, A->in[I_W_OUT_E], 1024, 1024, 0, 1024, (bf16*)(ws + WS_WOUT0), 1024, 0, 0, 1.f, scr, lane);
            else if (it < C5) tr_job<1>(it - C4, A->in[I_W_GATE_E], 1024, DFF, 0, DFF, (bf16*)(ws + WS_WGU0), 1024, 0, 0, 1.f, scr, lane);
            else if (it < C6) tr_job<1>(it - C5, A->in[I_W_UP_E], 1024, DFF, 0, DFF, (bf16*)(ws + WS_WGU0), 1024, 0, 128, 1.f, scr, lane);
            else if (it < C7) tr_job<0>(it - C6, A->in[I_W_DOWN_E], DFF, 1024, 0, 1024, (bf16*)(ws + WS_WDN0), DFF, 0, 0, 1.f, scr, lane);
            else if (it < C8) tr_job<0>(it - C7, A->in[I_W_IN_O], 1024, 3080, 0, 512, (bf16*)(ws + WS_WIN1), 1024, 0, 0, SC_64, scr, lane);
            else if (it < C9) tr_job<0>(it - C8, A->in[I_W_IN_O], 1024, 3080, 512, 1024, (bf16*)(ws + WS_WIN1), 1024, 0, 512, 1.f, scr, lane);
            else if (it < C10) tr_job<0>(it - C9, A->in[I_W_IN_O], 1024, 3080, 1536, 512, (bf16*)(ws + WS_WIN1), 1024, 0, 1536, SC_64, scr, lane);
            else if (it < C11) tr_job<0>(it - C10, A->in[I_W_IN_O], 1024, 3080, 2048, 1024, (bf16*)(ws + WS_WIN1), 1024, 0, 2048, 1.f, scr, lane);
            else tr_job<0>(it - C11, A->in[I_W_OUT_O], 1024, 1024, 0, 1024, (bf16*)(ws + WS_WOUT1), 1024, 0, 0, 1.f, scr, lane);
        }
        { const v4u z = {0u, 0u, 0u, 0u};
          GAS v4u* w0 = (GAS v4u*)(ws + WS_WIN0 + (size_t)1952 * 1024 * 2);
          for (int i = gt; i < 96 * 128; i += NGT) w0[i] = z;
          GAS v4u* wu = (GAS v4u*)(ws + WS_WUQKV);
          for (int i = gt; i < 768 * 16; i += NGT) wu[(size_t)(i >> 4) * 48 + 32 + (i & 15)] = z;
          for (int i = gt; i < 1024 * 32; i += NGT) wu[(size_t)(768 + (i >> 5)) * 48 + (i & 31)] = z; }
        { float* cM = (float*)(ws + WS_COSM); float* sM = (float*)(ws + WS_SINM); float* cD = (float*)(ws + WS_COSD); float* sD = (float*)(ws + WS_SIND);
          for (int idx = gt; idx < 4352 * 16; idx += NGT) { const int pos = idx >> 4, i = idx & 15; const float inv = __builtin_amdgcn_exp2f(-(float)i * (13.287712379549449f / 16.f));
              double rev = (double)pos * (double)inv * 0.15915494309189535; rev -= floor(rev); const float fr = (float)rev; cM[idx] = __builtin_amdgcn_cosf(fr); sM[idx] = __builtin_amdgcn_sinf(fr); }
          for (int idx = gt; idx < 4352 * 8; idx += NGT) { const int pos = idx >> 3, i = idx & 7; const float inv = __builtin_amdgcn_exp2f(-(float)i * (18.931568569324174f / 8.f));
              double rev = (double)pos * (double)inv * 0.15915494309189535; rev -= floor(rev); const float fr = (float)rev; cD[idx] = __builtin_amdgcn_cosf(fr); sD[idx] = __builtin_amdgcn_sinf(fr); } }
        for (int row = gw; row < MR; row += NGW) { f32x4 v[4];
            if (row < NTOK) rms_row(A->in[I_X] + (size_t)row * DM, A->in[I_LN_MIX_E], HN + (size_t)row * DM, lane, v);
            else if (row - NTOK < 16) rms_row(A->in[I_META] + (size_t)(row - NTOK) * DM, A->in[I_LN_MIX_E], HN + (size_t)row * DM, lane, v);
            else zero_row(HN + (size_t)row * DM, lane); }
    }
    SEAM(0);
    if (IN(1)) { PH(); PH_TABLES();
        pg8::Gemm g{HN, (const bf16*)(ws + WS_WIN0), MR, 2048, 1024}; pg8::StaticOrder S; S.init(MR, 2048, G, (int)blockIdx.x);
        pg8::EpiIn0 E{(bf16*)(ws + WS_SB), (bf16*)(ws + WS_CM)};
        pg8::gemm_phase<pg8::EpiIn0, pg8::StaticOrder, true, true>(lds + RING_OFF, g, S, E);
    }
    SEAM(1);
    if (IN(2)) { PH(); PH_TABLES();
        const bf16* CM = (const bf16*)(ws + WS_CM); bf16* CQ = (bf16*)(ws + WS_CQKV); bf16* KC = (bf16*)(ws + WS_KC);
        const float* gq = A->in[I_LN_Q]; const float* gkv = A->in[I_LN_KV];
        for (int row = gw; row < MR; row += NGW) {
            const bf16* cm = CM + (size_t)row * 512;
            const v2u raw = *(const GAS v2u*)(cm + 4 * lane);
            const float x0 = bf2f(raw.x & 0xffffu), x1 = __uint_as_float(raw.x & 0xffff0000u), x2 = bf2f(raw.y & 0xffffu), x3 = __uint_as_float(raw.y & 0xffff0000u);
            const float rq = 1.f / sqrtf(wave_sum((x0 * x0 + x1 * x1) + (x2 * x2 + x3 * x3)) * (1.f / 256.f) + EPS);
            const f32x4 g4 = *(const GAS f32x4*)(gq + 4 * lane);
            v2u w; w.x = pk2bf(x0 * rq * g4.x, x1 * rq * g4.y); w.y = pk2bf(x2 * rq * g4.z, x3 * rq * g4.w);
            *(GAS v2u*)(CQ + (size_t)row * 384 + 4 * lane) = w;
            const unsigned raw2 = *(const GAS unsigned*)(cm + 256 + 2 * lane);
            const float y0 = bf2f(raw2 & 0xffffu), y1 = __uint_as_float(raw2 & 0xffff0000u);
            const float rk = 1.f / sqrtf(wave_sum(y0 * y0 + y1 * y1) * (1.f / 128.f) + EPS);
            *(GAS unsigned*)(CQ + (size_t)row * 384 + 256 + 2 * lane) = pk2bf(y0 * rk * gkv[2 * lane], y1 * rk * gkv[2 * lane + 1]);
            const int i = lane & 15, part = lane >> 4, pos = row_pos(row);
            const float r1 = bf2f(cm[384 + i]), r2 = bf2f(cm[400 + i]), c = cosM[pos * 16 + i], s = sinM[pos * 16 + i];
            const unsigned pk = pk2bf(r1 * c - r2 * s, r2 * c + r1 * s);
            bf16* kr = KC + (size_t)row * 768 + (2 * part) * 96 + 64 + i;
            kr[0] = (bf16)(pk & 0xffffu); kr[16] = (bf16)(pk >> 16); kr[96] = (bf16)(pk & 0xffffu); kr[96 + 16] = (bf16)(pk >> 16);
        }
    }
    SEAM(2);
    if (IN(3)) { PH(); PH_TABLES();
        int k3 = 384; asm volatile("" : "+s"(k3));
        pg8::Gemm g{(const bf16*)(ws + WS_CQKV), (const bf16*)(ws + WS_WUQKV), MR, 1792, k3}; pg8::StaticOrder S; S.init(MR, 1792, G, (int)blockIdx.x);
        pg8::EpiUqkv E{(bf16*)(ws + WS_QMLA), (bf16*)(ws + WS_KC), (bf16*)(ws + WS_VC), cosM, sinM};
        pg8::gemm_phase<pg8::EpiUqkv, pg8::StaticOrder, true, true>(lds + RING_OFF, g, S, E);
    }
    SEAM(3);
    if (IN(4)) { PH(); PH_TABLES();
        const bf16* SBQ = (const bf16*)(ws + WS_SB);
        LAS unsigned char* wl = lds + wave * 8192;
#pragma unroll 1
        for (int u = gw; u < 8192 + 8; u += NGW) {
            const bool mt = u >= 8192; const int bh = mt ? 0 : (u >> 7), qt = u & 127, b = bh >> 3, hh = mt ? (u - 8192) : (bh & 7);
            sb_unit(wl, SBQ + hh * 64, SBQ + 512 + hh * 64, SBQ + 1024 + hh * 64, mt ? META0 : b * SEQ + 32 * qt, mt ? 0 : 16 + 32 * qt, mt ? -1 : qt, b * SEQ, HN + hh * 64, mt ? 16 : 32, lane);
        }
        __syncthreads();
        const bf16* QM = (const bf16*)(ws + WS_QMLA); const bf16* KC = (const bf16*)(ws + WS_KC); const bf16* VC = (const bf16*)(ws + WS_VC);
        const int v = vcu, r = lane & 31, h = lane >> 5;
#pragma unroll 1
        for (int i = 0; i < 5; ++i) {
            int hh, q_row0, kv_row0, NT, qp0; bool meta = false;
            if (i < 4) { const int s = v & 3, bh = v >> 2, b = bh >> 3; hh = bh & 7; const int qb = i == 0 ? s : (i == 1 ? 15 - s : (i == 2 ? 4 + s : 11 - s));
                q_row0 = b * SEQ + 256 * qb; kv_row0 = b * SEQ; NT = 4 * qb + 4; qp0 = 16 + 256 * qb; }
            else { if (v >= 8) break; hh = v; q_row0 = META0; kv_row0 = 0; NT = 0; qp0 = 0; meta = true; }
            const int qrow = q_row0 + 32 * wave + r, qp_lo = qp0 + 32 * wave;
            f32x16 o[2]; float linv;
            attn_pass<96, 64, false, false>(lds, QM + (size_t)qrow * 768 + hh * 96, KC + hh * 96, 768, VC + hh * 64, 512, kv_row0, NT, qp_lo + r, qp_lo, qp_lo + 31, nullptr, nullptr, o, linv);
            attn_store<64>(o, linv, HN + (size_t)qrow * 1024 + 512 + hh * 64, h, !meta || (wave == 0 && r < 16));
        }
    }
    SEAM(4);
    if (IN(5)) { PH(); PH_TABLES();
        pg8::Gemm g{HN, (const bf16*)(ws + WS_WOUT0), MR, 1024, 1024}; pg8::StaticOrder S; S.init(MR, 1024, G, (int)blockIdx.x);
        pg8::EpiResid E{A->in[I_X], A->out, A->in[I_META], HMETA};
        pg8::gemm_phase<pg8::EpiResid, pg8::StaticOrder, true, true>(lds + RING_OFF, g, S, E);
    }
    SEAM(5);
    if (IN(6)) { PH(); PH_TABLES();
        for (int row = gw; row < MR; row += NGW) { f32x4 v[4];
            if (row < NTOK) rms_row(A->out + (size_t)row * DM, A->in[I_LN_FFN_E], HN + (size_t)row * DM, lane, v);
            else if (row - NTOK < 16) rms_row(HMETA + (size_t)(row - NTOK) * DM, A->in[I_LN_FFN_E], HN + (size_t)row * DM, lane, v);
            else zero_row(HN + (size_t)row * DM, lane); }
        LAS float* scr = (LAS float*)(lds + wave * 16384);
        constexpr int PER = 1792;
        for (int it = gw; it < NEXP * 3 * PER; it += NGW) { const int e = it / (3 * PER), rr = it % (3 * PER), kind = rr / PER, j = rr % PER;
            if (kind == 0) tr_job<1>(j, A->in[I_W_MGATE] + (size_t)e * 1024 * DFE, 1024, DFE, 0, DFE, (bf16*)(ws + WS_WMG) + (size_t)e * 7168 * 1024, 1024, 0, 0, 1.f, scr, lane);
            else if (kind == 1) tr_job<1>(j, A->in[I_W_MUP] + (size_t)e * 1024 * DFE, 1024, DFE, 0, DFE, (bf16*)(ws + WS_WMG) + (size_t)e * 7168 * 1024, 1024, 0, 128, 1.f, scr, lane);
            else tr_job<0>(j, A->in[I_W_MDOWN] + (size_t)e * DFE * 1024, DFE, 1024, 0, 1024, (bf16*)(ws + WS_WMD) + (size_t)e * 1024 * DFE, DFE, 0, 0, 1.f, scr, lane); }
    }
    SEAM(6);
    if (IN(7)) { PH(); PH_TABLES();
        pg8::Gemm g{HN, (const bf16*)(ws + WS_WGU0), MR, 2 * DFF, 1024}; pg8::StaticOrder S; S.init(MR, 2 * DFF, G, (int)blockIdx.x);
        pg8::EpiSwiglu E{(bf16*)(ws + WS_ACT0), DFF, 22};
        pg8::gemm_phase<pg8::EpiSwiglu, pg8::StaticOrder, true, true>(lds + RING_OFF, g, S, E);
    }
    SEAM(7);
    if (IN(8)) { PH(); PH_TABLES();
        pg8::Gemm g{(const bf16*)(ws + WS_ACT0), (const bf16*)(ws + WS_WDN0), MR, 1024, DFF}; pg8::StaticOrder S; S.init(MR, 1024, G, (int)blockIdx.x);
        pg8::EpiResid E{A->out, A->out, HMETA, HMETA};
        pg8::gemm_phase<pg8::EpiResid, pg8::StaticOrder, true, true>(lds + RING_OFF, g, S, E);
    }
    SEAM(8);
    if (IN(9)) { PH(); PH_TABLES();
        LAS float* wl = (LAS float*)lds;
        for (int c = tid; c < 1024; c += 512) { const float* src = A->in[I_W_IN_O] + (size_t)c * 3080 + 3072; const f32x4 w0 = *(const GAS f32x4*)src, w1 = *(const GAS f32x4*)(src + 4);
            *(LAS f32x4*)(wl + c * 8) = w0; *(LAS f32x4*)(wl + c * 8 + 4) = w1; }
        __syncthreads();
        float* LF = (float*)(ws + WS_LF);
        for (int row = gw; row < MR; row += NGW) { f32x4 v[4];
            const bool real = row < NTOK, metav = !real && (row - NTOK < 16);
            if (!real && !metav) { zero_row(HN + (size_t)row * DM, lane); continue; }
            rms_row(real ? A->out + (size_t)row * DM : HMETA + (size_t)(row - NTOK) * DM, A->in[I_LN_MIX_O], HN + (size_t)row * DM, lane, v);
            float d[8]; row_dot8(v, wl, lane, d);
            float mine = d[0];
#pragma unroll
            for (int e = 1; e < 8; ++e) mine = (lane == e) ? d[e] : mine;
            if (lane < 8) { const float f = mine + A->in[I_B_FORGET][lane]; LF[(size_t)row * 8 + lane] = fminf(f, 0.f) - LN2 * __builtin_amdgcn_logf(1.f + __builtin_amdgcn_exp2f(-fabsf(f) * LOG2E)); }
        }
        __syncthreads();
    }
    SEAM(9);
    if (IN(10)) { PH(); PH_TABLES();
        if (blockIdx.x < 8) {
            const float* LF = (const float*)(ws + WS_LF); float* CF = (float*)(ws + WS_CFOX); float* CMT = (float*)(ws + WS_CMETA);
            const int b = blockIdx.x, hh = wave;
            float mv = lane < 16 ? LF[(size_t)(META0 + lane) * 8 + hh] : 0.f;
#pragma unroll
            for (int o = 1; o < 64; o <<= 1) { const float t = __shfl_up(mv, o); if (lane >= o) mv += t; }
            const float metatot = __shfl(mv, 15);
            if (b == 0 && lane < 16) CMT[hh * 64 + lane] = mv * LOG2E;
            const float* src = LF + (size_t)(b * SEQ + 64 * lane) * 8 + hh;
            float tot = 0.f;
#pragma unroll 8
            for (int k = 0; k < 64; ++k) tot += src[k * 8];
            float inc = tot;
#pragma unroll
            for (int o = 1; o < 64; o <<= 1) { const float t = __shfl_up(inc, o); if (lane >= o) inc += t; }
            float run = metatot + (inc - tot);
            float* dst = CF + (size_t)(b * 8 + hh) * SEQ + 64 * lane;
#pragma unroll 8
            for (int k = 0; k < 64; ++k) { run += src[k * 8]; dst[k] = run * LOG2E; }
        }
        pg8::Gemm g{HN, (const bf16*)(ws + WS_WIN1), MR, 3072, 1024}; pg8::StaticOrder S; S.init(MR, 3072, G, (int)blockIdx.x);
        pg8::EpiIn1 E{(bf16*)(ws + WS_PROJ1), cosD, sinD};
        pg8::gemm_phase<pg8::EpiIn1, pg8::StaticOrder, true, true>(lds + RING_OFF, g, S, E);
    }
    SEAM(10);
    if (IN(11)) { PH(); PH_TABLES();
        const bf16* P1 = (const bf16*)(ws + WS_PROJ1);
        const int v = vcu, r = lane & 31, h = lane >> 5;
        const float lam = __builtin_amdgcn_exp2f(wave_sum(A->in[I_LQ1][lane] * A->in[I_LK1][lane]) * LOG2E) - __builtin_amdgcn_exp2f(wave_sum(A->in[I_LQ2][lane] * A->in[I_LK2][lane]) * LOG2E) + LAM_INIT;
#pragma unroll 1
        for (int i = 0; i < 2; ++i) {
            const int s = v & 7, bh = v >> 3, b = bh >> 2, hh = bh & 3, qb = i == 0 ? s : 15 - s;
            const int q_row0 = b * SEQ + 256 * qb, NT = 4 * qb + 4, qp_lo = 16 + 256 * qb + 32 * wave, qrow = q_row0 + 32 * wave + r;
            bf16* orow = HN + (size_t)qrow * 1024 + hh * 128;
#pragma unroll 1
            for (int m = 0; m < 2; ++m) {
                f32x16 o[4]; float linv;
                attn_pass<64, 128, false, false>(lds, P1 + (size_t)qrow * 3072 + hh * 128 + m * 64, P1 + 512 + hh * 128 + m * 64, 3072, P1 + 1024 + hh * 128, 3072, b * SEQ, NT, qp_lo + r, qp_lo, qp_lo + 31, nullptr, nullptr, o, linv);
                if (m == 0) {
                    attn_store<128>(o, linv, orow, h, true);
                } else {
                    float ss = 0.f;
#pragma unroll
                    for (int dt = 0; dt < 4; ++dt)
#pragma unroll
                        for (int g = 0; g < 4; ++g) { const v2u p1 = *(const GAS v2u*)(orow + 32 * dt + 8 * g + 4 * h);
                            const float a0 = bf2f(p1.x & 0xffffu) - lam * o[dt][4 * g] * linv, a1 = __uint_as_float(p1.x & 0xffff0000u) - lam * o[dt][4 * g + 1] * linv;
                            const float a2 = bf2f(p1.y & 0xffffu) - lam * o[dt][4 * g + 2] * linv, a3 = __uint_as_float(p1.y & 0xffff0000u) - lam * o[dt][4 * g + 3] * linv;
                            o[dt][4 * g] = a0; o[dt][4 * g + 1] = a1; o[dt][4 * g + 2] = a2; o[dt][4 * g + 3] = a3; ss += (a0 * a0 + a1 * a1) + (a2 * a2 + a3 * a3); }
                    ss += __shfl_xor(ss, 32);
                    const float rstd = (1.f - LAM_INIT) / sqrtf(ss * (1.f / 128.f) + EPS);
#pragma unroll
                    for (int dt = 0; dt < 4; ++dt)
#pragma unroll
                        for (int g = 0; g < 4; ++g) { const int d0 = 32 * dt + 8 * g + 4 * h; const f32x4 gs = *(const GAS f32x4*)(A->in[I_SUBLN] + d0);
                            v2u w; w.x = pk2bf(o[dt][4 * g] * rstd * gs.x, o[dt][4 * g + 1] * rstd * gs.y); w.y = pk2bf(o[dt][4 * g + 2] * rstd * gs.z, o[dt][4 * g + 3] * rstd * gs.w);
                            *(GAS v2u*)(orow + d0) = w; }
                }
            }
        }
        const float* CF = (const float*)(ws + WS_CFOX); const float* CMT = (const float*)(ws + WS_CMETA);
#pragma unroll 1
        for (int i = 0; i < 4; ++i) {
            const int s = v & 3, bh = v >> 2, b = bh >> 3, hh = bh & 7, qb = i == 0 ? s : (i == 1 ? 15 - s : (i == 2 ? 4 + s : 11 - s));
            const int q_row0 = b * SEQ + 256 * qb, NT = 4 * qb + 4, qp_lo = 16 + 256 * qb + 32 * wave, qrow = q_row0 + 32 * wave + r;
            f32x16 o[2]; float linv;
            attn_pass<64, 64, true, true>(lds, P1 + (size_t)qrow * 3072 + 1536 + hh * 64, P1 + 2048 + hh * 64, 3072, P1 + 2560 + hh * 64, 3072, b * SEQ, NT, qp_lo + r, qp_lo, qp_lo + 31,
                                          CF + (size_t)(b * 8 + hh) * SEQ, CMT + hh * 64, o, linv);
            attn_store<64>(o, linv, HN + (size_t)qrow * 1024 + 512 + hh * 64, h, true);
        }
    }
    SEAM(11);
    if (IN(12)) { PH(); PH_TABLES();
        pg8::Gemm g{HN, (const bf16*)(ws + WS_WOUT1), NTOK, 1024, 1024}; pg8::StaticOrder S; S.init(NTOK, 1024, G, (int)blockIdx.x);
        pg8::EpiResid E{A->out, A->out, HMETA, HMETA};
        pg8::gemm_phase<pg8::EpiResid, pg8::StaticOrder, true, true>(lds + RING_OFF, g, S, E);
    }
    SEAM(12);
#define TOK ((int4*)(ws + WS_TOK))
#define XS ((bf16*)(ws + WS_XS))
    if (IN(13)) { PH(); PH_TABLES();
        LAS float* wl = (LAS float*)lds;
        for (int c = tid; c < 2048; c += 512) *(LAS f32x4*)(wl + c * 4) = *(const GAS f32x4*)(A->in[I_W_ROUTER] + c * 4);
        __syncthreads();
        for (int row = gw; row < NTOK; row += NGW) { f32x4 v[4];
            rms_row(A->out + (size_t)row * DM, A->in[I_LN_FFN_O], HN + (size_t)row * DM, lane, v);
            float d[8]; row_dot8(v, wl, lane, d);
            int e0 = 0; float v0 = d[0];
#pragma unroll
            for (int e = 1; e < 8; ++e) if (d[e] > v0) { v0 = d[e]; e0 = e; }
            int e1 = -1; float v1 = -INFINITY;
#pragma unroll
            for (int e = 0; e < 8; ++e) if (e != e0 && d[e] > v1) { v1 = d[e]; e1 = e; }
            if (lane == 0) { const float g0 = 1.f / (1.f + __builtin_amdgcn_exp2f((v1 - v0) * LOG2E));
                const int p0 = (int)__hip_atomic_fetch_add(((unsigned*)(ws + WS_CTL)) + CW_CNT + 64 * e0, 1u, __ATOMIC_RELAXED, __HIP_MEMORY_SCOPE_AGENT);
                const int p1 = (int)__hip_atomic_fetch_add(((unsigned*)(ws + WS_CTL)) + CW_CNT + 64 * e1, 1u, __ATOMIC_RELAXED, __HIP_MEMORY_SCOPE_AGENT);
                TOK[row] = make_int4(e0 | (e1 << 8), p0, p1, __float_as_int(g0)); }
        }
        __syncthreads();
    }
    SEAM(13);
    int tb[9]; int clo, chi;
    { CArgs A = fresh_args(); clo = A->clo; chi = A->chi; unsigned* cnt = (unsigned*)(A->ws + WS_CTL) + CW_CNT; tb[0] = 0;
#pragma unroll
      for (int e = 0; e < 8; ++e) { const int c = (int)__hip_atomic_load(cnt + 64 * e, __ATOMIC_RELAXED, __HIP_MEMORY_SCOPE_AGENT); tb[e + 1] = tb[e] + ((c + 255) >> 8); } }
#define TB_OF(e) ((e) == 0 ? tb[0] : (e) == 1 ? tb[1] : (e) == 2 ? tb[2] : (e) == 3 ? tb[3] : (e) == 4 ? tb[4] : (e) == 5 ? tb[5] : (e) == 6 ? tb[6] : tb[7])
    if (IN(14)) { PH(); PH_TABLES();
        for (int row = gw; row < NTOK; row += NGW) { const int4 ti = TOK[row]; const int e0 = ti.x & 255, e1 = ti.x >> 8;
            const size_t r0 = (size_t)TB_OF(e0) * 256 + ti.y, r1 = (size_t)TB_OF(e1) * 256 + ti.z;
            const GAS v4u* src = (const GAS v4u*)(HN + (size_t)row * DM) + lane; const v4u x0 = src[0], x1 = src[64];
            GAS v4u* d0 = (GAS v4u*)(XS + r0 * DM) + lane; GAS v4u* d1 = (GAS v4u*)(XS + r1 * DM) + lane;
            d0[0] = x0; d0[64] = x1; d1[0] = x0; d1[64] = x1; }
    }
    SEAM(14);
    for (int c = clo; c < chi; ++c) {
        const int t0 = c * MOE_CT; int nt = tb[8] - t0; nt = nt < 0 ? 0 : (nt > MOE_CT ? MOE_CT : nt);
        if (IN(15)) { PH(); PH_TABLES();
            pg8::Gemm g{XS + (size_t)t0 * 256 * DM, (const bf16*)(ws + WS_WMG), nt * 256, 2 * DFE, 1024};
            pg8::MoeOrder S; S.so.init(nt * 256, 2 * DFE, G, (int)blockIdx.x); S.tb1 = tb[1]; S.tb2 = tb[2]; S.tb3 = tb[3]; S.tb4 = tb[4]; S.tb5 = tb[5]; S.tb6 = tb[6]; S.tb7 = tb[7]; S.t0 = t0; S.nper = 28;
            pg8::EpiSwiglu E{(bf16*)(ws + WS_ACTC), DFE, 28};
            pg8::gemm_phase<pg8::EpiSwiglu, pg8::MoeOrder, true, true>(lds + RING_OFF, g, S, E);
            if (IN(16)) xcd_barrier(bar);
        }
        if (IN(16)) { PH(); PH_TABLES();
            pg8::Gemm g{(const bf16*)(ws + WS_ACTC), (const bf16*)(ws + WS_WMD), nt * 256, 1024, DFE};
            pg8::MoeOrder S; S.so.init(nt * 256, 1024, G, (int)blockIdx.x); S.tb1 = tb[1]; S.tb2 = tb[2]; S.tb3 = tb[3]; S.tb4 = tb[4]; S.tb5 = tb[5]; S.tb6 = tb[6]; S.tb7 = tb[7]; S.t0 = t0; S.nper = 4;
            pg8::EpiPlain E{XS + (size_t)t0 * 256 * DM, 1024, 4};
            pg8::gemm_phase<pg8::EpiPlain, pg8::MoeOrder, true, true>(lds + RING_OFF, g, S, E);
            if ((c + 1 < chi) ? IN(15) : IN(17)) xcd_barrier(bar);
        }
    }
    if (IN(17)) { PH(); PH_TABLES();
        for (int row = gw; row < NTOK; row += NGW) { const int4 ti = TOK[row]; const int e0 = ti.x & 255, e1 = ti.x >> 8; const float g0 = __int_as_float(ti.w), g1 = 1.f - g0;
            const size_t r0 = (size_t)TB_OF(e0) * 256 + ti.y, r1 = (size_t)TB_OF(e1) * 256 + ti.z;
            GAS f32x4* xr = (GAS f32x4*)(A->out + (size_t)row * DM) + lane; const GAS v2u* y0 = (const GAS v2u*)(XS + r0 * DM) + lane; const GAS v2u* y1 = (const GAS v2u*)(XS + r1 * DM) + lane;
            f32x4 v[4]; float s = 0.f;
#pragma unroll
            for (int j = 0; j < 4; ++j) { const v2u p = y0[64 * j], q = y1[64 * j]; f32x4 x = xr[64 * j];
                x.x += g0 * bf2f(p.x & 0xffffu) + g1 * bf2f(q.x & 0xffffu); x.y += g0 * __uint_as_float(p.x & 0xffff0000u) + g1 * __uint_as_float(q.x & 0xffff0000u);
                x.z += g0 * bf2f(p.y & 0xffffu) + g1 * bf2f(q.y & 0xffffu); x.w += g0 * __uint_as_float(p.y & 0xffff0000u) + g1 * __uint_as_float(q.y & 0xffff0000u);
                v[j] = x; s += (x.x * x.x + x.y * x.y) + (x.z * x.z + x.w * x.w); }
            const float rstd = 1.f / sqrtf(wave_sum(s) * (1.f / 1024.f) + EPS);
#pragma unroll
            for (int j = 0; j < 4; ++j) { const f32x4 gg = *((const GAS f32x4*)A->in[I_LN_FINAL] + lane + 64 * j); xr[64 * j] = v[j] * rstd * gg; }
        }
    }
#undef IN
#undef SEAM
#undef TB_OF
#undef TOK
#undef XS
#undef PH
#undef PH_TABLES
}

#ifndef MK_PER_PHASE
#define MK_PER_PHASE 1
#endif
extern "C" void kernel_launch(void* const* d_in, const int* in_sizes, int n_in, void* d_out, int out_size, void* d_ws, size_t ws_size, hipStream_t stream) {
    static int grid = 0;
    if (grid == 0) {
        if (n_in != 28 || in_sizes[0] != NTOK * DM || out_size != NTOK * DM || ws_size < WS_END) { fprintf(stderr, "kernel_launch: unexpected shapes / workspace (n_in %d, ws %zu, need %zu); nothing launched\n", n_in, ws_size, (size_t)WS_END); grid = -1; return; }
        int dev = 0, cus = 0;
        if (hipGetDevice(&dev) != hipSuccess || hipDeviceGetAttribute(&cus, hipDeviceAttributeMultiprocessorCount, dev) != hipSuccess) { grid = -1; return; }
        if (hipFuncSetAttribute((const void*)hybrid_fwd, hipFuncAttributeMaxDynamicSharedMemorySize, LDS_BYTES) != hipSuccess) { fprintf(stderr, "kernel_launch: hipFuncSetAttribute failed\n"); grid = -1; return; }
        int per_cu = 0;
        if (hipOccupancyMaxActiveBlocksPerMultiprocessor(&per_cu, (const void*)hybrid_fwd, NWAVES * 64, LDS_BYTES) != hipSuccess || per_cu < 1) fprintf(stderr, "kernel_launch: occupancy query says %d\n", per_cu);
        (void)hipGetLastError();
        grid = cus;
    }
    if (grid < 0) return;
    if (hipMemsetAsync((char*)d_ws + WS_CTL, 0, CTL_ZERO_BYTES, stream) != hipSuccess) return;
    Args ha{};
    for (int i = 0; i < 28; ++i) ha.in[i] = (const float*)d_in[i];
    ha.out = (float*)d_out; ha.ws = (unsigned char*)d_ws;
#if MK_PER_PHASE
    for (int p = 0; p < N_PHASES; ++p) {
        if (p == 15) { for (int c = 0; c < MOE_NCHUNK; ++c) { ha.lo = 15; ha.hi = 16; ha.clo = c; ha.chi = c + 1; hipLaunchKernelGGL(hybrid_fwd, dim3(grid), dim3(NWAVES * 64), LDS_BYTES, stream, ha);
                                                               ha.lo = 16; ha.hi = 17; hipLaunchKernelGGL(hybrid_fwd, dim3(grid), dim3(NWAVES * 64), LDS_BYTES, stream, ha); } ++p; continue; }
        ha.lo = p; ha.hi = p + 1; ha.clo = 0; ha.chi = 0;
        hipLaunchKernelGGL(hybrid_fwd, dim3(grid), dim3(NWAVES * 64), LDS_BYTES, stream, ha);
    }
#else
    ha.lo = 0; ha.hi = N_PHASES; ha.clo = 0; ha.chi = MOE_NCHUNK;
    hipLaunchKernelGGL(hybrid_fwd, dim3(grid), dim3(NWAVES * 64), LDS_BYTES, stream, ha);
#endif
}
```

```cpp
#include <hip/hip_runtime.h>
#include <cstdio>
#include <cstdint>
#include <cmath>
namespace pg8 {
#define PG8_LAS __attribute__((address_space(3)))
typedef unsigned short bf16_t;
typedef short bf16x8 __attribute__((ext_vector_type(8)));
typedef float f32x4 __attribute__((ext_vector_type(4)));
typedef unsigned u32x4 __attribute__((ext_vector_type(4)));
typedef int v4i_t __attribute__((ext_vector_type(4))); typedef int v8i_t __attribute__((ext_vector_type(8)));
constexpr int BM = 256, BK = 64, HALF = 128, HTB = HALF * BK * 2  , STAGE_BYTES = 8 * HTB, NXCD = 8, WGM = 8;

__host__ __device__ __forceinline__ int lds_byte(int r, int c) { const int st = (r >> 4) * 2 + (c >> 5), rr = r & 15, cc = c & 31, ob = rr * 64 + cc * 2; return st * 1024 + (ob ^ (((ob >> 9) & 1) << 5)); }
__host__ __device__ __forceinline__ void stage_rc(int b, int& R, int& C) { const int st = b / 1024, sb = b % 1024, swz = sb ^ (((sb >> 9) & 1) << 5); R = (st >> 1) * 16 + swz / 64; C = (st & 1) * 32 + (swz % 64) / 2; }
__host__ __device__ __forceinline__ int perm32(int rho) { const int n = rho >> 4, i = rho & 15; return 8 * (i >> 2) + 4 * n + (i & 3); }

struct Unit { int pm, pn; };
struct Gemm { const bf16_t* A; const bf16_t* Bt; int M, N, K; int ld; const bf16_t* A2; int splitA; };

struct StaticOrder {
    int nM, nN, nwg, G, c;
    __host__ __device__ void init(int M, int N, int G_, int c_) { nM = M / BM; nN = N / BM; nwg = nM * nN; G = G_; c = c_; }
    __host__ __device__ bool next(int i, Unit& u) const {
        const long L = (long)i * G + c; if (L >= nwg) return false;
        int wgid = (int)L; { const int q = nwg / NXCD, r = nwg % NXCD, xcd = wgid % NXCD, off = wgid / NXCD; wgid = (xcd < r ? xcd * (q + 1) : r * (q + 1) + (xcd - r) * q) + off; }
        const int nig = WGM * nN, gid = wgid / nig, fm = gid * WGM, gsz = (nM - fm) < WGM ? (nM - fm) : WGM;
        u.pm = fm + ((wgid % nig) % gsz); u.pn = (wgid % nig) / gsz; return true;
    }
    __device__ __forceinline__ void a_ready(const Unit&) const {}
    __device__ __forceinline__ void done(const Unit&) const {}
    __device__ __forceinline__ int kshift(const Unit&) const { return 0; }
};

__device__ __forceinline__ unsigned cvt_pk_bf16(float lo, float hi) { unsigned r; asm volatile("v_cvt_pk_bf16_f32 %0, %1, %2" : "=v"(r) : "v"(lo), "v"(hi)); return r; }
typedef float f32x2 __attribute__((ext_vector_type(2)));
constexpr int I8_SCALE_OFF = 131072 + 320 + 1024;
template <class Epi, class Sched, bool ALIGN_EPI = false, bool SP2 = false, bool FP8 = false, bool I8 = false, bool GATHER = false>
__device__ __forceinline__ void gemm_phase(PG8_LAS unsigned char* lds, const Gemm g, const Sched& S, const Epi& E) {
    int tid_ = threadIdx.x; asm volatile("" : "+v"(tid_));
    const int tid = tid_, wid = __builtin_amdgcn_readfirstlane(tid >> 6), lane = tid & 63, wr = wid >> 2, wc = wid & 3, fr = lane & 15, fq = lane >> 4;
    const int K = g.K, nt = K / BK, LD = g.ld ? g.ld : g.K;
    unsigned voffA[2], voffB[2];
#pragma unroll
    for (int i = 0; i < 2; ++i) { int R, C; stage_rc(tid * 16 + i * 8192, R, C); const int Rb = Epi::PERM ? ((R & ~31) + perm32(R & 31)) : R;
        voffA[i] = (unsigned)(R * LD + C) * 2u; voffB[i] = (unsigned)(Rb * LD + C) * 2u; }
    const size_t kstep = (size_t)(BK * 2);
    const size_t hstep = (size_t)HALF * LD * 2;
    const size_t tstep = 2 * hstep;
    static_assert(!GATHER || SP2, "GATHER is written for the SP2 schedule");
    const size_t hstepA = GATHER ? 0 : hstep;
    unsigned gcur[2] = {0u, 0u}, gnxt[2] = {0u, 0u}; int gR0 = 0, gC0 = 0; unsigned gcoff = 0u; int gwid = 0;
    if constexpr (GATHER) { int tidg = tid; asm volatile("" : "+v"(tidg));
        stage_rc(tidg * 16, gR0, gC0); gcoff = (unsigned)(gC0 * 2); gwid = __builtin_amdgcn_readfirstlane(tidg >> 6); }
    constexpr int GATHER_OFF = I8_SCALE_OFF + 4096;
#define PG8_GDMA(unit) do { const int* gp_ = S.gbase(unit); _Pragma("unroll") for (int j_ = 0; j_ < 4; ++j_) \
        __builtin_amdgcn_global_load_lds((const unsigned*)(gp_ + (j_ >> 1) * HALF + gR0 + (j_ & 1) * 64), (PG8_LAS unsigned*)(lds + GATHER_OFF + j_ * 2048 + gwid * 256), 4, 0, 0); } while (0)
#define PG8_GREAD(dst) do { const PG8_LAS unsigned* gl_ = (const PG8_LAS unsigned*)(lds + GATHER_OFF + gwid * 256) + lane; const unsigned i0_ = gl_[0], i1_ = gl_[512], i2_ = gl_[1024], i3_ = gl_[1536]; \
        dst[0] = i0_ | (i1_ << 16); dst[1] = i2_ | (i3_ << 16); } while (0)
#define PG8_STAGEA(bufoff, gbase, h, nx) do { if constexpr (GATHER) { const unsigned p_ = (nx) ? gnxt[h] : gcur[h]; unsigned vo_[2]; vo_[0] = (p_ & 0xffffu) * (unsigned)(LD * 2) + gcoff; vo_[1] = (p_ >> 16) * (unsigned)(LD * 2) + gcoff; \
            PG8_STAGE(bufoff, gbase, vo_); } \
        else PG8_STAGE(bufoff, gbase, voffA); } while (0)
    const unsigned ldsw = (unsigned)wid * 1024u;
    const int aoff = lds_byte(wr * 64 + fr, fq * 8), boff = lds_byte(wc * 32 + fr, fq * 8);
#define PG8_SA(b, h) (((b) * 2 + (h)) * HTB)
#define PG8_SB(b, h) ((4 + (b) * 2 + (h)) * HTB)
#define PG8_STAGE(bufoff, gbase, voff) do { _Pragma("unroll") for (int _i = 0; _i < 2; ++_i) \
        __builtin_amdgcn_global_load_lds((const unsigned*)((const char*)(gbase) + (voff)[_i]), (PG8_LAS unsigned*)(lds + (bufoff) + ldsw + _i * 8192), 16, 0, 0); } while (0)
#define PG8_LDA(dst, b, h) do { if constexpr (FP8) { _Pragma("unroll") for (int m = 0; m < 4; ++m) { const v4i_t lo_ = *(const PG8_LAS v4i_t*)(lds + PG8_SA(b, h) + aoff + m * 2048), hi_ = *(const PG8_LAS v4i_t*)(lds + PG8_SA(b, h) + aoff + m * 2048 + 1024); dst##8[m] = __builtin_shufflevector(lo_, hi_, 0, 1, 2, 3, 4, 5, 6, 7); } } \
        else { _Pragma("unroll") for (int m = 0; m < 4; ++m) _Pragma("unroll") for (int k = 0; k < 2; ++k) dst[m][k] = *(const PG8_LAS bf16x8*)(lds + PG8_SA(b, h) + aoff + m * 2048 + k * 1024); } } while (0)
#define PG8_LDB(dst, b, h) do { if constexpr (FP8) { _Pragma("unroll") for (int n = 0; n < 2; ++n) { const v4i_t lo_ = *(const PG8_LAS v4i_t*)(lds + PG8_SB(b, h) + boff + n * 2048), hi_ = *(const PG8_LAS v4i_t*)(lds + PG8_SB(b, h) + boff + n * 2048 + 1024); dst##8[n] = __builtin_shufflevector(lo_, hi_, 0, 1, 2, 3, 4, 5, 6, 7); } } \
        else { _Pragma("unroll") for (int n = 0; n < 2; ++n) _Pragma("unroll") for (int k = 0; k < 2; ++k) dst[n][k] = *(const PG8_LAS bf16x8*)(lds + PG8_SB(b, h) + boff + n * 2048 + k * 1024); } } while (0)
#define PG8_CAT8(lo, hi) __builtin_shufflevector(__builtin_bit_cast(v4i_t, lo), __builtin_bit_cast(v4i_t, hi), 0, 1, 2, 3, 4, 5, 6, 7)
#define PG8_MMA(ai, bj, At, Bt) do { __builtin_amdgcn_s_setprio(1); \
        if constexpr (FP8) { _Pragma("unroll") for (int m = 0; m < 4; ++m) _Pragma("unroll") for (int n = 0; n < 2; ++n) \
            asm volatile("v_mfma_scale_f32_16x16x128_f8f6f4 %0, %1, %2, %0, %3, %3 op_sel_hi:[0,0,0]" : "+v"(acc[ai][bj][m][n]) : "v"(Bt##8[n]), "v"(At##8[m]), "v"(one_scale)); }   \
        else if constexpr (I8) { _Pragma("unroll") for (int m = 0; m < 4; ++m) _Pragma("unroll") for (int n = 0; n < 2; ++n) _Pragma("unroll") for (int k = 0; k < 2; ++k) \
            asm volatile("v_mfma_i32_16x16x64_i8 %0, %1, %2, %0" : "+v"(acc[ai][bj][m][n]) : "v"(Bt[n][k]), "v"(At[m][k])); }   \
        else { _Pragma("unroll") for (int m = 0; m < 4; ++m) _Pragma("unroll") for (int n = 0; n < 2; ++n) _Pragma("unroll") for (int k = 0; k < 2; ++k) \
            acc[ai][bj][m][n] = __builtin_amdgcn_mfma_f32_16x16x32_bf16(Bt[n][k], At[m][k], acc[ai][bj][m][n], 0, 0, 0); } \
        __builtin_amdgcn_s_setprio(0); } while (0)
#define PG8_WAIT_V(n) asm volatile("s_waitcnt vmcnt(" #n ")" ::: "memory")
#define PG8_WAIT_L(n) asm volatile("s_waitcnt lgkmcnt(" #n ")" ::: "memory")
#define PG8_BAR __builtin_amdgcn_s_barrier()
#define PG8_SCHED __builtin_amdgcn_sched_barrier(0)
    Unit cur, nxt; int ui = 0;
    if (!S.next(0, cur)) return;
    f32x4 acc[2][2][4][2];
#pragma unroll
    for (int a = 0; a < 2; ++a)
#pragma unroll
        for (int b = 0; b < 2; ++b)
#pragma unroll
            for (int m = 0; m < 4; ++m)
#pragma unroll
                for (int n = 0; n < 2; ++n) acc[a][b][m][n] = (f32x4){0.f, 0.f, 0.f, 0.f};
    int one_scale = 0x7F7F7F7F; asm volatile("" : "+v"(one_scale));
    bf16x8 At[4][2], B0[2][2], B1[2][2]; v8i_t At8[4], B08[2], B18[2];
#define PG8_ABASE(pm_) ((g.splitA != 0 && (pm_) >= g.splitA) ? (const char*)g.A2 + (size_t)((pm_) - g.splitA) * tstep : (const char*)g.A + (size_t)(pm_) * tstep)
    const char* cA = (GATHER ? (const char*)g.A : PG8_ABASE(cur.pm)) + S.kshift(cur); const char* cB = (const char*)g.Bt + (size_t)cur.pn * tstep + S.kshift(cur);
    if constexpr (GATHER) { const int* gp_ = S.gbase(cur); const unsigned i0_ = (unsigned)gp_[gR0], i1_ = (unsigned)gp_[gR0 + 64], i2_ = (unsigned)gp_[HALF + gR0], i3_ = (unsigned)gp_[HALF + gR0 + 64];
        gcur[0] = i0_ | (i1_ << 16); gcur[1] = i2_ | (i3_ << 16); }
    S.a_ready(cur);
    if constexpr (SP2) {
        PG8_STAGE(PG8_SB(0, 0), cB, voffB); PG8_STAGE(PG8_SB(0, 1), cB + hstep, voffB); PG8_STAGEA(PG8_SA(0, 0), cA, 0, false); PG8_STAGEA(PG8_SA(0, 1), cA + hstepA, 1, false);
        if (wr == 1) PG8_BAR;
        PG8_WAIT_V(2); PG8_BAR;
        PG8_STAGE(PG8_SB(1, 0), cB + kstep, voffB); PG8_STAGEA(PG8_SA(1, 0), cA + kstep, 0, false); PG8_STAGE(PG8_SB(1, 1), cB + hstep + kstep, voffB);
        PG8_WAIT_V(6); PG8_BAR;
    } else {
        PG8_STAGE(PG8_SB(0, 0), cB, voffB); PG8_STAGE(PG8_SA(0, 0), cA, voffA); PG8_STAGE(PG8_SB(0, 1), cB + hstep, voffB); PG8_STAGE(PG8_SA(0, 1), cA + hstep, voffA);
        if (wr == 1) PG8_BAR;
        PG8_WAIT_V(4); PG8_BAR;
        PG8_STAGE(PG8_SB(1, 0), cB + kstep, voffB); PG8_STAGE(PG8_SA(1, 0), cA + kstep, voffA); PG8_STAGE(PG8_SB(1, 1), cB + hstep + kstep, voffB);
        PG8_WAIT_V(6); PG8_BAR;
    }
    for (;;) {
        const bool has_next = S.next(ui + 1, nxt);
        const char* nA = (has_next && !GATHER) ? PG8_ABASE(nxt.pm) + S.kshift(nxt) : cA; const char* nB = has_next ? (const char*)g.Bt + (size_t)nxt.pn * tstep + S.kshift(nxt) : cB;
        if constexpr (GATHER) { if (has_next) PG8_GDMA(nxt); }
        if constexpr (I8) E.prefetch(lds, cur, ui & 1, wid, lane);
        for (int t = 0; t < nt; t += 2) {
            const bool last = (t == nt - 2);
            const char* a1 = cA + (size_t)(t + 1) * kstep;
            const char* a2 = last ? nA : cA + (size_t)(t + 2) * kstep; const char* b2 = last ? nB : cB + (size_t)(t + 2) * kstep;
            const char* a3 = a2 + kstep; const char* b3 = b2 + kstep;
            if (last && has_next) S.a_ready(nxt);
            const bool nx = last && has_next; (void)nx;
            if constexpr (GATHER) { if (nx) PG8_GREAD(gnxt); }
            if constexpr (SP2) {
            PG8_LDB(B0, 0, 0); PG8_LDB(B1, 0, 1); PG8_SCHED; PG8_LDA(At, 0, 0); PG8_STAGEA(PG8_SA(1, 1), a1 + hstepA, 1, false);
            PG8_WAIT_V(8); PG8_WAIT_L(0); PG8_BAR; PG8_MMA(0, 0, At, B0); PG8_MMA(0, 1, At, B1); PG8_BAR; PG8_SCHED;
            PG8_LDA(At, 0, 1); PG8_STAGE(PG8_SB(0, 0), b2, voffB); PG8_STAGE(PG8_SB(0, 1), b2 + hstep, voffB); PG8_STAGEA(PG8_SA(0, 0), a2, 0, nx);
            PG8_WAIT_V(8); PG8_WAIT_L(0); PG8_BAR; PG8_MMA(1, 0, At, B0); PG8_MMA(1, 1, At, B1); PG8_BAR; PG8_SCHED;
            PG8_LDB(B0, 1, 0); PG8_LDB(B1, 1, 1); PG8_SCHED; PG8_LDA(At, 1, 0); PG8_STAGEA(PG8_SA(0, 1), a2 + hstepA, 1, nx);
            PG8_WAIT_V(8); PG8_WAIT_L(0); PG8_BAR; PG8_MMA(0, 0, At, B0); PG8_MMA(0, 1, At, B1); PG8_BAR; PG8_SCHED;
            PG8_LDA(At, 1, 1); PG8_STAGE(PG8_SB(1, 0), b3, voffB); PG8_STAGE(PG8_SB(1, 1), b3 + hstep, voffB); PG8_STAGEA(PG8_SA(1, 0), a3, 0, nx);
            PG8_WAIT_V(8); PG8_WAIT_L(0); PG8_BAR; PG8_MMA(1, 0, At, B0); PG8_MMA(1, 1, At, B1); PG8_BAR; PG8_SCHED;
            } else {
            PG8_LDB(B0, 0, 0); PG8_SCHED; PG8_LDA(At, 0, 0); PG8_STAGE(PG8_SA(1, 1), a1 + hstep, voffA);
            PG8_WAIT_L(8); PG8_BAR; PG8_WAIT_L(0); PG8_MMA(0, 0, At, B0); PG8_BAR; PG8_SCHED;
            PG8_LDB(B1, 0, 1); PG8_STAGE(PG8_SB(0, 0), b2, voffB);
            PG8_BAR; PG8_WAIT_L(0); PG8_MMA(0, 1, At, B1); PG8_BAR;
            PG8_LDA(At, 0, 1); PG8_STAGE(PG8_SA(0, 0), a2, voffA);
            PG8_BAR; PG8_WAIT_L(0); PG8_MMA(1, 0, At, B0); PG8_BAR; PG8_SCHED;
            PG8_STAGE(PG8_SB(0, 1), b2 + hstep, voffB);
            PG8_WAIT_V(6); PG8_BAR; PG8_MMA(1, 1, At, B1); PG8_BAR;
            PG8_LDB(B0, 1, 0); PG8_SCHED; PG8_LDA(At, 1, 0); PG8_STAGE(PG8_SA(0, 1), a2 + hstep, voffA);
            PG8_WAIT_L(8); PG8_BAR; PG8_WAIT_L(0); PG8_MMA(0, 0, At, B0); PG8_BAR; PG8_SCHED;
            PG8_LDB(B1, 1, 1); PG8_STAGE(PG8_SB(1, 0), b3, voffB);
            PG8_BAR; PG8_WAIT_L(0); PG8_MMA(0, 1, At, B1); PG8_BAR;
            PG8_LDA(At, 1, 1); PG8_STAGE(PG8_SA(1, 0), a3, voffA);
            PG8_BAR; PG8_WAIT_L(0); PG8_MMA(1, 0, At, B0); PG8_BAR; PG8_SCHED;
            PG8_STAGE(PG8_SB(1, 1), b3 + hstep, voffB);
            PG8_WAIT_V(6); PG8_BAR; PG8_MMA(1, 1, At, B1); PG8_BAR;
            }
        }
        if constexpr (ALIGN_EPI) { if (wr == 0) PG8_BAR; }
        if constexpr (FP8 || I8) asm volatile("s_nop 15\n\ts_nop 15" ::: "memory");
        if constexpr (!Epi::AFTER_DRAIN) { Unit cu_ = cur; int wr_ = wr, wc_ = wc, fr_ = fr, fq_ = fq;
            asm volatile("" : "+v"(cu_.pm), "+v"(cu_.pn), "+v"(wr_), "+v"(wc_), "+v"(fr_), "+v"(fq_));
            cu_.pm = __builtin_amdgcn_readfirstlane(cu_.pm); cu_.pn = __builtin_amdgcn_readfirstlane(cu_.pn); wr_ = __builtin_amdgcn_readfirstlane(wr_); wc_ = __builtin_amdgcn_readfirstlane(wc_);
            if constexpr (I8) E(acc, cu_, wr_, wc_, fr_, fq_, lds + I8_SCALE_OFF + (ui & 1) * 2048); else E(acc, cu_, wr_, wc_, fr_, fq_);
            S.done(cur); }
        if (!has_next) break;
#pragma unroll
        for (int a = 0; a < 2; ++a)
#pragma unroll
            for (int b = 0; b < 2; ++b)
#pragma unroll
                for (int m = 0; m < 4; ++m)
#pragma unroll
                    for (int n = 0; n < 2; ++n) acc[a][b][m][n] = (f32x4){0.f, 0.f, 0.f, 0.f};
        if constexpr (GATHER) { gcur[0] = gnxt[0]; gcur[1] = gnxt[1]; }
        cur = nxt; cA = nA; cB = nB; ++ui;
        if constexpr (ALIGN_EPI) { if (wr == 1) PG8_BAR; }
    }
    PG8_WAIT_V(0);
    if constexpr (!ALIGN_EPI) { if (wr == 0) PG8_BAR; }
    PG8_BAR;
    if constexpr (Epi::AFTER_DRAIN) { E.fused(acc, cur, wr, wc, fr, fq, lds, wid, lane); S.done(cur); }
#undef PG8_SA
#undef PG8_SB
#undef PG8_STAGE
#undef PG8_ABASE
#undef PG8_STAGEA
#undef PG8_GDMA
#undef PG8_GREAD
#undef PG8_LDA
#undef PG8_LDB
#undef PG8_MMA
#undef PG8_CAT8
#undef PG8_WAIT_V
#undef PG8_WAIT_L
#undef PG8_BAR
#undef PG8_SCHED
}
typedef float f32x2e __attribute__((ext_vector_type(2))); typedef __bf16 bf16x2e __attribute__((ext_vector_type(2)));
__device__ __forceinline__ unsigned pk2bf(float lo, float hi) { f32x2e v = {lo, hi}; bf16x2e b = __builtin_convertvector(v, bf16x2e); return __builtin_bit_cast(unsigned, b); }
__device__ __forceinline__ u32x4 pack8(const f32x4 v0, const f32x4 v1) { u32x4 w; w.x = pk2bf(v0[0], v0[1]); w.y = pk2bf(v0[2], v0[3]); w.z = pk2bf(v1[0], v1[1]); w.w = pk2bf(v1[2], v1[3]); return w; }
__device__ __forceinline__ int row_pos(int row) { return row < 32768 ? 16 + (row & 4095) : row - 32768; }

__device__ __forceinline__ void i8_scale_prefetch(PG8_LAS unsigned char* lds, const float* rs, const float* cs, int pm, int pn, int buf, int wid, int lane) {
    const float* src = wid < 4 ? rs + pm * 256 + wid * 64 + lane : cs + pn * 256 + (wid - 4) * 64 + lane;
    __builtin_amdgcn_global_load_lds((const unsigned*)src, (PG8_LAS unsigned*)(lds + I8_SCALE_OFF + buf * 2048 + wid * 256), 4, 0, 0);
}
struct EpiIn0 { static constexpr bool PERM = true, AFTER_DRAIN = false;
    bf16_t* sb; bf16_t* cm;
    __device__ __forceinline__ void operator()(const f32x4 (&acc)[2][2][4][2], const Unit& u, int wr, int wc, int fr, int fq) const {
        const int row0 = u.pm * BM + wr * 64 + fr;
        bf16_t* base; int ldc, colt;
        if (u.pn < 6) { base = sb; ldc = 1536; colt = u.pn * 256; } else { base = cm; ldc = 512; colt = (u.pn - 6) * 256; }
        const int col0 = colt + wc * 32 + 8 * fq;
#pragma unroll
        for (int ai = 0; ai < 2; ++ai)
#pragma unroll
            for (int m = 0; m < 4; ++m) { bf16_t* rowp = base + (size_t)(row0 + ai * HALF + m * 16) * ldc + col0;
#pragma unroll
                for (int bj = 0; bj < 2; ++bj) *(u32x4*)(rowp + bj * HALF) = pack8(acc[ai][bj][m][0], acc[ai][bj][m][1]); }
    }
};
struct EpiIn0I8 { static constexpr bool PERM = true, AFTER_DRAIN = false;
    bf16_t* sb; bf16_t* cm; const float* rs; const float* cs;
    __device__ __forceinline__ void prefetch(PG8_LAS unsigned char* lds, const Unit& u, int buf, int wid, int lane) const { i8_scale_prefetch(lds, rs, cs, u.pm, u.pn, buf, wid, lane); }
    __device__ __forceinline__ void operator()(const f32x4 (&acc)[2][2][4][2], const Unit& u, int wr, int wc, int fr, int fq, const PG8_LAS unsigned char* sc) const {
        const int row0 = u.pm * BM + wr * 64 + fr; const PG8_LAS float* sl = (const PG8_LAS float*)sc;
        bf16_t* base; int ldc, colt;
        if (u.pn < 6) { base = sb; ldc = 1536; colt = u.pn * 256; } else { base = cm; ldc = 512; colt = (u.pn - 6) * 256; }
        const int col0 = colt + wc * 32 + 8 * fq; const PG8_LAS float* cp = sl + 256 + wc * 32 + 8 * fq;
        f32x4 cc[2][2];
#pragma unroll
        for (int bj = 0; bj < 2; ++bj) { cc[bj][0] = *(const PG8_LAS f32x4*)(cp + bj * HALF); cc[bj][1] = *(const PG8_LAS f32x4*)(cp + bj * HALF + 4); }
#pragma unroll
        for (int ai = 0; ai < 2; ++ai)
#pragma unroll
            for (int m = 0; m < 4; ++m) { const int row = row0 + ai * HALF + m * 16; bf16_t* rowp = base + (size_t)row * ldc + col0; const float r = sl[wr * 64 + fr + ai * HALF + m * 16];
#pragma unroll
                for (int bj = 0; bj < 2; ++bj) { f32x4 v0, v1;
#pragma unroll
                    for (int e = 0; e < 4; ++e) { const float a0 = acc[ai][bj][m][0][e], a1 = acc[ai][bj][m][1][e]; v0[e] = (float)__float_as_int(a0) * (r * cc[bj][0][e]); v1[e] = (float)__float_as_int(a1) * (r * cc[bj][1][e]); }
                    *(u32x4*)(rowp + bj * HALF) = pack8(v0, v1); } }
    }
};
struct EpiPlain { static constexpr bool PERM = true, AFTER_DRAIN = false;
    bf16_t* O; int ldc; int nmod; float sc;
    __device__ __forceinline__ void operator()(const f32x4 (&acc)[2][2][4][2], const Unit& u, int wr, int wc, int fr, int fq) const {
        const int row0 = u.pm * BM + wr * 64 + fr; const int col0 = (u.pn % nmod) * 256 + wc * 32 + 8 * fq;
#pragma unroll
        for (int ai = 0; ai < 2; ++ai)
#pragma unroll
            for (int m = 0; m < 4; ++m) { bf16_t* rowp = O + (size_t)(row0 + ai * HALF + m * 16) * ldc + col0;
#pragma unroll
                for (int bj = 0; bj < 2; ++bj) *(u32x4*)(rowp + bj * HALF) = pack8(acc[ai][bj][m][0] * sc, acc[ai][bj][m][1] * sc); }
    }
};
struct EpiUqkv { static constexpr bool PERM = true, AFTER_DRAIN = false;
    bf16_t *q, *kc, *vc; const float* cosM; const float* sinM; int pn_off;
    __device__ __forceinline__ void operator()(const f32x4 (&acc)[2][2][4][2], const Unit& u, int wr, int wc, int fr, int fq) const {
        const int row0 = u.pm * BM + wr * 64 + fr; const int upn = u.pn + pn_off;
#pragma unroll
        for (int bj = 0; bj < 2; ++bj) {
            if (upn < 3) {
                const int gidx = 8 * upn + 4 * bj + wc; const bool rope = (gidx % 3) == 2; const int col = 32 * gidx + 8 * fq;
#pragma unroll
                for (int ai = 0; ai < 2; ++ai)
#pragma unroll
                    for (int m = 0; m < 4; ++m) { const int row = row0 + ai * HALF + m * 16; f32x4 v0 = acc[ai][bj][m][0], v1 = acc[ai][bj][m][1];
                        if (rope) { const int pos = row_pos(row); const float* cp = cosM + pos * 16 + 8 * (fq & 1); const float* sp = sinM + pos * 16 + 8 * (fq & 1);
                            const f32x4 c0 = *(const f32x4*)cp, c1 = *(const f32x4*)(cp + 4), s0 = *(const f32x4*)sp, s1 = *(const f32x4*)(sp + 4);
#pragma unroll
                            for (int e = 0; e < 4; ++e) { const float o0 = __shfl_xor(v0[e], 32), o1 = __shfl_xor(v1[e], 32);
                                v0[e] = (fq < 2) ? v0[e] * c0[e] - o0 * s0[e] : v0[e] * c0[e] + o0 * s0[e];
                                v1[e] = (fq < 2) ? v1[e] * c1[e] - o1 * s1[e] : v1[e] * c1[e] + o1 * s1[e]; } }
                        *(u32x4*)(q + (size_t)row * 768 + col) = pack8(v0, v1); }
            } else {
                const int head = 2 * (upn - 3) + bj, within = 32 * wc + 8 * fq; bf16_t* base; int ldc, c;
                if (wc < 2) { base = kc; ldc = 768; c = head * 96 + within; } else { base = vc; ldc = 512; c = head * 64 + within - 64; }
#pragma unroll
                for (int ai = 0; ai < 2; ++ai)
#pragma unroll
                    for (int m = 0; m < 4; ++m) { const int row = row0 + ai * HALF + m * 16; *(u32x4*)(base + (size_t)row * ldc + c) = pack8(acc[ai][bj][m][0], acc[ai][bj][m][1]); }
            }
        }
    }
};
struct EpiIn1 { static constexpr bool PERM = true, AFTER_DRAIN = false;
    bf16_t* o; const float* cosD; const float* sinD;
    __device__ __forceinline__ void operator()(const f32x4 (&acc)[2][2][4][2], const Unit& u, int wr, int wc, int fr, int fq) const {
        const int row0 = u.pm * BM + wr * 64 + fr; const int col0 = u.pn * 256 + wc * 32 + 8 * fq; const bool ropew = (u.pn < 4) && ((wc & 1) == 0);
#pragma unroll
        for (int ai = 0; ai < 2; ++ai)
#pragma unroll
            for (int m = 0; m < 4; ++m) { const int row = row0 + ai * HALF + m * 16; bf16_t* rowp = o + (size_t)row * 3072 + col0;
                f32x4 c0 = {1.f, 1.f, 1.f, 1.f}, c1 = c0, s0 = {0.f, 0.f, 0.f, 0.f}, s1 = s0;
                if (ropew) { const int pos = row_pos(row); c0 = *(const f32x4*)(cosD + pos * 8); c1 = *(const f32x4*)(cosD + pos * 8 + 4); s0 = *(const f32x4*)(sinD + pos * 8); s1 = *(const f32x4*)(sinD + pos * 8 + 4); }
#pragma unroll
                for (int bj = 0; bj < 2; ++bj) { f32x4 v0 = acc[ai][bj][m][0], v1 = acc[ai][bj][m][1];
                    if (ropew) {
#pragma unroll
                        for (int e = 0; e < 4; ++e) { const float o0 = __shfl_xor(v0[e], 16), o1 = __shfl_xor(v1[e], 16);
                            if (fq == 0) { v0[e] = v0[e] * c0[e] - o0 * s0[e]; v1[e] = v1[e] * c1[e] - o1 * s1[e]; }
                            else if (fq == 1) { v0[e] = v0[e] * c0[e] + o0 * s0[e]; v1[e] = v1[e] * c1[e] + o1 * s1[e]; } } }
                    *(u32x4*)(rowp + bj * HALF) = pack8(v0, v1); } }
    }
};
struct EpiIn1I8 { static constexpr bool PERM = true, AFTER_DRAIN = false;
    bf16_t* o; const float* cosD; const float* sinD; const float* rs; const float* cs; unsigned* kn;
    __device__ __forceinline__ void prefetch(PG8_LAS unsigned char* lds, const Unit& u, int buf, int wid, int lane) const { i8_scale_prefetch(lds, rs, cs, u.pm, u.pn, buf, wid, lane); }
    __device__ __forceinline__ void operator()(const f32x4 (&acc)[2][2][4][2], const Unit& u, int wr, int wc, int fr, int fq, const PG8_LAS unsigned char* sc) const {
        const int row0 = u.pm * BM + wr * 64 + fr; const int col0 = u.pn * 256 + wc * 32 + 8 * fq; const bool ropew = (u.pn < 4) && ((wc & 1) == 0); const bool kcol = (u.pn == 8) || (u.pn == 9);
        float knm[2] = {0.f, 0.f}; const PG8_LAS float* sl = (const PG8_LAS float*)sc; const PG8_LAS float* cp = sl + 256 + wc * 32 + 8 * fq;
        f32x4 cc[2][2];
#pragma unroll
        for (int bj = 0; bj < 2; ++bj) { cc[bj][0] = *(const PG8_LAS f32x4*)(cp + bj * HALF); cc[bj][1] = *(const PG8_LAS f32x4*)(cp + bj * HALF + 4); }
#pragma unroll
        for (int ai = 0; ai < 2; ++ai)
#pragma unroll
            for (int m = 0; m < 4; ++m) { const int row = row0 + ai * HALF + m * 16; bf16_t* rowp = o + (size_t)row * 3072 + col0; const float r = sl[wr * 64 + fr + ai * HALF + m * 16];
                f32x4 c0 = {1.f, 1.f, 1.f, 1.f}, c1 = c0, s0 = {0.f, 0.f, 0.f, 0.f}, s1 = s0;
                if (ropew) { const int pos = row_pos(row); c0 = *(const f32x4*)(cosD + pos * 8); c1 = *(const f32x4*)(cosD + pos * 8 + 4); s0 = *(const f32x4*)(sinD + pos * 8); s1 = *(const f32x4*)(sinD + pos * 8 + 4); }
#pragma unroll
                for (int bj = 0; bj < 2; ++bj) { f32x4 v0, v1;
#pragma unroll
                    for (int e = 0; e < 4; ++e) { const float a0 = acc[ai][bj][m][0][e], a1 = acc[ai][bj][m][1][e]; v0[e] = (float)__float_as_int(a0) * (r * cc[bj][0][e]); v1[e] = (float)__float_as_int(a1) * (r * cc[bj][1][e]); }
                    if (ropew) {
#pragma unroll
                        for (int e = 0; e < 4; ++e) { const float o0 = __shfl_xor(v0[e], 16), o1 = __shfl_xor(v1[e], 16);
                            if (fq == 0) { v0[e] = v0[e] * c0[e] - o0 * s0[e]; v1[e] = v1[e] * c1[e] - o1 * s1[e]; }
                            else if (fq == 1) { v0[e] = v0[e] * c0[e] + o0 * s0[e]; v1[e] = v1[e] * c1[e] + o1 * s1[e]; } } }
                    if (kcol) { float ss = (v0[0] * v0[0] + v0[1] * v0[1]) + (v0[2] * v0[2] + v0[3] * v0[3]) + (v1[0] * v1[0] + v1[1] * v1[1]) + (v1[2] * v1[2] + v1[3] * v1[3]);
                        ss += __shfl_xor(ss, 16); ss += __shfl_xor(ss, 32); knm[bj] = fmaxf(knm[bj], ss); }
                    *(u32x4*)(rowp + bj * HALF) = pack8(v0, v1); } }
        if (kcol) {
#pragma unroll
            for (int bj = 0; bj < 2; ++bj) { float m = knm[bj];
#pragma unroll
                for (int o_ = 1; o_ < 16; o_ <<= 1) m = fmaxf(m, __shfl_xor(m, o_));
                const int colk = u.pn * 256 + bj * HALF + wc * 32 - 2048;
                if (fr == 0 && fq == 0) atomicMax(kn + ((u.pm >> 4) * 8 + (colk >> 6)) * 2 + ((colk >> 5) & 1), __float_as_uint(m)); } }
    }
};
struct EpiResid { static constexpr bool PERM = false, AFTER_DRAIN = false;
    const float* rr; float* dr; const float* rm; float* dm;
    __device__ __forceinline__ void operator()(const f32x4 (&acc)[2][2][4][2], const Unit& u, int wr, int wc, int fr, int fq) const {
        const int col0 = u.pn * BM + wc * 32 + 4 * fq;
#pragma unroll
        for (int ai = 0; ai < 2; ++ai)
#pragma unroll
            for (int m = 0; m < 4; ++m) { const int rl = ai * HALF + wr * 64 + m * 16 + fr; const float* rp; float* dp; bool ok = true;
                if (u.pm < 128) { const size_t off = (size_t)(u.pm * BM + rl) * 1024; rp = rr + off; dp = dr + off; } else { ok = rl < 16; rp = rm + (size_t)rl * 1024; dp = dm + (size_t)rl * 1024; }
                if (ok) {
#pragma unroll
                    for (int bj = 0; bj < 2; ++bj)
#pragma unroll
                        for (int n = 0; n < 2; ++n) { const int c = col0 + bj * HALF + n * 16; *(f32x4*)(dp + c) = *(const f32x4*)(rp + c) + acc[ai][bj][m][n]; } } }
    }
};
template <bool RB, bool OB> struct EpiResidP { static constexpr bool PERM = true, AFTER_DRAIN = false;
    const void* rr; void* dr; void* dr2; int split;
    __device__ __forceinline__ void operator()(const f32x4 (&acc)[2][2][4][2], const Unit& u, int wr, int wc, int fr, int fq) const {
        const int row0 = u.pm * BM + wr * 64 + fr; const int col0 = u.pn * 256 + wc * 32 + 8 * fq;
        unsigned char* const dbase = u.pm < split ? (unsigned char*)dr : (unsigned char*)dr2 - (size_t)split * BM * 1024 * (OB ? 2 : 4);
#pragma unroll
        for (int ai = 0; ai < 2; ++ai)
#pragma unroll
            for (int m = 0; m < 4; ++m) { const size_t off = (size_t)(row0 + ai * HALF + m * 16) * 1024 + col0;
#pragma unroll
                for (int bj = 0; bj < 2; ++bj) { f32x4 r0, r1;
                    if constexpr (RB) { const u32x4 w = *(const u32x4*)((const bf16_t*)rr + off + bj * HALF);
                        r0[0] = __uint_as_float(w.x << 16); r0[1] = __uint_as_float(w.x & 0xffff0000u); r0[2] = __uint_as_float(w.y << 16); r0[3] = __uint_as_float(w.y & 0xffff0000u);
                        r1[0] = __uint_as_float(w.z << 16); r1[1] = __uint_as_float(w.z & 0xffff0000u); r1[2] = __uint_as_float(w.w << 16); r1[3] = __uint_as_float(w.w & 0xffff0000u); }
                    else { const float* p_ = (const float*)rr + off + bj * HALF; r0 = *(const f32x4*)p_; r1 = *(const f32x4*)(p_ + 4); }
                    r0 += acc[ai][bj][m][0]; r1 += acc[ai][bj][m][1];
                    if constexpr (OB) *(u32x4*)((bf16_t*)dbase + off + bj * HALF) = pack8(r0, r1);
                    else { float* q_ = (float*)dbase + off + bj * HALF; *(f32x4*)q_ = r0; *(f32x4*)(q_ + 4) = r1; } } }
    }
};
struct EpiSwiglu { static constexpr bool PERM = true, AFTER_DRAIN = false;
    bf16_t* O; int ldc; int nmod; float sc; int out8;
    unsigned char* O2; int split;
    __device__ __forceinline__ void operator()(const f32x4 (&acc)[2][2][4][2], const Unit& u, int wr, int wc, int fr, int fq) const {
        const int row0 = u.pm * BM + wr * 64 + fr; const int col0 = (u.pn % nmod) * 128 + wc * 32 + 8 * fq;
        const float k1_ = -1.4426950408889634f * sc, isc2_ = 1.f / (sc * sc);
        const f32x2 k1v = {k1_, k1_}, iv = {isc2_, isc2_};
#pragma unroll
        for (int ai = 0; ai < 2; ++ai)
#pragma unroll
            for (int m = 0; m < 4; ++m) { f32x4 a[2];
#pragma unroll
                for (int n = 0; n < 2; ++n)
#pragma unroll
                    for (int e = 0; e < 4; e += 2) { const float g0_ = acc[ai][0][m][n][e], g1_ = acc[ai][0][m][n][e + 1], u0_ = acc[ai][1][m][n][e], u1_ = acc[ai][1][m][n][e + 1];
                        const f32x2 G2 = {g0_, g1_}, U2 = {u0_, u1_}; const f32x2 gu = G2 * U2, t2 = G2 * k1v;
                        const f32x2 ex = {__builtin_amdgcn_exp2f(t2.x), __builtin_amdgcn_exp2f(t2.y)}; const f32x2 d2 = ex * iv + iv;
                        const f32x2 rc = {__builtin_amdgcn_rcpf(d2.x), __builtin_amdgcn_rcpf(d2.y)}; const f32x2 o2 = gu * rc; a[n][e] = o2.x; a[n][e + 1] = o2.y; }
                if (out8) { typedef unsigned u32x2 __attribute__((ext_vector_type(2))); u32x2 w8; int t_ = 0; t_ = __builtin_amdgcn_cvt_pk_fp8_f32(a[0][0], a[0][1], t_, false); t_ = __builtin_amdgcn_cvt_pk_fp8_f32(a[0][2], a[0][3], t_, true); w8.x = (unsigned)t_;
                    t_ = 0; t_ = __builtin_amdgcn_cvt_pk_fp8_f32(a[1][0], a[1][1], t_, false); t_ = __builtin_amdgcn_cvt_pk_fp8_f32(a[1][2], a[1][3], t_, true); w8.y = (unsigned)t_;
                    unsigned char* const ob_ = (split != 0 && u.pm >= split) ? O2 - (size_t)split * BM * ldc : (unsigned char*)O;
                    *(u32x2*)(ob_ + (size_t)(row0 + ai * HALF + m * 16) * ldc + col0) = w8; }
                else *(u32x4*)(O + (size_t)(row0 + ai * HALF + m * 16) * ldc + col0) = pack8(a[0], a[1]); }
    }
};
struct EpiSwigluI8 { static constexpr bool PERM = true, AFTER_DRAIN = false;
    bf16_t* O; int ldc; const float* rs; const float* cs;
    __device__ __forceinline__ void prefetch(PG8_LAS unsigned char* lds, const Unit& u, int buf, int wid, int lane) const { i8_scale_prefetch(lds, rs, cs, u.pm, u.pn, buf, wid, lane); }
    __device__ __forceinline__ void operator()(const f32x4 (&acc)[2][2][4][2], const Unit& u, int wr, int wc, int fr, int fq, const PG8_LAS unsigned char* sc) const {
        const int row0 = u.pm * BM + wr * 64 + fr; const int col0 = u.pn * 128 + wc * 32 + 8 * fq; const PG8_LAS float* sl = (const PG8_LAS float*)sc;
        const PG8_LAS float* cp = sl + 256 + wc * 32 + 8 * fq;
        f32x4 cg[2], cu[2]; cg[0] = *(const PG8_LAS f32x4*)cp; cg[1] = *(const PG8_LAS f32x4*)(cp + 4); cu[0] = *(const PG8_LAS f32x4*)(cp + 128); cu[1] = *(const PG8_LAS f32x4*)(cp + 132);
        f32x4 c1[2], icgu[2];
#pragma unroll
        for (int n = 0; n < 2; ++n)
#pragma unroll
            for (int e = 0; e < 4; ++e) { c1[n][e] = -1.4426950408889634f * cg[n][e]; icgu[n][e] = __builtin_amdgcn_rcpf(cg[n][e] * cu[n][e]); }
#pragma unroll
        for (int ai = 0; ai < 2; ++ai)
#pragma unroll
            for (int m = 0; m < 4; ++m) { f32x4 a[2]; const int row = row0 + ai * HALF + m * 16; const float r = sl[wr * 64 + fr + ai * HALF + m * 16]; const float ir2 = __builtin_amdgcn_rcpf(r * r); const f32x2 rv = {r, r}, ir2v = {ir2, ir2};
#pragma unroll
                for (int n = 0; n < 2; ++n)
#pragma unroll
                    for (int e = 0; e < 4; e += 2) { const float gf0 = acc[ai][0][m][n][e], gf1 = acc[ai][0][m][n][e + 1], uf0 = acc[ai][1][m][n][e], uf1 = acc[ai][1][m][n][e + 1];
                        const f32x2 G2 = {(float)__float_as_int(gf0), (float)__float_as_int(gf1)}, U2 = {(float)__float_as_int(uf0), (float)__float_as_int(uf1)};
                        const f32x2 c2 = {c1[n][e], c1[n][e + 1]}, ic2 = {icgu[n][e], icgu[n][e + 1]};
                        const f32x2 is2 = ir2v * ic2, gu = G2 * U2, t2 = G2 * (rv * c2);
                        const f32x2 ex = {__builtin_amdgcn_exp2f(t2.x), __builtin_amdgcn_exp2f(t2.y)}; const f32x2 d2 = ex * is2 + is2;
                        const f32x2 rc = {__builtin_amdgcn_rcpf(d2.x), __builtin_amdgcn_rcpf(d2.y)}; const f32x2 o2 = gu * rc; a[n][e] = o2.x; a[n][e + 1] = o2.y; }
                *(u32x4*)(O + (size_t)row * ldc + col0) = pack8(a[0], a[1]); }
    }
};
struct MoeOrder { StaticOrder so; int tb1, tb2, tb3, tb4, tb5, tb6, tb7; int t0; int nper;
    __device__ __forceinline__ bool next(int i, Unit& u) const { if (!so.next(i, u)) return false; const int T = t0 + u.pm;
        const int e = (T >= tb1) + (T >= tb2) + (T >= tb3) + (T >= tb4) + (T >= tb5) + (T >= tb6) + (T >= tb7); u.pn += e * nper; return true; }
    __device__ __forceinline__ void a_ready(const Unit&) const {}
    __device__ __forceinline__ void done(const Unit&) const {}
    __device__ __forceinline__ int kshift(const Unit&) const { return 0; }
    const int* glist;
    __device__ __forceinline__ const int* gbase(const Unit& u) const { const int T = t0 + u.pm;
        const int e = (T >= tb1) + (T >= tb2) + (T >= tb3) + (T >= tb4) + (T >= tb5) + (T >= tb6) + (T >= tb7);
        const int tbe = e == 0 ? 0 : e == 1 ? tb1 : e == 2 ? tb2 : e == 3 ? tb3 : e == 4 ? tb4 : e == 5 ? tb5 : e == 6 ? tb6 : tb7;
        return glist + e * 32768 + (T - tbe) * 256; }
};
struct UqkvOrder { StaticOrder so;
    __device__ __forceinline__ bool next(int i, Unit& u) const { return so.next(i, u); }
    __device__ __forceinline__ void a_ready(const Unit&) const {}
    __device__ __forceinline__ void done(const Unit&) const {}
    __device__ __forceinline__ int kshift(const Unit& u) const { return u.pn >= 3 ? 256 : 0; }
};
}
#define GAS __attribute__((address_space(1)))
#define LAS __attribute__((address_space(3)))
typedef unsigned short bf16;
typedef unsigned v4u __attribute__((ext_vector_type(4)));
typedef float f32x4 __attribute__((ext_vector_type(4)));
typedef short bf16x8 __attribute__((ext_vector_type(8)));
typedef GAS unsigned gu32;
typedef GAS unsigned long long gu64;
#define RLX_AGENT __ATOMIC_RELAXED, __HIP_MEMORY_SCOPE_AGENT
#define LDS_WAIT() asm volatile("s_waitcnt lgkmcnt(0)" ::: "memory")
#define VM_WAIT() asm volatile("s_waitcnt vmcnt(0)" ::: "memory")
__device__ __forceinline__ unsigned long long rt() { return __builtin_amdgcn_s_memrealtime(); }
__device__ __forceinline__ unsigned f2bf(float f) { unsigned u = __builtin_bit_cast(unsigned, f); return (u + 0x7fffu + ((u >> 16) & 1u)) >> 16; }
__device__ __forceinline__ unsigned pk2(float lo, float hi) { return f2bf(lo) | (f2bf(hi) << 16); }

#define XB_TMO      128
#define XB_XCNT(j)  (256  + 64 * (j))
#define XB_XSUB(j)  (1280 + 64 * (j))
#define XB_XGEN(j)  (2304 + 64 * (j))
#define XB_TOP      3328
#define XB_TOPGEN   3392
#define XCD_BAR_WORDS 3456
#define XB_SPIN_CAP (1u << 18)

__device__ __forceinline__ unsigned xb_ld(unsigned* p)              { return __hip_atomic_load(p, __ATOMIC_RELAXED, __HIP_MEMORY_SCOPE_AGENT); }
__device__ __forceinline__ unsigned xb_add(unsigned* p, unsigned v) { return __hip_atomic_fetch_add(p, v, __ATOMIC_RELAXED, __HIP_MEMORY_SCOPE_AGENT); }
__device__ __forceinline__ unsigned xb_xcc_id() { return (unsigned)__builtin_amdgcn_s_getreg((3 << 11) | 20) & 0xFu; }
#define XB_SPIN(cond, bar) do { unsigned _sp = 0; while (cond) { __builtin_amdgcn_s_sleep(1); \
    if ((++_sp & 255u) == 0u) { if (xb_ld(&(bar)[XB_TMO])) break; if (_sp > XB_SPIN_CAP) { atomicAdd(&(bar)[XB_TMO], 1u); break; } } } } while (0)

struct XcdBarrier {
    unsigned* bar; unsigned x;
    volatile LAS unsigned* st;
};

__device__ __forceinline__ XcdBarrier xcd_barrier_post(unsigned* bar, volatile LAS unsigned* st) {
    XcdBarrier b; b.bar = bar; b.x = xb_xcc_id(); b.st = st;
    if (threadIdx.x == 0) (void)xb_add(&bar[XB_XCNT(b.x)], 1u);
    return b;
}
__device__ __forceinline__ void xcd_barrier_complete(unsigned* bar, unsigned x, unsigned& nloc, unsigned& nx) {
    const unsigned G = gridDim.x * gridDim.y * gridDim.z;
    unsigned sum, cnt, mine, sp = 0u;
    for (;;) {
        sum = 0u; cnt = 0u; mine = 0u;
#pragma unroll
        for (unsigned j = 0; j < 16; ++j) { const unsigned c = xb_ld(&bar[XB_XCNT(j)]); sum += c; cnt += (c > 0u) ? 1u : 0u; mine = (j == x) ? c : mine; }
        if (sum == G) break;
        __builtin_amdgcn_s_sleep(1);
        if ((++sp & 255u) == 0u) { if (xb_ld(&bar[XB_TMO])) break; if (sp > XB_SPIN_CAP) { atomicAdd(&bar[XB_TMO], 1u); break; } }
    }
    nloc = mine > 0u ? mine : 1u; nx = cnt > 0u ? cnt : 1u;
}

__device__ __forceinline__ void xcd_barrier(const XcdBarrier& b) {
    asm volatile("s_waitcnt vmcnt(0)" ::: "memory");
    __syncthreads();
    if (threadIdx.x == 0) {
        unsigned* bar = b.bar;
        __builtin_amdgcn_s_waitcnt(0);
        unsigned nloc = b.st[0], nx = b.st[1];
        if (nloc == 0u) { xcd_barrier_complete(bar, b.x, nloc, nx); b.st[0] = nloc; b.st[1] = nx; }
        const unsigned old = xb_add(&bar[XB_XSUB(b.x)], 1u);
        const unsigned gen = old / nloc;
        if (old + 1u == (gen + 1u) * nloc) {
            __builtin_amdgcn_fence(__ATOMIC_RELEASE, "agent");
            asm volatile("s_waitcnt vmcnt(0)" ::: "memory");
            const unsigned og = xb_add(&bar[XB_TOP], 1u);
            const unsigned tg = og / nx;
            if (og + 1u == (tg + 1u) * nx) xb_add(&bar[XB_TOPGEN], 1u);
            else XB_SPIN(xb_ld(&bar[XB_TOPGEN]) == tg, bar);
            __builtin_amdgcn_fence(__ATOMIC_ACQUIRE, "agent");
            xb_add(&bar[XB_XGEN(b.x)], 1u);
            asm volatile("s_waitcnt vmcnt(0)" ::: "memory");
        } else {
            XB_SPIN(xb_ld(&bar[XB_XGEN(b.x)]) == gen, bar);
            __builtin_amdgcn_fence(__ATOMIC_ACQUIRE, "agent");
            asm volatile("s_waitcnt vmcnt(0)" ::: "memory");
        }
    }
    __syncthreads();
}
typedef unsigned short bf16;
typedef unsigned v4u __attribute__((ext_vector_type(4)));
typedef unsigned v2u __attribute__((ext_vector_type(2)));
typedef float f32x4 __attribute__((ext_vector_type(4)));
typedef float f32x16 __attribute__((ext_vector_type(16)));
typedef short bf16x8 __attribute__((ext_vector_type(8)));
typedef short s16x4 __attribute__((ext_vector_type(4)));
using pg8::pk2bf;
using pg8::row_pos;

constexpr int NWAVES = 8;
constexpr int DM = 1024, NB = 8, SEQ = 4096, NTOK = NB * SEQ  , MR = NTOK + 256  , META0 = NTOK;
constexpr float EPS = 1e-6f, LOG2E = 1.4426950408889634f, LN2 = 0.6931471805599453f;
constexpr int DFF = 2816, DFE = 3584, NEXP = 8;
constexpr int MOE_ROWS = 264 * 256, MOE_CT = 264  , MOE_NCHUNK = 1, MOE_CT_MAX = 264, ACT_SPLIT = 136  ;

constexpr size_t MiB = 1u << 20;
constexpr size_t WS_CTL = 0, CTL_ZERO_BYTES = 2 * MiB;
constexpr int CW_BAR = 4096;
constexpr int CW_CNT = 16384;
constexpr int CW_KN = 40000;
constexpr int FOX_FLAG_OFF = 49152;
constexpr size_t WS_COSM = 5 * MiB + 128 * 1024, WS_SINM = WS_COSM + 4352 * 16 * 4, WS_COSD = WS_SINM + 4352 * 16 * 4, WS_SIND = WS_COSD + 4352 * 8 * 4;
constexpr size_t WS_HMETA = 2 * MiB;
constexpr size_t WS_CFOX = 3 * MiB;
constexpr size_t WS_CMETA = 4 * MiB;
constexpr size_t WS_LF = 4 * MiB + 65536;
constexpr size_t WS_TOK = 6 * MiB;
constexpr size_t WS_WIN0 = 8 * MiB, WS_WUQKV = 12 * MiB, WS_WOUT0 = 13 * MiB + 512 * 1024, WS_WGU0 = 15 * MiB + 512 * 1024, WS_WDN0 = 26 * MiB + 512 * 1024, WS_WIN1 = 32 * MiB, WS_WOUT1 = 38 * MiB;
constexpr size_t WS_HN = 40 * MiB;
constexpr size_t WS_R = 104 * MiB + 512 * 1024;
constexpr size_t WS_SB = WS_R, WS_CM = WS_SB + (size_t)MR * 1536 * 2, WS_CQKV = WS_CM + (size_t)MR * 512 * 2;
constexpr size_t WS_ACT0 = WS_R, WS_PROJ1 = WS_R;
constexpr size_t WS_XS8 = 166 * MiB;
constexpr size_t WS_Y = 247 * MiB;
constexpr size_t WS_YP = 198 * MiB; constexpr int YP_SPLIT = 7;
constexpr size_t WS_ACTC = 40 * MiB;
constexpr size_t WS_WM = 380 * MiB, WS_WMG = WS_WM  , WS_WMD = WS_WM + (size_t)NEXP * 7168 * 1024  ;
constexpr float WMG_SCALE = 64.f;
constexpr size_t WS_QMLA = 258 * MiB, WS_KC = 307 * MiB, WS_VC = WS_CM;
constexpr size_t WS_CSC = 6 * MiB + 512 * 1024;
constexpr size_t WS_RSC = 6 * MiB + 640 * 1024;
constexpr size_t WS_WGU0Q = 494 * MiB;
constexpr size_t WS_CMAXP = 510 * MiB; constexpr int CMAX_LD = 5632;
constexpr size_t WS_CMAXP0 = 511 * MiB + 512 * 1024, WS_CSC0 = 6 * MiB + 560 * 1024, WS_WIN0Q = 504 * MiB;
constexpr size_t WS_CMAXP1 = 511 * MiB, WS_CSC1 = 6 * MiB + 544 * 1024, WS_WIN1Q = 500 * MiB;
constexpr size_t WS_H16 = 300 * MiB;
constexpr size_t WS_H3A = 464 * MiB, WS_H3B = 160 * MiB; constexpr int H3_SPLIT = 31744;
constexpr size_t WS_ELIST = 1 * MiB;
constexpr size_t WS_END = 526 * MiB;
static_assert(WS_CQKV + (size_t)MR * 384 * 2 <= WS_WM && WS_ACT0 + (size_t)MR * DFF * 2 <= WS_WM && WS_PROJ1 + (size_t)MR * 3072 * 2 <= WS_WM, "R region");
static_assert(WS_ACTC + (size_t)ACT_SPLIT * 256 * DFE <= WS_H3B && (size_t)(MOE_CT_MAX - ACT_SPLIT) * 256 * DFE <= (size_t)NTOK * DM * 4 && WS_Y + (size_t)MOE_ROWS * 1024 * 2 <= WS_WM, "MoE buffers");
static_assert(WS_XS8 + (size_t)NTOK * 1024 <= WS_YP && WS_YP + (size_t)YP_SPLIT * 7 * 256 * 1024 * 2 <= WS_Y, "YP");
static_assert(WS_CQKV + (size_t)MR * 384 * 2 <= WS_QMLA && WS_QMLA + (size_t)MR * 768 * 2 <= WS_KC && WS_KC + (size_t)MR * 768 * 2 <= WS_WM && WS_WMD + (size_t)NEXP * 1024 * DFE * 2 <= WS_END, "tail region");
static_assert(WS_WOUT1 + 2 * MiB <= WS_HN && WS_HN + (size_t)MR * 1024 * 2 <= WS_R && WS_SIND + 4352 * 8 * 4 <= WS_TOK && WS_LF + (size_t)MR * 32 <= WS_COSM && WS_LF + (size_t)MR * 32 <= WS_TOK, "head region");

constexpr int RING_OFF = 0, RING_BYTES = 131072, LDSCTL_OFF = RING_BYTES, MISC_OFF = LDSCTL_OFF + 320, LDS_BYTES = 147456;

__device__ __forceinline__ float wave_sum(float v) {
#pragma unroll
    for (int o = 1; o < 64; o <<= 1) v += __shfl_xor(v, o);
    return v;
}
__device__ __forceinline__ float bf2f(unsigned b) { return __uint_as_float(b << 16); }
__device__ __forceinline__ unsigned pk4fp8(float a, float b, float c, float d) { int w = 0; w = __builtin_amdgcn_cvt_pk_fp8_f32(a, b, w, false); w = __builtin_amdgcn_cvt_pk_fp8_f32(c, d, w, true); return (unsigned)w; }
#define LDS_WAIT() asm volatile("s_waitcnt lgkmcnt(0)" ::: "memory")

struct Frame {
    LAS unsigned char* lds;
    unsigned* ctl;
    unsigned char* ws;
    int tid, lane, wave, vcu, G;
};

__device__ __forceinline__ void tr_item(const float* W, int ldw, int ncol0, bf16* WT, int Kd, int koff, int drow0, float scale, LAS float* scr, int k0, int n0, int lane) {
    const int rg = lane >> 3, c4 = lane & 7; f32x4 v[8];
#pragma unroll
    for (int i = 0; i < 8; ++i) v[i] = *(const GAS f32x4*)(W + (size_t)(k0 + 8 * i + rg) * ldw + ncol0 + n0 + 4 * c4);
#pragma unroll
    for (int i = 0; i < 8; ++i) { LAS float* d = scr + (8 * i + rg) * 33 + 4 * c4; d[0] = v[i].x * scale; d[1] = v[i].y * scale; d[2] = v[i].z * scale; d[3] = v[i].w * scale; }
    LDS_WAIT(); asm volatile("" ::: "memory");
    const int c = lane & 7;
#pragma unroll
    for (int j = 0; j < 4; ++j) { const int n = (lane >> 3) + 8 * j; const LAS float* s = scr + (8 * c) * 33 + n;
        v4u o; o.x = pk2bf(s[0 * 33], s[1 * 33]); o.y = pk2bf(s[2 * 33], s[3 * 33]); o.z = pk2bf(s[4 * 33], s[5 * 33]); o.w = pk2bf(s[6 * 33], s[7 * 33]);
        *(GAS v4u*)(WT + (size_t)(drow0 + n) * Kd + koff + k0 + 8 * c) = o; }
    LDS_WAIT(); asm volatile("" ::: "memory");
}
__device__ __forceinline__ void tr_load(const float* W, int ldw, int k0, int n0, int lane, f32x4 (&v)[8]) {
    const int rg = lane >> 3, c4 = lane & 7;
#pragma unroll
    for (int i = 0; i < 8; ++i) v[i] = *(const GAS f32x4*)(W + (size_t)(k0 + 8 * i + rg) * ldw + n0 + 4 * c4);
}
__device__ __forceinline__ void tr_finish(const f32x4 (&v)[8], bf16* WT, int Kd, int drow0, int k0, LAS float* scr, int lane, bool fp8 = false) {
    const int rg = lane >> 3, c4 = lane & 7;
#pragma unroll
    for (int i = 0; i < 8; ++i) { LAS float* d = scr + (8 * i + rg) * 33 + 4 * c4; d[0] = v[i].x; d[1] = v[i].y; d[2] = v[i].z; d[3] = v[i].w; }
    LDS_WAIT(); asm volatile("" ::: "memory");
    const int c = lane & 7;
#pragma unroll
    for (int j = 0; j < 4; ++j) { const int n = (lane >> 3) + 8 * j; const LAS float* s = scr + (8 * c) * 33 + n;
        v4u o; o.x = pk2bf(s[0 * 33], s[1 * 33]); o.y = pk2bf(s[2 * 33], s[3 * 33]); o.z = pk2bf(s[4 * 33], s[5 * 33]); o.w = pk2bf(s[6 * 33], s[7 * 33]);
        if (fp8) { v2u o8; o8.x = pk4fp8(s[0 * 33] * WMG_SCALE, s[1 * 33] * WMG_SCALE, s[2 * 33] * WMG_SCALE, s[3 * 33] * WMG_SCALE); o8.y = pk4fp8(s[4 * 33] * WMG_SCALE, s[5 * 33] * WMG_SCALE, s[6 * 33] * WMG_SCALE, s[7 * 33] * WMG_SCALE);
            *(GAS v2u*)((unsigned char*)WT + (size_t)(drow0 + n) * Kd + k0 + 8 * c) = o8; }
        else *(GAS v4u*)(WT + (size_t)(drow0 + n) * Kd + k0 + 8 * c) = o; }
    LDS_WAIT(); asm volatile("" ::: "memory");
}
__device__ __forceinline__ unsigned pk4i8(float a, float b, float c, float d) { const int x = __float2int_rn(a), y = __float2int_rn(b), z = __float2int_rn(c), w = __float2int_rn(d);
    return __builtin_amdgcn_perm((unsigned)y, (unsigned)x, 0x0c0c0400u) | __builtin_amdgcn_perm((unsigned)w, (unsigned)z, 0x04000c0cu); }
__device__ __forceinline__ void colmax_job(const float* W, int ldw, int ncols, int cb, int kc, float* cmax, int cld, int mapup, int lane) {
    const int c = 256 * cb + 4 * lane; if (c >= ncols) return; const GAS f32x4* p = (const GAS f32x4*)(W + (size_t)(32 * kc) * ldw + c); f32x4 m = {0.f, 0.f, 0.f, 0.f};
    f32x4 vv[32];
#pragma unroll
    for (int k = 0; k < 32; ++k) vv[k] = *(const GAS f32x4*)((const GAS float*)p + (size_t)k * ldw);
#pragma unroll
    for (int k = 0; k < 32; ++k) { const f32x4 v = vv[k]; m.x = fmaxf(m.x, fabsf(v.x)); m.y = fmaxf(m.y, fabsf(v.y)); m.z = fmaxf(m.z, fabsf(v.z)); m.w = fmaxf(m.w, fabsf(v.w)); }
    *(GAS f32x4*)(cmax + (size_t)kc * cld + (mapup < 0 ? c : mapup + 256 * (c / 128) + (c % 128))) = m;
}
__device__ __forceinline__ void tr_item_q8(const float* W, int ldw, unsigned char* WT8, int Kd, int drow0, const float* cmax, int cld, float* cs, float csmul, LAS float* scr, int k0, int n0, int lane) {
    const int rg = lane >> 3, c4 = lane & 7; f32x4 v[8];
#pragma unroll
    for (int i = 0; i < 8; ++i) v[i] = *(const GAS f32x4*)(W + (size_t)(k0 + 8 * i + rg) * ldw + n0 + 4 * c4);
#pragma unroll
    for (int i = 0; i < 8; ++i) { LAS float* d = scr + (8 * i + rg) * 33 + 4 * c4; d[0] = v[i].x; d[1] = v[i].y; d[2] = v[i].z; d[3] = v[i].w; }
    LDS_WAIT(); asm volatile("" ::: "memory");
    const int c = lane & 7;
#pragma unroll
    for (int j = 0; j < 4; ++j) { const int n = (lane >> 3) + 8 * j; const LAS float* s = scr + (8 * c) * 33 + n;
        float mx = fmaxf(fmaxf(cmax[(size_t)(4 * c) * cld + drow0 + n], cmax[(size_t)(4 * c + 1) * cld + drow0 + n]), fmaxf(cmax[(size_t)(4 * c + 2) * cld + drow0 + n], cmax[(size_t)(4 * c + 3) * cld + drow0 + n]));
        mx = fmaxf(mx, __shfl_xor(mx, 1)); mx = fmaxf(mx, __shfl_xor(mx, 2)); mx = fmaxf(mx, __shfl_xor(mx, 4));
        const float inv = mx > 0.f ? 127.f / mx : 0.f;
        v2u o8; o8.x = pk4i8(s[0 * 33] * inv, s[1 * 33] * inv, s[2 * 33] * inv, s[3 * 33] * inv); o8.y = pk4i8(s[4 * 33] * inv, s[5 * 33] * inv, s[6 * 33] * inv, s[7 * 33] * inv);
        *(GAS v2u*)(WT8 + (size_t)(drow0 + n) * Kd + k0 + 8 * c) = o8;
        if (k0 == 0 && c == 0) cs[drow0 + n] = mx * (1.f / 127.f) * csmul; }
    LDS_WAIT(); asm volatile("" ::: "memory");
}
constexpr int MOE_CONV_PER = 1792, MOE_CONV_ITEMS = NEXP * 3 * MOE_CONV_PER;
struct MoeConv { const float* wg; const float* wu; const float* wd; bf16* dg; bf16* dd; };
struct ConvItem { const float* W; bf16* WT; int ldw, Kd, drow0, k0, n0; bool fp8; };
__device__ __forceinline__ ConvItem moe_conv_item(int it, const MoeConv& C) {
    ConvItem r; const int e = it / (3 * MOE_CONV_PER), rr = it % (3 * MOE_CONV_PER), kind = rr / MOE_CONV_PER, j = rr % MOE_CONV_PER;
    r.fp8 = true;
    if (kind < 2) { r.W = (kind == 0 ? C.wg : C.wu) + (size_t)e * 1024 * DFE; r.ldw = DFE; r.WT = (bf16*)((unsigned char*)C.dg + (size_t)e * 7168 * 1024); r.Kd = 1024;   const int kb = j / (DFE / 32), nb = j % (DFE / 32);
        r.n0 = nb * 32; r.k0 = kb * 64; r.drow0 = (kind == 1 ? 128 : 0) + 256 * (r.n0 / 128) + (r.n0 % 128); }
    else { r.W = C.wd + (size_t)e * DFE * 1024; r.ldw = 1024; r.WT = (bf16*)((unsigned char*)C.dd + (size_t)e * 1024 * DFE); r.Kd = DFE;   const int kb = j / 32, nb = j % 32; r.n0 = nb * 32; r.k0 = kb * 64; r.drow0 = r.n0; }
    return r;
}
template <int MAP> __device__ __forceinline__ void tr_job(int it, const float* W, int K, int ldw, int c0, int nc, bf16* WT, int Kd, int koff, int rbase, float scale, LAS float* scr, int lane) {
    const int nblk = nc / 32, kb = it / nblk, nb = it % nblk, n0 = nb * 32;
    const int drow0 = MAP == 0 ? rbase + n0 : rbase + 256 * (n0 / 128) + (n0 % 128);
    tr_item(W, ldw, c0, WT, Kd, koff, drow0, scale, scr, kb * 64, n0, lane);
}

__device__ __forceinline__ void rms_row(const float* xrow, const float* g, bf16* orow, int lane, f32x4 (&v)[4]) {
    const GAS f32x4* xr = (const GAS f32x4*)xrow + lane; float s = 0.f;
#pragma unroll
    for (int j = 0; j < 4; ++j) { v[j] = xr[64 * j]; s += (v[j].x * v[j].x + v[j].y * v[j].y) + (v[j].z * v[j].z + v[j].w * v[j].w); }
    const float rstd = 1.f / sqrtf(wave_sum(s) * (1.f / 1024.f) + EPS);
    GAS v2u* o8 = (GAS v2u*)orow + lane;
#pragma unroll
    for (int j = 0; j < 4; ++j) { const f32x4 gg = *((const GAS f32x4*)g + lane + 64 * j); v[j] = v[j] * rstd * gg; v2u w; w.x = pk2bf(v[j].x, v[j].y); w.y = pk2bf(v[j].z, v[j].w); o8[64 * j] = w; }
}
__device__ __forceinline__ void rms_row_q(const float* xrow, const float* g, bf16* orow, unsigned char* o8, float* rs, int lane, f32x4 (&v)[4]) {
    rms_row(xrow, g, orow, lane, v); float m = 0.f;
#pragma unroll
    for (int j = 0; j < 4; ++j) m = fmaxf(fmaxf(m, fmaxf(fabsf(v[j].x), fabsf(v[j].y))), fmaxf(fabsf(v[j].z), fabsf(v[j].w)));
#pragma unroll
    for (int o = 1; o < 64; o <<= 1) m = fmaxf(m, __shfl_xor(m, o));
    const float inv = m > 0.f ? 127.f / m : 0.f; GAS unsigned* q = (GAS unsigned*)o8 + lane;
#pragma unroll
    for (int j = 0; j < 4; ++j) q[64 * j] = pk4i8(v[j].x * inv, v[j].y * inv, v[j].z * inv, v[j].w * inv);
    if (lane == 0) *rs = m * (1.f / 127.f);
}
__device__ __forceinline__ void rms_row2(const float* xa, const float* xb, const float* g, bf16* oa, bf16* ob, int lane, f32x4 (&va)[4], f32x4 (&vb)[4]) {
    const GAS f32x4* pa = (const GAS f32x4*)xa + lane; const GAS f32x4* pb = (const GAS f32x4*)xb + lane; float sa = 0.f, sb = 0.f;
#pragma unroll
    for (int j = 0; j < 4; ++j) { va[j] = pa[64 * j]; vb[j] = pb[64 * j]; }
#pragma unroll
    for (int j = 0; j < 4; ++j) { sa += (va[j].x * va[j].x + va[j].y * va[j].y) + (va[j].z * va[j].z + va[j].w * va[j].w); sb += (vb[j].x * vb[j].x + vb[j].y * vb[j].y) + (vb[j].z * vb[j].z + vb[j].w * vb[j].w); }
#pragma unroll
    for (int o = 1; o < 64; o <<= 1) { sa += __shfl_xor(sa, o); sb += __shfl_xor(sb, o); }
    const float ra = 1.f / sqrtf(sa * (1.f / 1024.f) + EPS), rb = 1.f / sqrtf(sb * (1.f / 1024.f) + EPS);
    GAS v2u* qa = (GAS v2u*)oa + lane; GAS v2u* qb = (GAS v2u*)ob + lane;
#pragma unroll
    for (int j = 0; j < 4; ++j) { const f32x4 gg = *((const GAS f32x4*)g + lane + 64 * j); va[j] = va[j] * ra * gg; vb[j] = vb[j] * rb * gg;
        v2u w; w.x = pk2bf(va[j].x, va[j].y); w.y = pk2bf(va[j].z, va[j].w); qa[64 * j] = w; w.x = pk2bf(vb[j].x, vb[j].y); w.y = pk2bf(vb[j].z, vb[j].w); qb[64 * j] = w; }
}
template <bool XB> struct RowRaw;
template <> struct RowRaw<true> { v2u w[4]; };
template <> struct RowRaw<false> { f32x4 w[4]; };
template <bool XB> __device__ __forceinline__ void row_raw_load(const void* x, int lane, RowRaw<XB>& r) {
    if constexpr (XB) { const GAS v2u* p_ = (const GAS v2u*)x + lane;
#pragma unroll
        for (int j = 0; j < 4; ++j) r.w[j] = p_[64 * j]; }
    else { const GAS f32x4* p_ = (const GAS f32x4*)x + lane;
#pragma unroll
        for (int j = 0; j < 4; ++j) r.w[j] = p_[64 * j]; }
}
template <bool XB> __device__ __forceinline__ void row_raw_cvt(const RowRaw<XB>& r, f32x4 (&v)[4]) {
#pragma unroll
    for (int j = 0; j < 4; ++j) { if constexpr (XB) { v[j].x = __uint_as_float(r.w[j].x << 16); v[j].y = __uint_as_float(r.w[j].x & 0xffff0000u); v[j].z = __uint_as_float(r.w[j].y << 16); v[j].w = __uint_as_float(r.w[j].y & 0xffff0000u); } else v[j] = r.w[j]; }
}
__device__ __forceinline__ const bf16* h3row(const unsigned char* ws, int row) { return row < H3_SPLIT ? (const bf16*)(ws + WS_H3A) + (size_t)row * DM : (const bf16*)(ws + WS_H3B) + (size_t)(row - H3_SPLIT) * DM; }
template <bool XB = false>
__device__ __forceinline__ void rms_row2_f8(const RowRaw<XB>& xa, const RowRaw<XB>& xb, const float* g, unsigned char* oa, unsigned char* ob, int lane, f32x4 (&va)[4], f32x4 (&vb)[4]) {
    float sa = 0.f, sb = 0.f; row_raw_cvt<XB>(xa, va); row_raw_cvt<XB>(xb, vb);
#pragma unroll
    for (int j = 0; j < 4; ++j) { sa += (va[j].x * va[j].x + va[j].y * va[j].y) + (va[j].z * va[j].z + va[j].w * va[j].w); sb += (vb[j].x * vb[j].x + vb[j].y * vb[j].y) + (vb[j].z * vb[j].z + vb[j].w * vb[j].w); }
#pragma unroll
    for (int o = 1; o < 64; o <<= 1) { sa += __shfl_xor(sa, o); sb += __shfl_xor(sb, o); }
    const float ra = 1.f / sqrtf(sa * (1.f / 1024.f) + EPS), rb = 1.f / sqrtf(sb * (1.f / 1024.f) + EPS);
    GAS unsigned* qa = (GAS unsigned*)oa + lane; GAS unsigned* qb = (GAS unsigned*)ob + lane;
#pragma unroll
    for (int j = 0; j < 4; ++j) { const f32x4 gg = *((const GAS f32x4*)g + lane + 64 * j); va[j] = va[j] * ra * gg; vb[j] = vb[j] * rb * gg;
        qa[64 * j] = pk4fp8(va[j].x, va[j].y, va[j].z, va[j].w); qb[64 * j] = pk4fp8(vb[j].x, vb[j].y, vb[j].z, vb[j].w); }
}
template <bool XB = false>
__device__ __forceinline__ void rms_row2_i8(const RowRaw<XB>& xa, const RowRaw<XB>& xb, const float* g, unsigned char* oa, unsigned char* ob, float* rsa, float* rsb, int lane, f32x4 (&va)[4], f32x4 (&vb)[4]) {
    float sa = 0.f, sb = 0.f; row_raw_cvt<XB>(xa, va); row_raw_cvt<XB>(xb, vb);
#pragma unroll
    for (int j = 0; j < 4; ++j) { sa += (va[j].x * va[j].x + va[j].y * va[j].y) + (va[j].z * va[j].z + va[j].w * va[j].w); sb += (vb[j].x * vb[j].x + vb[j].y * vb[j].y) + (vb[j].z * vb[j].z + vb[j].w * vb[j].w); }
#pragma unroll
    for (int o = 1; o < 64; o <<= 1) { sa += __shfl_xor(sa, o); sb += __shfl_xor(sb, o); }
    const float ra = 1.f / sqrtf(sa * (1.f / 1024.f) + EPS), rb = 1.f / sqrtf(sb * (1.f / 1024.f) + EPS);
    float ma = 0.f, mb = 0.f;
#pragma unroll
    for (int j = 0; j < 4; ++j) { const f32x4 gg = *((const GAS f32x4*)g + lane + 64 * j); va[j] = va[j] * ra * gg; vb[j] = vb[j] * rb * gg;
        ma = fmaxf(fmaxf(ma, fmaxf(fabsf(va[j].x), fabsf(va[j].y))), fmaxf(fabsf(va[j].z), fabsf(va[j].w))); mb = fmaxf(fmaxf(mb, fmaxf(fabsf(vb[j].x), fabsf(vb[j].y))), fmaxf(fabsf(vb[j].z), fabsf(vb[j].w))); }
#pragma unroll
    for (int o = 1; o < 64; o <<= 1) { ma = fmaxf(ma, __shfl_xor(ma, o)); mb = fmaxf(mb, __shfl_xor(mb, o)); }
    const float ia = ma > 0.f ? 127.f / ma : 0.f, ib = mb > 0.f ? 127.f / mb : 0.f;
    GAS unsigned* qa = (GAS unsigned*)oa + lane; GAS unsigned* qb = (GAS unsigned*)ob + lane;
#pragma unroll
    for (int j = 0; j < 4; ++j) { qa[64 * j] = pk4i8(va[j].x * ia, va[j].y * ia, va[j].z * ia, va[j].w * ia); qb[64 * j] = pk4i8(vb[j].x * ib, vb[j].y * ib, vb[j].z * ib, vb[j].w * ib); }
    if (lane == 0) { *rsa = ma * (1.f / 127.f); *rsb = mb * (1.f / 127.f); }
}
__device__ __forceinline__ void zero_row(bf16* orow, int lane) {
    GAS v2u* o8 = (GAS v2u*)orow + lane; const v2u z = {0u, 0u};
#pragma unroll
    for (int j = 0; j < 4; ++j) o8[64 * j] = z;
}
__device__ __forceinline__ void row_dot8(const f32x4 (&v)[4], const LAS float* wl, int lane, float (&d)[8]) {
#pragma unroll
    for (int e = 0; e < 8; ++e) d[e] = 0.f;
#pragma unroll
    for (int j = 0; j < 4; ++j)
#pragma unroll
        for (int t = 0; t < 4; ++t) { const int c = 4 * lane + 256 * j + t; const LAS f32x4* wp = (const LAS f32x4*)(wl + c * 8); const f32x4 w0 = wp[0], w1 = wp[1]; const float x = v[j][t];
            d[0] += x * w0.x; d[1] += x * w0.y; d[2] += x * w0.z; d[3] += x * w0.w; d[4] += x * w1.x; d[5] += x * w1.y; d[6] += x * w1.z; d[7] += x * w1.w; }
#pragma unroll
    for (int e = 0; e < 8; ++e) d[e] = wave_sum(d[e]);
}

struct W8 { f32x4 w[4][4][2]; };
__device__ __forceinline__ void w8_load(W8& W, const float* base, int pitch, int lane) {
#pragma unroll
    for (int j = 0; j < 4; ++j)
#pragma unroll
        for (int t = 0; t < 4; ++t) { const float* p_ = base + (size_t)(4 * lane + 256 * j + t) * pitch; W.w[j][t][0] = *(const GAS f32x4*)p_; W.w[j][t][1] = *(const GAS f32x4*)(p_ + 4); }
}
__device__ __forceinline__ float dot8_reduce(const f32x4 (&v)[4], const W8& W, int lane) {
    float d[8];
#pragma unroll
    for (int e = 0; e < 8; ++e) d[e] = 0.f;
#pragma unroll
    for (int j = 0; j < 4; ++j)
#pragma unroll
        for (int t = 0; t < 4; ++t) { const f32x4 w0 = W.w[j][t][0], w1 = W.w[j][t][1]; const float x = v[j][t];
            d[0] += x * w0.x; d[1] += x * w0.y; d[2] += x * w0.z; d[3] += x * w0.w; d[4] += x * w1.x; d[5] += x * w1.y; d[6] += x * w1.z; d[7] += x * w1.w; }
    const bool b0 = (lane & 1) != 0, b1 = (lane & 2) != 0, b2 = (lane & 4) != 0; float a[4], b[2];
#pragma unroll
    for (int i = 0; i < 4; ++i) { const float send = b0 ? d[i] : d[i + 4], keep = b0 ? d[i + 4] : d[i]; a[i] = keep + __shfl_xor(send, 1); }
#pragma unroll
    for (int i = 0; i < 2; ++i) { const float send = b1 ? a[i] : a[i + 2], keep = b1 ? a[i + 2] : a[i]; b[i] = keep + __shfl_xor(send, 2); }
    float c; { const float send = b2 ? b[0] : b[1], keep = b2 ? b[1] : b[0]; c = keep + __shfl_xor(send, 4); }
    c += __shfl_xor(c, 8); c += __shfl_xor(c, 16); c += __shfl_xor(c, 32);
    return c;
}
__device__ __forceinline__ int bitrev3(int x) { return ((x & 1) << 2) | (x & 2) | ((x & 4) >> 2); }
#define MFMA16(a, b, c) __builtin_amdgcn_mfma_f32_16x16x32_bf16((a), (b), (c), 0, 0, 0)
__device__ __forceinline__ void mini_pair(const bf16* A, int K, int nsplit, const bf16* Bt, int rb0, int rb1, int lane, int wave, LAS float* red, f32x4& c0, f32x4& c1) {
    const int n = lane & 15, kq = lane >> 4, ks = K / nsplit;
    const bf16* ap = A + (size_t)n * K + 8 * kq; const bf16* b0 = Bt + (size_t)(rb0 + n) * K + 8 * kq; const bf16* b1 = Bt + (size_t)(rb1 + n) * K + 8 * kq;
    c0 = (f32x4){0.f, 0.f, 0.f, 0.f}; c1 = c0;
    if (wave < nsplit) {
#pragma unroll 4
        for (int k0 = wave * ks; k0 < (wave + 1) * ks; k0 += 32) { const bf16x8 a = *(const GAS bf16x8*)(ap + k0), x0 = *(const GAS bf16x8*)(b0 + k0), x1 = *(const GAS bf16x8*)(b1 + k0);
            c0 = MFMA16(x0, a, c0); c1 = MFMA16(x1, a, c1); }
    }
    *(LAS f32x4*)(red + (wave * 64 + lane) * 8) = c0; *(LAS f32x4*)(red + (wave * 64 + lane) * 8 + 4) = c1;
    __syncthreads();
    if (wave == 0) {
#pragma unroll
        for (int w = 1; w < 8; ++w) { c0 += *(const LAS f32x4*)(red + (w * 64 + lane) * 8); c1 += *(const LAS f32x4*)(red + (w * 64 + lane) * 8 + 4); }
    }
    __syncthreads();
}
__device__ __forceinline__ void mini_pair_i8(const unsigned char* A8, int K, int nsplit, const unsigned char* Bt8, int rb0, int rb1, const float* rs, const float* cs, int lane, int wave, LAS float* red, f32x4& c0, f32x4& c1) {
    typedef int v4i_ __attribute__((ext_vector_type(4)));
    const int n = lane & 15, kq = lane >> 4, ks = K / nsplit;
    const unsigned char* ap = A8 + (size_t)n * K + 16 * kq; const unsigned char* b0 = Bt8 + (size_t)(rb0 + n) * K + 16 * kq; const unsigned char* b1 = Bt8 + (size_t)(rb1 + n) * K + 16 * kq;
    v4i_ i0 = {0, 0, 0, 0}, i1 = {0, 0, 0, 0};
    if (wave < nsplit) {
#pragma unroll 2
        for (int k0 = wave * ks; k0 < (wave + 1) * ks; k0 += 64) { const v4i_ a = *(const GAS v4i_*)(ap + k0), x0 = *(const GAS v4i_*)(b0 + k0), x1 = *(const GAS v4i_*)(b1 + k0);
            i0 = __builtin_amdgcn_mfma_i32_16x16x64_i8(x0, a, i0, 0, 0, 0); i1 = __builtin_amdgcn_mfma_i32_16x16x64_i8(x1, a, i1, 0, 0, 0); }
    }
    LAS v4i_* ri = (LAS v4i_*)red;
    ri[(wave * 64 + lane) * 2] = i0; ri[(wave * 64 + lane) * 2 + 1] = i1;
    __syncthreads();
    if (wave == 0) {
#pragma unroll
        for (int w = 1; w < 8; ++w) { i0 += ri[(w * 64 + lane) * 2]; i1 += ri[(w * 64 + lane) * 2 + 1]; }
        const float r = rs[n]; const f32x4 s0 = *(const GAS f32x4*)(cs + rb0 + 4 * kq), s1 = *(const GAS f32x4*)(cs + rb1 + 4 * kq);
#pragma unroll
        for (int e = 0; e < 4; ++e) { c0[e] = (float)i0[e] * (r * s0[e]); c1[e] = (float)i1[e] * (r * s1[e]); }
    }
    __syncthreads();
}
__device__ __forceinline__ void st4bf(bf16* dst, const f32x4 v) { v2u w; w.x = pk2bf(v[0], v[1]); w.y = pk2bf(v[2], v[3]); *(GAS v2u*)dst = w; }
__device__ __forceinline__ void zero_fill16(unsigned char* base, int nrows, size_t row_bytes, int col_byte0, int ncol_bytes, int gt, int NGT) {
    const int per = ncol_bytes / 16; const v4u z = {0u, 0u, 0u, 0u};
    for (int i = gt; i < nrows * per; i += NGT) *(GAS v4u*)(base + (size_t)(i / per) * row_bytes + col_byte0 + (size_t)(i % per) * 16) = z;
}

#define MFMA32(a, b, c) __builtin_amdgcn_mfma_f32_32x32x16_bf16((a), (b), (c), 0, 0, 0)
typedef short v4i16_t __attribute__((ext_vector_type(4)));
__device__ __forceinline__ s16x4 vtr(const LAS unsigned char* p) { return __builtin_bit_cast(s16x4, __builtin_amdgcn_ds_read_tr16_b64_v4i16((LAS v4i16_t*)p)); }
__device__ __forceinline__ float max3f(float a, float b, float c) { float r; asm("v_max3_f32 %0, %1, %2, %3" : "=v"(r) : "v"(a), "v"(b), "v"(c)); return r; }
__device__ __forceinline__ float max2f(float a, float b) { float r; asm("v_max_f32_e32 %0, %1, %2" : "=v"(r) : "v"(a), "v"(b)); return r; }
__device__ __forceinline__ int crow(int r, int hi) { return (r & 3) + 8 * (r >> 2) + 4 * hi; }
__device__ __forceinline__ int chunk_of(int p) { return p < 16 ? 0 : 1 + ((p - 16) >> 6); }
constexpr int KPOS_BAD = 1 << 29;

template <int DQK, int DV> struct AttnCarry { bf16x8 qf[DQK / 16]; v4u k[(64 * (DQK / 8) + 511) / 512]; v4u v[(64 * (DV / 8)) / 512]; float b; bool valid; };
struct AttnNext { const bf16* qrow; const bf16* Kg; const bf16* Vg; const float* cb_real; const float* cb_meta; int kv_row0, first_tile; bool has; };
template <int DQK, int DV, bool CAUSAL, bool BIAS, bool BACKWARD, bool LMFMA, bool CONV, int VPRE = 0>
__device__ __forceinline__ void attn_pass(LAS unsigned char* lds, const bf16* qrow, const bf16* Kg, int kpitch, const bf16* Vg, int vpitch, int kv_row0, int NT,
                                          int qp, int qp_lo, int qp_hi, const float* cb_real, const float* cb_meta, f32x16 (&o)[DV / 32], float& linv,
                                          int& cv_it, int cv_stride, const MoeConv& CV, LAS float* cscr, float kmax = 0.f, AttnCarry<DQK, DV>* cyp = nullptr, const AttnNext* nxp = nullptr) {
    constexpr int KP = DQK * 2 + 16, VP = DV * 2 + 64, KPC = DQK / 8, VPC = DV / 8, NK = (64 * KPC + 511) / 512, NV = (64 * VPC) / 512, NS = DQK / 16, ND = DV / 32;
    constexpr int OFF_V = 64 * KP, OFF_B = OFF_V + 64 * VP, STG = OFF_B + 256;
    const int tid = threadIdx.x, lane = tid & 63, r = lane & 31, h = lane >> 5;
    bf16x8 qf[NS]; const bool pre_ = cyp != nullptr && cyp->valid;
    if (pre_) {
#pragma unroll
        for (int st = 0; st < NS; ++st) qf[st] = cyp->qf[st]; }
    else {
#pragma unroll
        for (int st = 0; st < NS; ++st) qf[st] = *(const GAS bf16x8*)(qrow + st * 16 + h * 8); }
#pragma unroll
    for (int dt = 0; dt < ND; ++dt)
#pragma unroll
        for (int i = 0; i < 16; ++i) o[dt][i] = 0.f;
    f32x16 ol;
#pragma unroll
    for (int i = 0; i < 16; ++i) ol[i] = 0.f;
    const bf16x8 ones8 = {0x3F80, 0x3F80, 0x3F80, 0x3F80, 0x3F80, 0x3F80, 0x3F80, 0x3F80};
    float mref = 0.f, l_run = 0.f;
    f32x16 negm;
#pragma unroll
    for (int i = 0; i < 16; ++i) negm[i] = 0.f;
    const int cq = chunk_of(qp), cq_lo = chunk_of(qp_lo), cq_hi = chunk_of(qp_hi);
    float qbound = 0.f; const int wave_id = __builtin_amdgcn_readfirstlane(tid >> 6);
    if (BACKWARD) { float ss = 0.f;
#pragma unroll
        for (int st = 0; st < NS; ++st)
#pragma unroll
            for (int e = 0; e < 8; ++e) { const float x = __uint_as_float(((unsigned)(unsigned short)qf[st][e]) << 16); ss += x * x; }
        ss += __shfl_xor(ss, 32); qbound = sqrtf(ss) * kmax * 1.02f; }
    bool fin = false;
    v4u kreg[2][NK], vreg[2][NV]; float breg[2] = {0.f, 0.f};
#define ATT_LOAD(t, S) do { const int rowb_ = (t) == 0 ? META0 : kv_row0 + 64 * ((t) - 1); \
        _Pragma("unroll") for (int j_ = 0; j_ < NK; ++j_) { const int p_ = tid + 512 * j_; if (p_ < 64 * KPC) { const int key_ = p_ / KPC, pc_ = p_ % KPC; kreg[S][j_] = *(const GAS v4u*)(Kg + (size_t)(rowb_ + key_) * kpitch + pc_ * 8); } } \
        _Pragma("unroll") for (int j_ = 0; j_ < NV; ++j_) { const int p_ = tid + 512 * j_; const int key_ = p_ / VPC, pc_ = p_ % VPC; vreg[S][j_] = *(const GAS v4u*)(Vg + (size_t)(rowb_ + key_) * vpitch + pc_ * 8); } \
        if (BIAS) { if (tid < 64) breg[S] = (t) == 0 ? (tid < 16 ? cb_meta[tid] : 0.f) : cb_real[64 * ((t) - 1) + tid]; } } while (0)
#define ATT_STORE(buf, S) do { LAS unsigned char* sb_ = lds + (buf) * STG; \
        _Pragma("unroll") for (int j_ = 0; j_ < NK; ++j_) { const int p_ = tid + 512 * j_; if (p_ < 64 * KPC) { const int key_ = p_ / KPC, pc_ = p_ % KPC; *(LAS v4u*)(sb_ + key_ * KP + pc_ * 16) = kreg[S][j_]; } } \
        _Pragma("unroll") for (int j_ = 0; j_ < NV; ++j_) { const int p_ = tid + 512 * j_; const int key_ = p_ / VPC, pc_ = p_ % VPC; *(LAS v4u*)(sb_ + OFF_V + key_ * VP + pc_ * 16) = vreg[S][j_]; } \
        if (BIAS) { if (tid < 64) *(LAS float*)(sb_ + OFF_B + tid * 4) = -breg[S]; } } while (0)
#define ATT_BAR() asm volatile("s_waitcnt lgkmcnt(0)\n\ts_barrier" ::: "memory")
#define TILE(i) (BACKWARD ? NT - (i) : (i))
    bool started = false;
    if (pre_) {
#pragma unroll
        for (int j_ = 0; j_ < NK; ++j_) kreg[0][j_] = cyp->k[j_];
#pragma unroll
        for (int j_ = 0; j_ < NV; ++j_) vreg[0][j_] = cyp->v[j_];
        if (BIAS) breg[0] = cyp->b; }
    else { ATT_LOAD(TILE(0), 0); }
    ATT_STORE(0, 0); if (NT >= 1) ATT_LOAD(TILE(1), 1); ATT_BAR();
    const int q4 = (lane & 15) >> 2, p4 = lane & 3, blk = (lane >> 4) & 1;
    ConvItem ci = {}; f32x4 cvv[8]; bool cv_pend = false;
    for (int t2 = 0; t2 <= NT; t2 += 2) {
#pragma unroll
      for (int par = 0; par < 2; ++par) { const int step = t2 + par; if (step > NT) break; const int t = TILE(step);
        if (BACKWARD) { if (step >= 1) { const LAS int* fl = (const LAS int*)(lds + FOX_FLAG_OFF); int agree = 1;
#pragma unroll
            for (int w = 0; w < 8; ++w) agree &= (fl[w] == step) ? 1 : 0;
            if (__builtin_amdgcn_readfirstlane(agree)) { fin = true; break; } } }
        if (CONV) { if ((step & 3) == 0 && cv_it < MOE_CONV_ITEMS) { ci = moe_conv_item(cv_it, CV); tr_load(ci.W, ci.ldw, ci.k0, ci.n0, lane, cvv); cv_pend = true; asm volatile("" ::: "memory"); } }
        if (step + 2 <= NT) ATT_LOAD(TILE(step + 2), par);
        int status;
        if (t == 0) status = 2;
        else if (CAUSAL) { const int kp_lo = 16 + 64 * (t - 1), kp_hi = kp_lo + 63; status = kp_lo > qp_hi ? 0 : (kp_hi <= qp_lo ? 1 : 2); }
        else { status = t > cq_hi ? 0 : (t <= cq_lo ? 1 : 2); }
        if (status != 0) {
            const LAS unsigned char* sb = lds + par * STG;
            f32x16 s0, s1;
            f32x4 bb0[BIAS ? 4 : 1], bb1[BIAS ? 4 : 1];
            if (BIAS) {
#pragma unroll
                for (int g = 0; g < 4; ++g) { bb0[g] = *(const LAS f32x4*)(sb + OFF_B + (8 * g + 4 * h) * 4); bb1[g] = *(const LAS f32x4*)(sb + OFF_B + (32 + 8 * g + 4 * h) * 4); }
            }
            __builtin_amdgcn_s_setprio(1);
#pragma unroll
            for (int st = 0; st < NS; ++st) { const bf16x8 k0 = *(const LAS bf16x8*)(sb + r * KP + st * 32 + h * 16), k1 = *(const LAS bf16x8*)(sb + (32 + r) * KP + st * 32 + h * 16);
                if (st == 0) { s0 = MFMA32(k0, qf[0], negm); s1 = MFMA32(k1, qf[0], negm); } else { s0 = MFMA32(k0, qf[st], s0); s1 = MFMA32(k1, qf[st], s1); } }
            __builtin_amdgcn_s_setprio(0);
            if (BIAS) {
#pragma unroll
                for (int g = 0; g < 4; ++g)
#pragma unroll
                    for (int e = 0; e < 4; ++e) { s0[4 * g + e] += bb0[g][e]; s1[4 * g + e] += bb1[g][e]; }
                __builtin_amdgcn_sched_barrier(0);
            }
            bf16x8 vfa[VPRE ? VPRE : 1][VPRE ? ND : 1];
            if constexpr (VPRE > 0) {
#pragma unroll
                for (int ks = 0; ks < VPRE; ++ks)
#pragma unroll
                    for (int dt = 0; dt < ND; ++dt) { const LAS unsigned char* vp = sb + OFF_V + (16 * ks + 4 * h + q4) * VP + (32 * dt + 16 * blk) * 2 + 8 * p4;
                        const s16x4 lo = vtr(vp), hi = vtr(vp + 8 * VP); vfa[ks][dt] = (bf16x8){lo[0], lo[1], lo[2], lo[3], hi[0], hi[1], hi[2], hi[3]}; }
            }
            if (status == 2) {
#pragma unroll
                for (int i = 0; i < 16; ++i) { const int k0 = crow(i, h), k1 = 32 + k0;
                    const int kp0 = t == 0 ? (k0 < 16 ? k0 : KPOS_BAD) : 16 + 64 * (t - 1) + k0, kp1 = t == 0 ? KPOS_BAD : 16 + 64 * (t - 1) + k1;
                    const bool v0 = CAUSAL ? (kp0 <= qp) : (kp0 < KPOS_BAD && chunk_of(kp0) <= cq), v1 = CAUSAL ? (kp1 <= qp) : (kp1 < KPOS_BAD && chunk_of(kp1) <= cq);
                    if (!v0) s0[i] = -INFINITY; if (!v1) s1[i] = -INFINITY; }
            }
            asm volatile("s_nop 15\n\ts_nop 7" : "+v"(s0), "+v"(s1));
            float mxa = max3f(s0[0], s0[1], s1[0]), mxb = max3f(s0[2], s0[3], s1[1]); mxa = max3f(mxa, s1[2], s1[3]);
#pragma unroll
            for (int i = 4; i < 16; i += 4) { mxa = max3f(mxa, s0[i], s0[i + 1]); mxb = max3f(mxb, s0[i + 2], s0[i + 3]); mxa = max3f(mxa, s1[i], s1[i + 1]); mxb = max3f(mxb, s1[i + 2], s1[i + 3]); }
            float mx = max2f(mxa, mxb);
            { asm volatile("s_nop 1" : "+v"(mx));
              const auto sw_ = __builtin_amdgcn_permlane32_swap(__float_as_uint(mx), __float_as_uint(mx), false, false);
              mx = max2f(__uint_as_float(sw_[0]), __uint_as_float(sw_[1])); }
            const bool first = !started; started = true;
            const bool upd = first || __any(mx > 6.f);
            if (upd) {
                float delta = first ? mx : fmaxf(mx, 0.f); delta = (delta == -INFINITY) ? 0.f : delta;
                mref += delta;
#pragma unroll
                for (int i = 0; i < 16; ++i) { s0[i] -= delta; s1[i] -= delta; negm[i] = -mref; }
                if (!first) { const float alpha = __builtin_amdgcn_exp2f(-delta); l_run *= alpha; if (LMFMA) ol[0] *= alpha;
#pragma unroll
                    for (int dt = 0; dt < ND; ++dt)
#pragma unroll
                        for (int i = 0; i < 16; ++i) o[dt][i] *= alpha; }
            }
            if (upd || !__all(mx < -40.f)) {
            if (LMFMA) {
#pragma unroll
                for (int i = 0; i < 16; ++i) { s0[i] = __builtin_amdgcn_exp2f(s0[i]); s1[i] = __builtin_amdgcn_exp2f(s1[i]); }
            } else { float psum = 0.f;
#pragma unroll
                for (int i = 0; i < 16; ++i) { s0[i] = __builtin_amdgcn_exp2f(s0[i]); s1[i] = __builtin_amdgcn_exp2f(s1[i]); psum += s0[i] + s1[i]; }
                l_run += psum; }
            bf16x8 pf[4];
            { v4u w;
              w.x = pk2bf(s0[0], s0[1]); w.y = pk2bf(s0[2], s0[3]); w.z = pk2bf(s0[4], s0[5]); w.w = pk2bf(s0[6], s0[7]); pf[0] = __builtin_bit_cast(bf16x8, w);
              w.x = pk2bf(s0[8], s0[9]); w.y = pk2bf(s0[10], s0[11]); w.z = pk2bf(s0[12], s0[13]); w.w = pk2bf(s0[14], s0[15]); pf[1] = __builtin_bit_cast(bf16x8, w);
              w.x = pk2bf(s1[0], s1[1]); w.y = pk2bf(s1[2], s1[3]); w.z = pk2bf(s1[4], s1[5]); w.w = pk2bf(s1[6], s1[7]); pf[2] = __builtin_bit_cast(bf16x8, w);
              w.x = pk2bf(s1[8], s1[9]); w.y = pk2bf(s1[10], s1[11]); w.z = pk2bf(s1[12], s1[13]); w.w = pk2bf(s1[14], s1[15]); pf[3] = __builtin_bit_cast(bf16x8, w); }
#pragma unroll
            for (int ks = 0; ks < 4; ++ks) { bf16x8 vf[ND];
#pragma unroll
                for (int dt = 0; dt < ND; ++dt) { if (VPRE > 0 && ks < VPRE) { vf[dt] = vfa[ks < VPRE ? ks : 0][dt]; } else { const LAS unsigned char* vp = sb + OFF_V + (16 * ks + 4 * h + q4) * VP + (32 * dt + 16 * blk) * 2 + 8 * p4;
                    const s16x4 lo = vtr(vp), hi = vtr(vp + 8 * VP);
                    vf[dt] = (bf16x8){lo[0], lo[1], lo[2], lo[3], hi[0], hi[1], hi[2], hi[3]}; } }
#pragma unroll
                for (int dt = 0; dt < ND; ++dt) o[dt] = MFMA32(vf[dt], pf[ks], o[dt]);
                if (LMFMA) ol = MFMA32(ones8, pf[ks], ol);
                if (ND > 2) __builtin_amdgcn_sched_barrier(0); }
            }
        }
        if (BACKWARD) { bool c = false;
            if (status != 0 && started && t != 0) { const float bt = *(const LAS float*)(lds + par * STG + OFF_B + 63 * 4); c = __all(qbound + bt - mref < -40.f); }
            if (lane == 0) ((LAS int*)(lds + FOX_FLAG_OFF))[wave_id] = c ? step + 1 : 0; }
        if (CONV) { if (cv_pend && ((step & 3) == 3 || step == NT)) { tr_finish(cvv, ci.WT, ci.Kd, ci.drow0, ci.k0, cscr, lane, ci.fp8); cv_it += cv_stride; cv_pend = false; } }
        if (step + 1 <= NT) ATT_STORE(par ^ 1, par ^ 1);
        ATT_BAR();
      }
      if (fin) break;
    }
#undef ATT_LOAD
#undef ATT_STORE
#undef ATT_BAR
#undef TILE
    if (cyp != nullptr) { const bool hn_ = nxp != nullptr && nxp->has; cyp->valid = hn_;
        if (hn_) {
#pragma unroll
            for (int st = 0; st < NS; ++st) cyp->qf[st] = *(const GAS bf16x8*)(nxp->qrow + st * 16 + h * 8);
            const int t_ = nxp->first_tile, rowb_ = t_ == 0 ? META0 : nxp->kv_row0 + 64 * (t_ - 1); cyp->b = 0.f;
#pragma unroll
            for (int j_ = 0; j_ < NK; ++j_) { const int p_ = tid + 512 * j_; cyp->k[j_] = (v4u){0u, 0u, 0u, 0u}; if (p_ < 64 * KPC) { const int key_ = p_ / KPC, pc_ = p_ % KPC; cyp->k[j_] = *(const GAS v4u*)(nxp->Kg + (size_t)(rowb_ + key_) * kpitch + pc_ * 8); } }
#pragma unroll
            for (int j_ = 0; j_ < NV; ++j_) { const int p_ = tid + 512 * j_; const int key_ = p_ / VPC, pc_ = p_ % VPC; cyp->v[j_] = *(const GAS v4u*)(nxp->Vg + (size_t)(rowb_ + key_) * vpitch + pc_ * 8); }
            if (BIAS) { if (tid < 64) cyp->b = t_ == 0 ? (tid < 16 ? nxp->cb_meta[tid] : 0.f) : nxp->cb_real[64 * (t_ - 1) + tid]; } }
        else {
#pragma unroll
            for (int st = 0; st < NS; ++st) cyp->qf[st] = (bf16x8){0, 0, 0, 0, 0, 0, 0, 0};
#pragma unroll
            for (int j_ = 0; j_ < NK; ++j_) cyp->k[j_] = (v4u){0u, 0u, 0u, 0u};
#pragma unroll
            for (int j_ = 0; j_ < NV; ++j_) cyp->v[j_] = (v4u){0u, 0u, 0u, 0u};
            cyp->b = 0.f; } }
    const float lt = LMFMA ? ol[0] : l_run + __shfl_xor(l_run, 32);
    linv = 1.f / lt;
}

__device__ __forceinline__ void st_pair16(bf16* base, v2u a, v2u b, int h, bool ok) {
    const auto rx = __builtin_amdgcn_permlane32_swap(a.x, b.x, false, false); const auto ry = __builtin_amdgcn_permlane32_swap(a.y, b.y, false, false);
    v4u w; w.x = rx[0]; w.y = ry[0]; w.z = rx[1]; w.w = ry[1];
    if (ok) *(GAS v4u*)(base + 8 * h) = w;
}
template <int DV> __device__ __forceinline__ void attn_store(const f32x16 (&o)[DV / 32], float linv, bf16* out_row, int h, bool ok) {
#pragma unroll
    for (int dt = 0; dt < DV / 32; ++dt)
#pragma unroll
        for (int g = 0; g < 4; g += 2) { v2u a, b;
            a.x = pk2bf(o[dt][4 * g] * linv, o[dt][4 * g + 1] * linv); a.y = pk2bf(o[dt][4 * g + 2] * linv, o[dt][4 * g + 3] * linv);
            b.x = pk2bf(o[dt][4 * g + 4] * linv, o[dt][4 * g + 5] * linv); b.y = pk2bf(o[dt][4 * g + 6] * linv, o[dt][4 * g + 7] * linv);
            st_pair16(out_row + 32 * dt + 8 * g, a, b, h, ok); }
}

__device__ __forceinline__ void sb_unit(LAS unsigned char* wl  , const bf16* Qg, const bf16* Kg, const bf16* Vg  ,
                                        int q_row0, int qp0, int ktop  , int kv_row0, bf16* out  , int nvalid_q, int lane) {
    constexpr int VP = 192, PITCH = 1536;
    const int r = lane & 31, h = lane >> 5, q4 = (lane & 15) >> 2, p4 = lane & 3, blk = (lane >> 4) & 1;
    const int qp = qp0 + r;
    bf16x8 qf[4];
#pragma unroll
    for (int st = 0; st < 4; ++st) qf[st] = *(const GAS bf16x8*)(Qg + (size_t)(q_row0 + r) * PITCH + st * 16 + h * 8);
    f32x16 o[2];
#pragma unroll
    for (int dt = 0; dt < 2; ++dt)
#pragma unroll
        for (int i = 0; i < 16; ++i) o[dt][i] = 0.f;
    float carry = 0.f;
    bf16x8 kn[4]; v4u vn[4];
#define SB_LOAD(tile_) do { const int rowb_ = (tile_) >= 0 ? kv_row0 + 32 * (tile_) : META0; \
        _Pragma("unroll") for (int st_ = 0; st_ < 4; ++st_) kn[st_] = *(const GAS bf16x8*)(Kg + (size_t)(rowb_ + r) * PITCH + st_ * 16 + h * 8); \
        _Pragma("unroll") for (int j_ = 0; j_ < 4; ++j_) { const int p_ = lane + 64 * j_; vn[j_] = *(const GAS v4u*)(Vg + (size_t)(rowb_ + (p_ >> 3)) * PITCH + (p_ & 7) * 8); } } while (0)
    SB_LOAD(ktop);
    for (int tile = ktop; tile >= -1; --tile) {
        const int kp0 = tile >= 0 ? 16 + 32 * tile : 0, nval = tile >= 0 ? 32 : 16;
        bf16x8 kf[4]; v4u vr[4];
#pragma unroll
        for (int st = 0; st < 4; ++st) kf[st] = kn[st];
#pragma unroll
        for (int j = 0; j < 4; ++j) vr[j] = vn[j];
        asm volatile("" ::: "memory");
        if (tile > -1) SB_LOAD(tile - 1);
        asm volatile("" ::: "memory");
#pragma unroll
        for (int j = 0; j < 4; ++j) { const int p = lane + 64 * j; *(LAS v4u*)(wl + (p >> 3) * VP + (p & 7) * 16) = vr[j]; }
        f32x16 z;
#pragma unroll
        for (int i = 0; i < 16; ++i) z[i] = 0.f;
#pragma unroll
        for (int st = 0; st < 4; ++st) z = MFMA32(kf[st], qf[st], z);
        LDS_WAIT(); asm volatile("" ::: "memory");
        bf16x8 vfs[2][2];
#pragma unroll
        for (int dt = 0; dt < 2; ++dt)
#pragma unroll
            for (int ks = 0; ks < 2; ++ks) { const LAS unsigned char* vp = wl + (16 * ks + 4 * h + q4) * VP + (32 * dt + 16 * blk) * 2 + 8 * p4;
                const s16x4 lo = vtr(vp), hi = vtr(vp + 8 * VP); vfs[dt][ks] = (bf16x8){lo[0], lo[1], lo[2], lo[3], hi[0], hi[1], hi[2], hi[3]}; }
        float L[16]; bool vis[16];
#pragma unroll
        for (int i = 0; i < 16; ++i) { const int k = crow(i, h); vis[i] = (k < nval) && (kp0 + k < qp);
            const float a = fabsf(z[i]); const float sp = fmaxf(z[i], 0.f) + LN2 * __builtin_amdgcn_logf(1.f + __builtin_amdgcn_exp2f(-a * LOG2E));
            L[i] = vis[i] ? -sp : 0.f; }
        float G[4], PG[4];
#pragma unroll
        for (int g = 0; g < 4; ++g) { G[g] = (L[4 * g] + L[4 * g + 1]) + (L[4 * g + 2] + L[4 * g + 3]); const auto sg_ = __builtin_amdgcn_permlane32_swap(__float_as_uint(G[g]), __float_as_uint(G[g]), false, false); PG[g] = __uint_as_float(h ? sg_[0] : sg_[1]); }
        float after[4]; float acc = 0.f;
#pragma unroll
        for (int g = 3; g >= 0; --g) { after[g] = acc + (h == 0 ? PG[g] : 0.f); acc += G[g] + PG[g]; }
        float w[16];
#pragma unroll
        for (int g = 0; g < 4; ++g) { float suf = 0.f;
#pragma unroll
            for (int e = 3; e >= 0; --e) { const int i = 4 * g + e; const float btw = carry + after[g] + suf; suf += L[i];
                w[i] = vis[i] ? __builtin_amdgcn_exp2f((z[i] + L[i] + btw) * LOG2E) : 0.f; } }
        carry += acc;
        bf16x8 pf[2];
        { v4u x;
          x.x = pk2bf(w[0], w[1]); x.y = pk2bf(w[2], w[3]); x.z = pk2bf(w[4], w[5]); x.w = pk2bf(w[6], w[7]); pf[0] = __builtin_bit_cast(bf16x8, x);
          x.x = pk2bf(w[8], w[9]); x.y = pk2bf(w[10], w[11]); x.z = pk2bf(w[12], w[13]); x.w = pk2bf(w[14], w[15]); pf[1] = __builtin_bit_cast(bf16x8, x); }
#pragma unroll
        for (int dt = 0; dt < 2; ++dt)
#pragma unroll
            for (int ks = 0; ks < 2; ++ks) o[dt] = MFMA32(vfs[dt][ks], pf[ks], o[dt]);
        LDS_WAIT(); asm volatile("" ::: "memory");
        if (__all(carry < -36.f)) break;
    }
#undef SB_LOAD
    attn_store<64>(o, 1.f, out + (size_t)(q_row0 + r) * 1024, h, r < nvalid_q);
}
struct Args { const float* in[28]; float* out; unsigned char* ws; int lo, hi, clo, chi; };
enum { I_X = 0, I_META, I_LN_MIX_E, I_W_IN_E, I_LN_Q, I_W_UQ, I_LN_KV, I_W_UKV, I_W_OUT_E, I_LN_FFN_E, I_W_GATE_E, I_W_UP_E, I_W_DOWN_E, I_LN_MIX_O, I_W_IN_O, I_B_FORGET,
       I_LQ1, I_LK1, I_LQ2, I_LK2, I_SUBLN, I_W_OUT_O, I_LN_FFN_O, I_W_ROUTER, I_W_MGATE, I_W_MUP, I_W_MDOWN, I_LN_FINAL };
constexpr int N_PHASES = 18;
constexpr float LAM_INIT = 0.35550906759096927f;
constexpr float SC_MLA = 0.10206207261596575f * LOG2E, SC_64 = 0.125f * LOG2E;

typedef const __attribute__((address_space(4))) Args* CArgs;
__device__ __forceinline__ CArgs fresh_args() { CArgs p = (CArgs)__builtin_amdgcn_kernarg_segment_ptr(); asm volatile("" : "+s"(p)); return p; }
#define PH() CArgs A = fresh_args(); unsigned char* const ws = A->ws; int tid = threadIdx.x; asm volatile("" : "+v"(tid)); \
    const int lane = tid & 63, wave = __builtin_amdgcn_readfirstlane(tid >> 6); const int G = gridDim.x, bx = blockIdx.x, vcu = (G % 8 == 0) ? (bx % 8) * (G / 8) + bx / 8 : bx; \
    const int gw = vcu * NWAVES + wave, NGW = G * NWAVES, gt = vcu * 512 + tid, NGT = G * 512; const int WPB = NGW >> 3, r0_ = (gw / WPB) * 4096 + gw % WPB, NIT_ = 2048 / WPB; LAS unsigned char* const lds = (LAS unsigned char*)lds_raw; \
    bf16* const HN = (bf16*)(ws + WS_HN); float* const HMETA = (float*)(ws + WS_HMETA); \
    (void)lane; (void)wave; (void)gw; (void)NGW; (void)gt; (void)NGT; (void)lds; (void)HN; (void)HMETA; (void)vcu
#define PH_TABLES() const float* cosM = (const float*)(ws + WS_COSM); const float* sinM = (const float*)(ws + WS_SINM); const float* cosD = (const float*)(ws + WS_COSD); const float* sinD = (const float*)(ws + WS_SIND); \
    (void)cosM; (void)sinM; (void)cosD; (void)sinD

__global__ void __launch_bounds__(NWAVES * 64, 2) hybrid_fwd(Args a_unused) {
    extern __shared__ __attribute__((aligned(16))) unsigned char lds_raw[];
    int lo, hi;
    XcdBarrier bar;
    { CArgs A = fresh_args(); lo = A->lo; hi = A->hi;
      LAS unsigned char* const lds = (LAS unsigned char*)lds_raw;
      for (int u = threadIdx.x; u < (LDS_BYTES - LDSCTL_OFF) / 4; u += NWAVES * 64) ((LAS unsigned*)(lds + LDSCTL_OFF))[u] = 0u;
      __syncthreads();
      bar = xcd_barrier_post((unsigned*)(A->ws + WS_CTL) + CW_BAR, (volatile LAS unsigned*)(lds + MISC_OFF) + 8); }
#ifndef PHMASK
#define PHMASK 0xFFFFFFFFu
#endif
#define IN(k) (((PHMASK >> (k)) & 1u) && lo <= (k) && (k) < hi)
#ifndef REPMASK
#define REPMASK 0u
#endif
#if REPMASK == 0u
#define PHASE(k) if (IN(k))
#else
#define PHASE(k) for (int rep_ = 0; rep_ < (IN(k) ? 1 + (int)((REPMASK >> (k)) & 1u) : 0); ++rep_)
#endif
#define SEAM(k) do { if (IN(k) && IN((k) + 1)) xcd_barrier(bar); } while (0)

    PHASE(0) { PH();
        LAS float* scr = (LAS float*)(lds + wave * 16384);
        RowRaw<false> ca, cb, na, nb; row_raw_load<false>(A->in[I_X] + (size_t)r0_ * DM, lane, ca); row_raw_load<false>(A->in[I_X] + (size_t)(r0_ + WPB) * DM, lane, cb);
        if (gw < 256) colmax_job(A->in[I_W_IN_E], 1952, 1952, gw % 8, gw / 8, (float*)(ws + WS_CMAXP0), 2048, -1, lane);
        else if (gw < 960) { const int it = gw - 256, mtx = it / 352, r_ = it % 352; colmax_job(A->in[mtx ? I_W_UP_E : I_W_GATE_E], DFF, DFF, r_ % 11, r_ / 11, (float*)(ws + WS_CMAXP), CMAX_LD, mtx * 128, lane); }
        else if (gw < 1344) { const int it = gw - 960; colmax_job(A->in[I_W_IN_O], 3080, 3072, it % 12, it / 12, (float*)(ws + WS_CMAXP1), 3072, -1, lane); }
        constexpr int C1 = 96, C2 = C1 + 64, C3 = C2 + 512, C4 = C3 + 1408, C5 = C4 + 512;
        for (int it = gw; it < C5; it += NGW) {
            if (it < C1) tr_job<0>(it, A->in[I_W_UQ], 256, 768, 0, 768, (bf16*)(ws + WS_WUQKV), 384, 0, 0, SC_MLA, scr, lane);
            else if (it < C2) tr_job<0>(it - C1, A->in[I_W_UKV], 128, 1024, 0, 1024, (bf16*)(ws + WS_WUQKV), 384, 256, 768, 1.f, scr, lane);
            else if (it < C3) tr_job<0>(it - C2, A->in[I_W_OUT_E], 1024, 1024, 0, 1024, (bf16*)(ws + WS_WOUT0), 1024, 0, 0, 1.f, scr, lane);
            else if (it < C4) tr_job<0>(it - C3, A->in[I_W_DOWN_E], DFF, 1024, 0, 1024, (bf16*)(ws + WS_WDN0), DFF, 0, 0, 1.f, scr, lane);
            else tr_job<0>(it - C4, A->in[I_W_OUT_O], 1024, 1024, 0, 1024, (bf16*)(ws + WS_WOUT1), 1024, 0, 0, 1.f, scr, lane);
        }
        { const v4u z = {0u, 0u, 0u, 0u};
          GAS v4u* wu = (GAS v4u*)(ws + WS_WUQKV);
          for (int i = gt; i < 768 * 16; i += NGT) wu[(size_t)(i >> 4) * 48 + 32 + (i & 15)] = z;
          for (int i = gt; i < 1024 * 32; i += NGT) wu[(size_t)(768 + (i >> 5)) * 48 + (i & 31)] = z; }
        { float* cM = (float*)(ws + WS_COSM); float* sM = (float*)(ws + WS_SINM); float* cD = (float*)(ws + WS_COSD); float* sD = (float*)(ws + WS_SIND);
          for (int idx = gt; idx < 4352 * 16; idx += NGT) { const int pos = idx >> 4, i = idx & 15; const float inv = __builtin_amdgcn_exp2f(-(float)i * (13.287712379549449f / 16.f));
              double rev = (double)pos * (double)inv * 0.15915494309189535; rev -= floor(rev); const float fr = (float)rev; cM[idx] = __builtin_amdgcn_cosf(fr); sM[idx] = __builtin_amdgcn_sinf(fr); }
          for (int idx = gt; idx < 4352 * 8; idx += NGT) { const int pos = idx >> 3, i = idx & 7; const float inv = __builtin_amdgcn_exp2f(-(float)i * (18.931568569324174f / 8.f));
              double rev = (double)pos * (double)inv * 0.15915494309189535; rev -= floor(rev); const float fr = (float)rev; cD[idx] = __builtin_amdgcn_cosf(fr); sD[idx] = __builtin_amdgcn_sinf(fr); } }
        {
          for (int it_ = 0, row = r0_; it_ < NIT_; ++it_, row += 2 * WPB) { f32x4 va[4], vb[4]; const int rb = row + WPB, nrow = row + 2 * WPB; const bool more = it_ + 1 < NIT_;
            if (more) { row_raw_load<false>(A->in[I_X] + (size_t)nrow * DM, lane, na); row_raw_load<false>(A->in[I_X] + (size_t)(nrow + WPB) * DM, lane, nb); }
            rms_row2_i8<false>(ca, cb, A->in[I_LN_MIX_E], ws + WS_HN + (size_t)row * DM, ws + WS_HN + (size_t)rb * DM, (float*)(ws + WS_RSC) + row, (float*)(ws + WS_RSC) + rb, lane, va, vb);
            if (more) { ca = na; cb = nb; } } }
        for (int row = NTOK + gw; row < MR; row += NGW) { f32x4 v[4];
            if (row - NTOK < 16) rms_row_q(A->in[I_META] + (size_t)(row - NTOK) * DM, A->in[I_LN_MIX_E], HN + (size_t)row * DM, ws + WS_HN + (size_t)row * DM, (float*)(ws + WS_RSC) + row, lane, v);
            else zero_row(HN + (size_t)row * DM, lane); }
        xcd_barrier(bar);
        for (int it = gw; it < 976; it += NGW) { const int kb = it / 61, n0 = 32 * (it % 61);
            tr_item_q8(A->in[I_W_IN_E], 1952, ws + WS_WIN0Q, 1024, n0, (const float*)(ws + WS_CMAXP0), 2048, (float*)(ws + WS_CSC0), n0 < 512 ? 0.125f : 1.f, scr, kb * 64, n0, lane); }
        { const v4u z = {0u, 0u, 0u, 0u}; GAS v4u* w0 = (GAS v4u*)(ws + WS_WIN0Q + (size_t)1952 * 1024);
          for (int i = gt; i < 96 * 64; i += NGT) w0[i] = z;
          for (int i = gt; i < 96; i += NGT) ((float*)(ws + WS_CSC0))[1952 + i] = 0.f; }
    }
    SEAM(0);
    PHASE(1) { PH(); PH_TABLES();
        for (int j = vcu; j < 64; j += G) { f32x4 c0, c1; mini_pair_i8(ws + WS_HN + (size_t)META0 * DM, 1024, 8, ws + WS_WIN0Q, 32 * j, 32 * j + 16, (const float*)(ws + WS_RSC) + META0, (const float*)(ws + WS_CSC0), lane, wave, (LAS float*)lds, c0, c1); if (wave != 0) continue;
            const int mrow = META0 + (lane & 15);
#pragma unroll
            for (int blk = 0; blk < 2; ++blk) { const int c = 32 * j + 16 * blk + 4 * (lane >> 4);
                bf16* dst = c < 1536 ? (bf16*)(ws + WS_SB) + (size_t)mrow * 1536 + c : (bf16*)(ws + WS_CM) + (size_t)mrow * 512 + (c - 1536); st4bf(dst, blk ? c1 : c0); } }
        zero_fill16(ws + WS_SB + (size_t)(META0 + 16) * 1536 * 2, 48, 1536 * 2, 512 * 2, 1024 * 2, gt, NGT);
        int k1 = 512; asm volatile("" : "+s"(k1));
        pg8::Gemm g{(const bf16*)(ws + WS_HN), (const bf16*)(ws + WS_WIN0Q), NTOK, 2048, k1}; pg8::StaticOrder S; S.init(NTOK, 2048, G, (int)blockIdx.x);
        pg8::EpiIn0I8 E{(bf16*)(ws + WS_SB), (bf16*)(ws + WS_CM), (const float*)(ws + WS_RSC), (const float*)(ws + WS_CSC0)};
        pg8::gemm_phase<pg8::EpiIn0I8, pg8::StaticOrder, true, true, false, true>(lds + RING_OFF, g, S, E);
    }
    SEAM(1);
    PHASE(2) { PH(); PH_TABLES();
        const bf16* CM = (const bf16*)(ws + WS_CM); bf16* CQ = (bf16*)(ws + WS_CQKV); bf16* KC = (bf16*)(ws + WS_KC);
        const float* gq = A->in[I_LN_Q]; const float* gkv = A->in[I_LN_KV];
        for (int ph = 0; ph < 2; ++ph) {
        if ((ph == 0) == (wave < 4)) {
        const bf16* SBQ = (const bf16*)(ws + WS_SB);
        LAS unsigned char* wl = lds + wave * 6144;
#pragma unroll 1
        for (int ku = 0; ku <= 1024 / WPB; ++ku) { const int u = ku < 1024 / WPB ? (gw / WPB) * 1024 + gw % WPB + WPB * ku : 8192 + gw; if (u >= 8192 + 8) break;
            const bool mt = u >= 8192; const int bh = mt ? 0 : (u >> 7), qt = u & 127, b = bh >> 3, hh = mt ? (u - 8192) : (bh & 7);
            sb_unit(wl, SBQ + hh * 64, SBQ + 512 + hh * 64, SBQ + 1024 + hh * 64, mt ? META0 : b * SEQ + 32 * qt, mt ? 0 : 16 + 32 * qt, mt ? -1 : qt, b * SEQ, HN + hh * 64, mt ? 16 : 32, lane);
        }
        } else {
        const f32x4 g4 = *(const GAS f32x4*)(gq + 4 * lane); const float gk0 = gkv[2 * lane], gk1 = gkv[2 * lane + 1]; const int ri = lane & 15, part = lane >> 4;
#define PREP_LOAD(row_, S) const bf16* cm##S = CM + (size_t)(row_) * 512; const v2u raw##S = *(const GAS v2u*)(cm##S + 4 * lane); const unsigned rw2##S = *(const GAS unsigned*)(cm##S + 256 + 2 * lane); \
            const int pos##S = row_pos(row_); const bf16 ra1##S = cm##S[384 + ri], ra2##S = cm##S[400 + ri]; const float co##S = cosM[pos##S * 16 + ri], si##S = sinM[pos##S * 16 + ri]
#define PREP_SUMS(S) const float x0##S = bf2f(raw##S.x & 0xffffu), x1##S = __uint_as_float(raw##S.x & 0xffff0000u), x2##S = bf2f(raw##S.y & 0xffffu), x3##S = __uint_as_float(raw##S.y & 0xffff0000u); \
            const float y0##S = bf2f(rw2##S & 0xffffu), y1##S = __uint_as_float(rw2##S & 0xffff0000u); float sq##S = (x0##S * x0##S + x1##S * x1##S) + (x2##S * x2##S + x3##S * x3##S), sk##S = y0##S * y0##S + y1##S * y1##S
#define PREP_STORE(row_, S) do { const float rq_ = 1.f / sqrtf(sq##S * (1.f / 256.f) + EPS), rk_ = 1.f / sqrtf(sk##S * (1.f / 128.f) + EPS); \
            v2u w_; w_.x = pk2bf(x0##S * rq_ * g4.x, x1##S * rq_ * g4.y); w_.y = pk2bf(x2##S * rq_ * g4.z, x3##S * rq_ * g4.w); *(GAS v2u*)(CQ + (size_t)(row_) * 384 + 4 * lane) = w_; \
            *(GAS unsigned*)(CQ + (size_t)(row_) * 384 + 256 + 2 * lane) = pk2bf(y0##S * rk_ * gk0, y1##S * rk_ * gk1); \
            const float r1_ = bf2f(ra1##S), r2_ = bf2f(ra2##S); const unsigned pk_ = pk2bf(r1_ * co##S - r2_ * si##S, r2_ * co##S + r1_ * si##S); \
            bf16* kr_ = KC + (size_t)(row_) * 768 + (2 * part) * 96 + 64 + ri; kr_[0] = (bf16)(pk_ & 0xffffu); kr_[16] = (bf16)(pk_ >> 16); kr_[96] = (bf16)(pk_ & 0xffffu); kr_[96 + 16] = (bf16)(pk_ >> 16); } while (0)
        for (int it_ = 0, row = r0_; it_ < NIT_; ++it_, row += 2 * WPB) { const int rowb = row + WPB;
            PREP_LOAD(row, A_); PREP_LOAD(rowb, B_); PREP_SUMS(A_); PREP_SUMS(B_);
#pragma unroll
            for (int o = 1; o < 64; o <<= 1) { sqA_ += __shfl_xor(sqA_, o); skA_ += __shfl_xor(skA_, o); sqB_ += __shfl_xor(sqB_, o); skB_ += __shfl_xor(skB_, o); }
            PREP_STORE(row, A_); PREP_STORE(rowb, B_); }
        if (gw < 16) { const int row = NTOK + gw; PREP_LOAD(row, A_); PREP_SUMS(A_);
#pragma unroll
            for (int o = 1; o < 64; o <<= 1) { sqA_ += __shfl_xor(sqA_, o); skA_ += __shfl_xor(skA_, o); }
            PREP_STORE(row, A_); }
#undef PREP_LOAD
#undef PREP_SUMS
#undef PREP_STORE
        } }
    }
    SEAM(2);
    PHASE(3) { PH(); PH_TABLES();
        int k3 = 256; asm volatile("" : "+s"(k3));
        for (int j = (896 % G) ? (int)blockIdx.x - 896 % G : vcu; j < 56; j += (896 % G) ? G - 896 % G : G) { if (j < 0) break; f32x4 c0, c1; mini_pair((const bf16*)(ws + WS_CQKV) + (size_t)META0 * 384,     384, 4, (const bf16*)(ws + WS_WUQKV), 32 * j, 32 * j + 16, lane, wave, (LAS float*)lds, c0, c1); if (wave != 0) continue;
            const int m16 = lane & 15, mrow = META0 + m16, fq = lane >> 4;
            if (j < 24) {
                if (j % 3 == 2) { const f32x4 cc = *(const GAS f32x4*)(cosM + m16 * 16 + 4 * fq), ss = *(const GAS f32x4*)(sinM + m16 * 16 + 4 * fq);
#pragma unroll
                    for (int e = 0; e < 4; ++e) { const float x1 = c0[e], x2 = c1[e]; c0[e] = x1 * cc[e] - x2 * ss[e]; c1[e] = x2 * cc[e] + x1 * ss[e]; } }
                bf16* dst = (bf16*)(ws + WS_QMLA) + (size_t)mrow * 768 + 32 * j + 4 * fq; st4bf(dst, c0); st4bf(dst + 16, c1);
            } else {
#pragma unroll
                for (int blk = 0; blk < 2; ++blk) { const int cp = 32 * (j - 24) + 16 * blk + 4 * fq, head = cp >> 7, within = cp & 127;
                    bf16* dst = within < 64 ? (bf16*)(ws + WS_KC) + (size_t)mrow * 768 + head * 96 + within : (bf16*)(ws + WS_VC) + (size_t)mrow * 512 + head * 64 + within - 64; st4bf(dst, blk ? c1 : c0); }
            } }
        zero_fill16(ws + WS_KC + (size_t)(META0 + 16) * 768 * 2, 48, 768 * 2, 0, 768 * 2, gt, NGT);
        zero_fill16(ws + WS_VC + (size_t)(META0 + 16) * 512 * 2, 48, 512 * 2, 0, 512 * 2, gt, NGT);
        pg8::EpiUqkv E{(bf16*)(ws + WS_QMLA), (bf16*)(ws + WS_KC), (bf16*)(ws + WS_VC), cosM, sinM, 0};
        pg8::Gemm g{(const bf16*)(ws + WS_CQKV), (const bf16*)(ws + WS_WUQKV), NTOK, 1792, k3, 384}; pg8::UqkvOrder S; S.so.init(NTOK, 1792, G, (int)blockIdx.x);
        pg8::gemm_phase<pg8::EpiUqkv, pg8::UqkvOrder, true, true>(lds + RING_OFF, g, S, E);
        { const int rem_ = 896 % G, bx_ = (int)blockIdx.x; const bool idle_ = rem_ == 0 || bx_ >= rem_; const int nw_ = (rem_ == 0 ? G : G - rem_) * NWAVES, iw_ = ((rem_ == 0 ? bx_ : bx_ - rem_)) * NWAVES + wave;
          if (idle_) { LAS float* scr = (LAS float*)(lds + wave * 16384);
            for (int it = iw_; it < 2816; it += nw_) { const int mtx = it / 1408, j = it % 1408, kb = j / 88, n0 = 32 * (j % 88);
                tr_item_q8(A->in[mtx ? I_W_UP_E : I_W_GATE_E], DFF, ws + WS_WGU0Q, 1024, mtx * 128 + 256 * (n0 / 128) + (n0 % 128), (const float*)(ws + WS_CMAXP), CMAX_LD, (float*)(ws + WS_CSC), 1.f, scr, kb * 64, n0, lane); }
            for (int it = iw_; it < 1536; it += nw_) { const int kb = it / 96, n0 = 32 * (it % 96); const bool qk = n0 < 512 || (n0 >= 1536 && n0 < 2048);
                tr_item_q8(A->in[I_W_IN_O], 3080, ws + WS_WIN1Q, 1024, n0, (const float*)(ws + WS_CMAXP1), 3072, (float*)(ws + WS_CSC1), qk ? SC_64 : 1.f, scr, kb * 64, n0, lane); } } }
    }
    SEAM(3);
    PHASE(4) { PH(); PH_TABLES();
        const bf16* QM = (const bf16*)(ws + WS_QMLA); const bf16* KC = (const bf16*)(ws + WS_KC); const bf16* VC = (const bf16*)(ws + WS_VC);
        const int v = vcu, r = lane & 31, h = lane >> 5;
        LAS float* cscr = (LAS float*)(lds + 61440 + wave * 8448);
        const MoeConv CV{A->in[I_W_MGATE], A->in[I_W_MUP], A->in[I_W_MDOWN], (bf16*)(ws + WS_WMG), (bf16*)(ws + WS_WMD)};
        int cv_it = gw;
        AttnCarry<96, 64> cy; cy.valid = false;
#pragma unroll 1
        for (int i = 0; i < 5; ++i) {
            int hh, q_row0, kv_row0, NT, qp0; bool meta = false;
            if (i < 4) { const int s = v & 3, bh = v >> 2, b = bh >> 3; hh = bh & 7; const int qb = i == 0 ? s : (i == 1 ? 15 - s : (i == 2 ? 4 + s : 11 - s));
                q_row0 = b * SEQ + 256 * qb; kv_row0 = b * SEQ; NT = 4 * qb + 4; qp0 = 16 + 256 * qb; }
            else { if (v >= 8) break; hh = v; q_row0 = META0; kv_row0 = 0; NT = 0; qp0 = 0; meta = true; }
            const int qrow = q_row0 + 32 * wave + r, qp_lo = qp0 + 32 * wave;
            f32x16 o[2]; float linv;
            AttnNext nx; nx.has = i < 3;
            { const int s_ = v & 3, qbn = i == 0 ? 15 - s_ : (i == 1 ? 4 + s_ : 11 - s_); nx.qrow = QM + (size_t)(kv_row0 + 256 * qbn + 32 * wave + r) * 768 + hh * 96; nx.Kg = KC + hh * 96; nx.Vg = VC + hh * 64; nx.cb_real = nullptr; nx.cb_meta = nullptr; nx.kv_row0 = kv_row0; nx.first_tile = 0; }
            attn_pass<96, 64, false, false, false, true, true, 0>(lds, QM + (size_t)qrow * 768 + hh * 96, KC + hh * 96, 768, VC + hh * 64, 512, kv_row0, NT, qp_lo + r, qp_lo, qp_lo + 31, nullptr, nullptr, o, linv, cv_it, NGW, CV, cscr, 0.f, &cy, &nx);
            attn_store<64>(o, linv, HN + (size_t)qrow * 1024 + 512 + hh * 64, h, !meta || (wave == 0 && r < 16));
        }
#pragma unroll 1
        for (; cv_it < MOE_CONV_ITEMS; cv_it += NGW) { const ConvItem ci = moe_conv_item(cv_it, CV); f32x4 cvv[8]; tr_load(ci.W, ci.ldw, ci.k0, ci.n0, lane, cvv); tr_finish(cvv, ci.WT, ci.Kd, ci.drow0, ci.k0, cscr, lane, ci.fp8); }
    }
    SEAM(4);
    PHASE(5) { PH(); PH_TABLES();
        for (int j = vcu; j < 32; j += G) { f32x4 c0, c1; mini_pair(HN + (size_t)META0 * DM, 1024, 8, (const bf16*)(ws + WS_WOUT0), 32 * j, 32 * j + 16, lane, wave, (LAS float*)lds, c0, c1); if (wave != 0) continue;
            const size_t off = (size_t)(lane & 15) * DM + 32 * j + 4 * (lane >> 4);
            *(GAS f32x4*)(HMETA + off) = *(const GAS f32x4*)(A->in[I_META] + off) + c0; *(GAS f32x4*)(HMETA + off + 16) = *(const GAS f32x4*)(A->in[I_META] + off + 16) + c1; }
        pg8::Gemm g{HN, (const bf16*)(ws + WS_WOUT0), NTOK, 1024, 1024}; pg8::StaticOrder S; S.init(NTOK, 1024, G, (int)blockIdx.x);
        pg8::EpiResidP<false, true> E{A->in[I_X], ws + WS_H16, nullptr, 1 << 20};
        pg8::gemm_phase<pg8::EpiResidP<false, true>, pg8::StaticOrder, true, true>(lds + RING_OFF, g, S, E);
    }
    SEAM(5);
    PHASE(6) { PH(); PH_TABLES();
        const bf16* H1 = (const bf16*)(ws + WS_H16); RowRaw<true> ca, cb, na, nb; row_raw_load<true>(H1 + (size_t)r0_ * DM, lane, ca); row_raw_load<true>(H1 + (size_t)(r0_ + WPB) * DM, lane, cb);
        { float* RS = (float*)(ws + WS_RSC);
          for (int it_ = 0, row = r0_; it_ < NIT_; ++it_, row += 2 * WPB) { const int rb = row + WPB, nrow = row + 2 * WPB; const bool more = it_ + 1 < NIT_; f32x4 va[4], vb[4];
            if (more) { row_raw_load<true>(H1 + (size_t)nrow * DM, lane, na); row_raw_load<true>(H1 + (size_t)(nrow + WPB) * DM, lane, nb); }
            rms_row2_i8<true>(ca, cb, A->in[I_LN_FFN_E], ws + WS_HN + (size_t)row * DM, ws + WS_HN + (size_t)rb * DM, RS + row, RS + rb, lane, va, vb);
            if (more) { ca = na; cb = nb; } } }
        for (int row = NTOK + gw; row < MR; row += NGW) { f32x4 v[4];
            if (row - NTOK < 16) rms_row_q(HMETA + (size_t)(row - NTOK) * DM, A->in[I_LN_FFN_E], HN + (size_t)row * DM, ws + WS_HN + (size_t)row * DM, (float*)(ws + WS_RSC) + row, lane, v);
            else zero_row(HN + (size_t)row * DM, lane); }
    }
    SEAM(6);
    PHASE(7) { PH(); PH_TABLES();
        for (int j = vcu; j < DFF / 16; j += G) { f32x4 c0, c1; const int cc = 16 * j, rb = 256 * (cc / 128) + (cc % 128);
            mini_pair_i8(ws + WS_HN + (size_t)META0 * DM, 1024, 8, ws + WS_WGU0Q, rb, rb + 128, (const float*)(ws + WS_RSC) + META0, (const float*)(ws + WS_CSC), lane, wave, (LAS float*)lds, c0, c1); if (wave != 0) continue;
            f32x4 act;
#pragma unroll
            for (int e = 0; e < 4; ++e) act[e] = c0[e] * __builtin_amdgcn_rcpf(1.f + __builtin_amdgcn_exp2f(-LOG2E * c0[e])) * c1[e];
            st4bf((bf16*)(ws + WS_ACT0) + (size_t)(META0 + (lane & 15)) * DFF + cc + 4 * (lane >> 4), act); }
        int k7 = 512; asm volatile("" : "+s"(k7));
        pg8::Gemm g{(const bf16*)(ws + WS_HN), (const bf16*)(ws + WS_WGU0Q), NTOK, 2 * DFF, k7}; pg8::StaticOrder S; S.init(NTOK, 2 * DFF, G, (int)blockIdx.x);
        pg8::EpiSwigluI8 E{(bf16*)(ws + WS_ACT0), DFF, (const float*)(ws + WS_RSC), (const float*)(ws + WS_CSC)};
        pg8::gemm_phase<pg8::EpiSwigluI8, pg8::StaticOrder, true, true, false, true>(lds + RING_OFF, g, S, E);
    }
    SEAM(7);
    PHASE(8) { PH(); PH_TABLES();
        for (int j = vcu; j < 32; j += G) { f32x4 c0, c1; mini_pair((const bf16*)(ws + WS_ACT0) + (size_t)META0 * DFF, DFF, 8, (const bf16*)(ws + WS_WDN0), 32 * j, 32 * j + 16, lane, wave, (LAS float*)lds, c0, c1); if (wave != 0) continue;
            const size_t off = (size_t)(lane & 15) * DM + 32 * j + 4 * (lane >> 4);
            *(GAS f32x4*)(HMETA + off) = *(const GAS f32x4*)(HMETA + off) + c0; *(GAS f32x4*)(HMETA + off + 16) = *(const GAS f32x4*)(HMETA + off + 16) + c1; }
        pg8::Gemm g{(const bf16*)(ws + WS_ACT0), (const bf16*)(ws + WS_WDN0), NTOK, 1024, DFF}; pg8::StaticOrder S; S.init(NTOK, 1024, G, (int)blockIdx.x);
        pg8::EpiResidP<true, true> E{ws + WS_H16, ws + WS_H16, nullptr, 1 << 20};
        pg8::gemm_phase<pg8::EpiResidP<true, true>, pg8::StaticOrder, true, true>(lds + RING_OFF, g, S, E);
    }
    SEAM(8);
    PHASE(9) { PH(); PH_TABLES();
        W8 WF; w8_load(WF, A->in[I_W_IN_O] + 3072, 3080, lane);
        float* LF = (float*)(ws + WS_LF); const int fe_ = bitrev3(lane & 7); const float fb_ = A->in[I_B_FORGET][fe_];
#define LF_ROW(v_, row_) do { const float val_ = dot8_reduce(v_, WF, lane); \
            if (lane < 8) { const float f_ = val_ + fb_; LF[(size_t)(row_) * 8 + fe_] = fminf(f_, 0.f) - LN2 * __builtin_amdgcn_logf(1.f + __builtin_amdgcn_exp2f(-fabsf(f_) * LOG2E)); } } while (0)
        { const bf16* H2 = (const bf16*)(ws + WS_H16); RowRaw<true> ca, cb, na, nb; row_raw_load<true>(H2 + (size_t)r0_ * DM, lane, ca); row_raw_load<true>(H2 + (size_t)(r0_ + WPB) * DM, lane, cb);
          for (int it_ = 0, row = r0_; it_ < NIT_; ++it_, row += 2 * WPB) { f32x4 va[4], vb[4]; const int rb = row + WPB, nrow = row + 2 * WPB; const bool more = it_ + 1 < NIT_;
            if (more) { row_raw_load<true>(H2 + (size_t)nrow * DM, lane, na); row_raw_load<true>(H2 + (size_t)(nrow + WPB) * DM, lane, nb); }
            rms_row2_i8<true>(ca, cb, A->in[I_LN_MIX_O], ws + WS_HN + (size_t)row * DM, ws + WS_HN + (size_t)rb * DM, (float*)(ws + WS_RSC) + row, (float*)(ws + WS_RSC) + rb, lane, va, vb);
            LF_ROW(va, row); LF_ROW(vb, rb);
            if (more) { ca = na; cb = nb; } } }
        for (int row = NTOK + gw; row < MR; row += NGW) { f32x4 v[4];
            if (row - NTOK >= 16) { zero_row(HN + (size_t)row * DM, lane); continue; }
            rms_row_q(HMETA + (size_t)(row - NTOK) * DM, A->in[I_LN_MIX_O], HN + (size_t)row * DM, ws + WS_HN + (size_t)row * DM, (float*)(ws + WS_RSC) + row, lane, v);
            LF_ROW(v, row); }
#undef LF_ROW
        __syncthreads();
    }
    SEAM(9);
    PHASE(10) { PH(); PH_TABLES();
        if (vcu >= 128 && vcu < 192) {
            const float* LF = (const float*)(ws + WS_LF); float* CF = (float*)(ws + WS_CFOX); float* CMT = (float*)(ws + WS_CMETA);
            const int bh = vcu - 128, b = bh >> 3, hh = bh & 7; LAS float* wtot = (LAS float*)lds;
            if (wave == 0) { float mv = lane < 16 ? LF[(size_t)(META0 + lane) * 8 + hh] : 0.f;
#pragma unroll
                for (int o = 1; o < 16; o <<= 1) { const float t = __shfl_up(mv, o); if (lane >= o) mv += t; }
                if (b == 0 && lane < 16) CMT[hh * 64 + lane] = mv * LOG2E;
                if (lane == 15) wtot[8] = mv; }
            const float* src = LF + (size_t)(b * SEQ + 8 * tid) * 8 + hh; float v[8];
#pragma unroll
            for (int k = 0; k < 8; ++k) v[k] = src[k * 8];
#pragma unroll
            for (int k = 1; k < 8; ++k) v[k] += v[k - 1];
            const float tot = v[7]; float inc = tot;
#pragma unroll
            for (int o = 1; o < 64; o <<= 1) { const float t = __shfl_up(inc, o); if (lane >= o) inc += t; }
            if (lane == 63) wtot[wave] = inc;
            __syncthreads();
            float off = wtot[8] + (inc - tot);
#pragma unroll
            for (int w = 0; w < 7; ++w) off += (w < wave) ? wtot[w] : 0.f;
            float* dst = CF + (size_t)(b * 8 + hh) * SEQ + 8 * tid;
            f32x4 o0, o1; o0.x = (v[0] + off) * LOG2E; o0.y = (v[1] + off) * LOG2E; o0.z = (v[2] + off) * LOG2E; o0.w = (v[3] + off) * LOG2E; o1.x = (v[4] + off) * LOG2E; o1.y = (v[5] + off) * LOG2E; o1.z = (v[6] + off) * LOG2E; o1.w = (v[7] + off) * LOG2E;
            *(GAS f32x4*)dst = o0; *(GAS f32x4*)(dst + 4) = o1;
            __syncthreads();
        }
        for (int j = vcu; j < 96; j += G) { f32x4 c0, c1; mini_pair_i8(ws + WS_HN + (size_t)META0 * DM, 1024, 8, ws + WS_WIN1Q, 32 * j, 32 * j + 16, (const float*)(ws + WS_RSC) + META0, (const float*)(ws + WS_CSC1), lane, wave, (LAS float*)lds, c0, c1); if (wave != 0) continue;
            const int m16 = lane & 15, fq = lane >> 4;
            if (j < 32 && (j & 1) == 0) {
                const f32x4 cc = *(const GAS f32x4*)(cosD + m16 * 8 + 4 * (fq & 1)), ss = *(const GAS f32x4*)(sinD + m16 * 8 + 4 * (fq & 1));
#pragma unroll
                for (int e = 0; e < 4; ++e) { const float o = __shfl_xor(c0[e], 32); c0[e] = fq < 2 ? c0[e] * cc[e] - o * ss[e] : c0[e] * cc[e] + o * ss[e]; } }
            if (j >= 64 && j < 80) {
                float ss = (c0[0] * c0[0] + c0[1] * c0[1]) + (c0[2] * c0[2] + c0[3] * c0[3]) + (c1[0] * c1[0] + c1[1] * c1[1]) + (c1[2] * c1[2] + c1[3] * c1[3]);
                ss += __shfl_xor(ss, 16); ss += __shfl_xor(ss, 32);
#pragma unroll
                for (int o_ = 1; o_ < 16; o_ <<= 1) ss = fmaxf(ss, __shfl_xor(ss, o_));
                const int colk = 32 * j - 2048;
                if (lane < 8) atomicMax((unsigned*)(ws + WS_CTL) + CW_KN + (lane * 8 + (colk >> 6)) * 2 + ((colk >> 5) & 1), __float_as_uint(ss)); }
            bf16* dst = (bf16*)(ws + WS_PROJ1) + (size_t)(META0 + m16) * 3072 + 32 * j + 4 * fq; st4bf(dst, c0); st4bf(dst + 16, c1); }
        zero_fill16(ws + WS_PROJ1 + (size_t)(META0 + 16) * 3072 * 2, 48, 3072 * 2, 0, 3072 * 2, gt, NGT);
        int k10 = 512; asm volatile("" : "+s"(k10));
        pg8::Gemm g{(const bf16*)(ws + WS_HN), (const bf16*)(ws + WS_WIN1Q), NTOK, 3072, k10}; pg8::StaticOrder S; S.init(NTOK, 3072, G, (int)blockIdx.x);
        pg8::EpiIn1I8 E{(bf16*)(ws + WS_PROJ1), cosD, sinD, (const float*)(ws + WS_RSC), (const float*)(ws + WS_CSC1), (unsigned*)(ws + WS_CTL) + CW_KN};
        pg8::gemm_phase<pg8::EpiIn1I8, pg8::StaticOrder, true, true, false, true>(lds + RING_OFF, g, S, E);
    }
    SEAM(10);
    PHASE(11) { PH(); PH_TABLES();
        const bf16* P1 = (const bf16*)(ws + WS_PROJ1);
        const int v = vcu, r = lane & 31, h = lane >> 5;
        int cvd = MOE_CONV_ITEMS; const MoeConv CVD{nullptr, nullptr, nullptr, nullptr, nullptr};
        const float lam = __builtin_amdgcn_exp2f(wave_sum(A->in[I_LQ1][lane] * A->in[I_LK1][lane]) * LOG2E) - __builtin_amdgcn_exp2f(wave_sum(A->in[I_LQ2][lane] * A->in[I_LK2][lane]) * LOG2E) + LAM_INIT;
#pragma unroll 1
        for (int i = 0; i < 2; ++i) {
            const int s = v & 7, bh = v >> 3, b = bh >> 2, hh = bh & 3, qb = i == 0 ? s : 15 - s;
            const int q_row0 = b * SEQ + 256 * qb, NT = 4 * qb + 4, qp_lo = 16 + 256 * qb + 32 * wave, qrow = q_row0 + 32 * wave + r;
            bf16* orow = HN + (size_t)qrow * 1024 + hh * 128;
#pragma unroll 1
            for (int m = 0; m < 2; ++m) {
                f32x16 o[4]; float linv;
                attn_pass<64, 128, false, false, false, true, false>(lds, P1 + (size_t)qrow * 3072 + hh * 128 + m * 64, P1 + 512 + hh * 128 + m * 64, 3072, P1 + 1024 + hh * 128, 3072, b * SEQ, NT, qp_lo + r, qp_lo, qp_lo + 31, nullptr, nullptr, o, linv, cvd, 0, CVD, nullptr);
                if (m == 0) {
                    attn_store<128>(o, linv, orow, h, true);
                } else {
                    float ss = 0.f;
#pragma unroll
                    for (int dt = 0; dt < 4; ++dt)
#pragma unroll
                        for (int g2 = 0; g2 < 4; g2 += 2) { const v4u pw = *(const GAS v4u*)(orow + 32 * dt + 8 * g2 + 8 * h);
                            const auto rx = __builtin_amdgcn_permlane32_swap(pw.x, pw.z, false, false); const auto ry = __builtin_amdgcn_permlane32_swap(pw.y, pw.w, false, false);
#pragma unroll
                            for (int gg = 0; gg < 2; ++gg) { const int g = g2 + gg; v2u p1; p1.x = rx[gg]; p1.y = ry[gg];
                            const float a0 = bf2f(p1.x & 0xffffu) - lam * o[dt][4 * g] * linv, a1 = __uint_as_float(p1.x & 0xffff0000u) - lam * o[dt][4 * g + 1] * linv;
                            const float a2 = bf2f(p1.y & 0xffffu) - lam * o[dt][4 * g + 2] * linv, a3 = __uint_as_float(p1.y & 0xffff0000u) - lam * o[dt][4 * g + 3] * linv;
                            o[dt][4 * g] = a0; o[dt][4 * g + 1] = a1; o[dt][4 * g + 2] = a2; o[dt][4 * g + 3] = a3; ss += (a0 * a0 + a1 * a1) + (a2 * a2 + a3 * a3); } }
                    ss += __shfl_xor(ss, 32);
                    const float rstd = (1.f - LAM_INIT) / sqrtf(ss * (1.f / 128.f) + EPS);
#pragma unroll
                    for (int dt = 0; dt < 4; ++dt)
#pragma unroll
                        for (int g = 0; g < 4; g += 2) { const int d0 = 32 * dt + 8 * g + 4 * h; const f32x4 gs = *(const GAS f32x4*)(A->in[I_SUBLN] + d0), gt_ = *(const GAS f32x4*)(A->in[I_SUBLN] + d0 + 8);
                            v2u wa, wb; wa.x = pk2bf(o[dt][4 * g] * rstd * gs.x, o[dt][4 * g + 1] * rstd * gs.y); wa.y = pk2bf(o[dt][4 * g + 2] * rstd * gs.z, o[dt][4 * g + 3] * rstd * gs.w);
                            wb.x = pk2bf(o[dt][4 * g + 4] * rstd * gt_.x, o[dt][4 * g + 5] * rstd * gt_.y); wb.y = pk2bf(o[dt][4 * g + 6] * rstd * gt_.z, o[dt][4 * g + 7] * rstd * gt_.w);
                            st_pair16(orow + 32 * dt + 8 * g, wa, wb, h, true); }
                }
            }
        }
        const float* CF = (const float*)(ws + WS_CFOX); const float* CMT = (const float*)(ws + WS_CMETA);
        AttnCarry<64, 64> cyf; cyf.valid = false;
#pragma unroll 1
        for (int i = 0; i < 4; ++i) {
            const int b = v >> 5, w_ = v & 31, ha = w_ & 3, s = w_ >> 2, hh = i < 2 ? ha : 7 - ha, qb = (i & 1) ? 15 - s : s;
            const int q_row0 = b * SEQ + 256 * qb, NT = 4 * qb + 4, qp_lo = 16 + 256 * qb + 32 * wave, qrow = q_row0 + 32 * wave + r;
            const unsigned* KN = (const unsigned*)(ws + WS_CTL) + CW_KN + (b * 8 + hh) * 2; const float kmax = sqrtf(__uint_as_float(KN[0]) + __uint_as_float(KN[1]));
            AttnNext nxf; nxf.has = i < 3;
            { const int in_ = i + 1, hn_ = in_ < 2 ? ha : 7 - ha, qbn = (in_ & 1) ? 15 - s : s;
              nxf.qrow = P1 + (size_t)(b * SEQ + 256 * qbn + 32 * wave + r) * 3072 + 1536 + hn_ * 64; nxf.Kg = P1 + 2048 + hn_ * 64; nxf.Vg = P1 + 2560 + hn_ * 64;
              nxf.cb_real = CF + (size_t)(b * 8 + hn_) * SEQ; nxf.cb_meta = CMT + hn_ * 64; nxf.kv_row0 = b * SEQ; nxf.first_tile = 4 * qbn + 4; }
            f32x16 o[2]; float linv;
            attn_pass<64, 64, true, true, true, true, false, 4>(lds, P1 + (size_t)qrow * 3072 + 1536 + hh * 64, P1 + 2048 + hh * 64, 3072, P1 + 2560 + hh * 64, 3072, b * SEQ, NT, qp_lo + r, qp_lo, qp_lo + 31,
                                          CF + (size_t)(b * 8 + hh) * SEQ, CMT + hh * 64, o, linv, cvd, 0, CVD, nullptr, kmax, &cyf, &nxf);
            attn_store<64>(o, linv, HN + (size_t)qrow * 1024 + 512 + hh * 64, h, true);
        }
    }
    SEAM(11);
    PHASE(12) { PH(); PH_TABLES();
        pg8::Gemm g{HN, (const bf16*)(ws + WS_WOUT1), NTOK, 1024, 1024}; pg8::StaticOrder S; S.init(NTOK, 1024, G, (int)blockIdx.x);
        pg8::EpiResidP<true, true> E{ws + WS_H16, ws + WS_H3A, ws + WS_H3B, H3_SPLIT / 256};
        pg8::gemm_phase<pg8::EpiResidP<true, true>, pg8::StaticOrder, true, true>(lds + RING_OFF, g, S, E);
    }
    SEAM(12);
#define TOK ((int4*)(ws + WS_TOK))
#define XS8 ((unsigned char*)(ws + WS_XS8))
#define YB ((bf16*)(ws + WS_Y))
    PHASE(13) { PH(); PH_TABLES();
        LAS float* wl = (LAS float*)lds;
        LAS unsigned* lcnt = (LAS unsigned*)(lds + 32768); LAS unsigned* lbase = lcnt + 16; typedef int v4i_t __attribute__((ext_vector_type(4))); LAS v4i_t* rec = (LAS v4i_t*)(lds + 32768 + 256);
        W8 WR; w8_load(WR, A->in[I_W_ROUTER], 8, lane);
        if (tid < 8) lcnt[tid] = 0u;
        __syncthreads();
#define ROUTE_ROW(v_, k_) do { float d[8]; { const int val_ = __float_as_int(dot8_reduce(v_, WR, lane)); \
            d[0] = __int_as_float(__builtin_amdgcn_readlane(val_, 0)); d[1] = __int_as_float(__builtin_amdgcn_readlane(val_, 4)); d[2] = __int_as_float(__builtin_amdgcn_readlane(val_, 2)); d[3] = __int_as_float(__builtin_amdgcn_readlane(val_, 6)); \
            d[4] = __int_as_float(__builtin_amdgcn_readlane(val_, 1)); d[5] = __int_as_float(__builtin_amdgcn_readlane(val_, 5)); d[6] = __int_as_float(__builtin_amdgcn_readlane(val_, 3)); d[7] = __int_as_float(__builtin_amdgcn_readlane(val_, 7)); } \
            int e0 = 0; float v0 = d[0]; \
            _Pragma("unroll") for (int e = 1; e < 8; ++e) if (d[e] > v0) { v0 = d[e]; e0 = e; } \
            int e1 = -1; float v1 = -INFINITY; \
            _Pragma("unroll") for (int e = 0; e < 8; ++e) if (e != e0 && d[e] > v1) { v1 = d[e]; e1 = e; } \
            if (lane == 0) { const float g0 = 1.f / (1.f + __builtin_amdgcn_exp2f((v1 - v0) * LOG2E)); \
                const int p0 = (int)__hip_atomic_fetch_add(lcnt + e0, 1u, __ATOMIC_RELAXED, __HIP_MEMORY_SCOPE_WORKGROUP); \
                const int p1 = (int)__hip_atomic_fetch_add(lcnt + e1, 1u, __ATOMIC_RELAXED, __HIP_MEMORY_SCOPE_WORKGROUP); \
                rec[wave * 16 + (k_)] = (v4i_t){e0 | (e1 << 8), p0, p1, __float_as_int(g0)}; } } while (0)
        { int k = 0;
          RowRaw<true> ca, cb, na, nb; row_raw_load<true>(h3row(ws, r0_), lane, ca); row_raw_load<true>(h3row(ws, r0_ + WPB), lane, cb);
          for (int it_ = 0, row = r0_; it_ < NIT_; ++it_, row += 2 * WPB, k += 2) { f32x4 va[4], vb[4]; const int rb = row + WPB, nrow = row + 2 * WPB; const bool more = it_ + 1 < NIT_;
            if (more) { row_raw_load<true>(h3row(ws, nrow), lane, na); row_raw_load<true>(h3row(ws, nrow + WPB), lane, nb); }
            rms_row2_f8<true>(ca, cb, A->in[I_LN_FFN_O], XS8 + (size_t)row * DM, XS8 + (size_t)rb * DM, lane, va, vb);
            ROUTE_ROW(va, k); ROUTE_ROW(vb, k + 1);
            if (more) { ca = na; cb = nb; } } }
#undef ROUTE_ROW
        __syncthreads();
        if (tid < 8) lbase[tid] = __hip_atomic_fetch_add(((unsigned*)(ws + WS_CTL)) + CW_CNT + 64 * tid, lcnt[tid], __ATOMIC_RELAXED, __HIP_MEMORY_SCOPE_AGENT);
        __syncthreads();
        if (lane < 16) { const int row = r0_ + lane * WPB; if (lane < 2 * NIT_) { const v4i_t rc = rec[wave * 16 + lane]; const int e0 = rc.x & 255, e1 = rc.x >> 8;
            const int s0_ = (int)lbase[e0] + rc.y, s1_ = (int)lbase[e1] + rc.z; int* EL = (int*)(ws + WS_ELIST);
            TOK[row] = make_int4(rc.x, s0_, s1_, rc.w); EL[e0 * 32768 + s0_] = row; EL[e1 * 32768 + s1_] = row; } }
        __syncthreads();
    }
    SEAM(13);
#define LOAD_TB() int tb[9]; { unsigned* cnt_ = (unsigned*)(ws + WS_CTL) + CW_CNT; tb[0] = 0; \
        _Pragma("unroll") for (int e_ = 0; e_ < 8; ++e_) { const int c_ = (int)__hip_atomic_load(cnt_ + 64 * e_, __ATOMIC_RELAXED, __HIP_MEMORY_SCOPE_AGENT); tb[e_ + 1] = tb[e_] + ((c_ + 255) >> 8); } }
    int clo, chi; { CArgs A = fresh_args(); clo = A->clo; chi = A->chi; }
#define TB_OF(e) ((e) == 0 ? tb[0] : (e) == 1 ? tb[1] : (e) == 2 ? tb[2] : (e) == 3 ? tb[3] : (e) == 4 ? tb[4] : (e) == 5 ? tb[5] : (e) == 6 ? tb[6] : tb[7])
    for (int c = clo; c < chi; ++c) {
#define CHUNK_RANGE() const int t0 = c * MOE_CT; int nt = tb[8] - t0; nt = nt < 0 ? 0 : ((c + 1 < MOE_NCHUNK && nt > MOE_CT) ? MOE_CT : (nt > MOE_CT_MAX ? MOE_CT_MAX : nt))
        if (IN(15)) { PH(); PH_TABLES(); LOAD_TB(); CHUNK_RANGE();
            int k8 = 512; asm volatile("" : "+s"(k8));
            pg8::Gemm g{(const bf16*)XS8, (const bf16*)(ws + WS_WMG), nt * 256, 2 * DFE, k8};
            pg8::MoeOrder S; S.so.init(nt * 256, 2 * DFE, G, (int)blockIdx.x); S.tb1 = tb[1]; S.tb2 = tb[2]; S.tb3 = tb[3]; S.tb4 = tb[4]; S.tb5 = tb[5]; S.tb6 = tb[6]; S.tb7 = tb[7]; S.t0 = t0; S.nper = 28; S.glist = (const int*)(ws + WS_ELIST);
            pg8::EpiSwiglu E{(bf16*)(ws + WS_ACTC), DFE, 28, 1.f / WMG_SCALE, 1, (unsigned char*)A->out, ACT_SPLIT};
            pg8::gemm_phase<pg8::EpiSwiglu, pg8::MoeOrder, true, true, true, false, true>(lds + RING_OFF, g, S, E);
            if (IN(16)) xcd_barrier(bar);
        }
        if (IN(16)) { PH(); PH_TABLES(); LOAD_TB(); CHUNK_RANGE();
            const int ntm = (t0 + nt > 256) ? 256 - t0 : nt, ntr = nt - ntm;
            { int kf = DFE / 2; asm volatile("" : "+s"(kf));
              pg8::Gemm g{(const bf16*)(ws + WS_ACTC), (const bf16*)(ws + WS_WMD), ntm * 256, 1024, kf, 0, (const bf16*)A->out, ACT_SPLIT};
              pg8::MoeOrder S; S.so.init(ntm * 256, 1024, G, (int)blockIdx.x); S.tb1 = tb[1]; S.tb2 = tb[2]; S.tb3 = tb[3]; S.tb4 = tb[4]; S.tb5 = tb[5]; S.tb6 = tb[6]; S.tb7 = tb[7]; S.t0 = t0; S.nper = 4;
              pg8::EpiPlain E{YB + (size_t)t0 * 256 * DM, 1024, 4, 1.f / WMG_SCALE};
              pg8::gemm_phase<pg8::EpiPlain, pg8::MoeOrder, true, true, true>(lds + RING_OFF, g, S, E); }
            if (ntr > 0 && (int)blockIdx.x < 36 * YP_SPLIT) { const int kh = (int)blockIdx.x / 36; int kq = DFE / (2 * YP_SPLIT); asm volatile("" : "+s"(kq));
              pg8::Gemm g{(const bf16*)((const unsigned char*)A->out + (size_t)(t0 + ntm - ACT_SPLIT) * 256 * DFE + (size_t)kh * (DFE / YP_SPLIT)), (const bf16*)(ws + WS_WMD + (size_t)kh * (DFE / YP_SPLIT)), ntr * 256, 1024, kq, DFE / 2};
              pg8::MoeOrder S; S.so.init(ntr * 256, 1024, 36, (int)blockIdx.x % 36); S.tb1 = tb[1]; S.tb2 = tb[2]; S.tb3 = tb[3]; S.tb4 = tb[4]; S.tb5 = tb[5]; S.tb6 = tb[6]; S.tb7 = tb[7]; S.t0 = t0 + ntm; S.nper = 4;
              pg8::EpiPlain E{(bf16*)(ws + WS_YP) + (size_t)kh * 7 * 256 * DM, 1024, 4, 1.f / WMG_SCALE};
              pg8::gemm_phase<pg8::EpiPlain, pg8::MoeOrder, true, true, true>(lds + RING_OFF, g, S, E); }
            if ((c + 1 < chi) ? IN(15) : IN(17)) xcd_barrier(bar);
        }
    }
    if (IN(17)) { PH(); PH_TABLES(); LOAD_TB();
#define FIN_ADDR(ti_, r0_, r1_, g0_) const int e0##r0_ = ti_.x & 255, e1##r0_ = ti_.x >> 8; const float g0_ = __int_as_float(ti_.w); \
        const size_t r0_ = (size_t)TB_OF(e0##r0_) * 256 + ti_.y, r1_ = (size_t)TB_OF(e1##r0_) * 256 + ti_.z
#define FIN_LOADS(row_, r0_, r1_, X, P, Q) GAS f32x4* xr##row_ = (GAS f32x4*)(A->out + (size_t)(row_) * DM) + lane; const GAS v2u* hx##row_ = (const GAS v2u*)h3row(ws, row_) + lane; v2u hw##row_[4]; \
        { const GAS v2u* y0_ = (const GAS v2u*)(YB + (r0_) * DM) + lane; const GAS v2u* y1_ = (const GAS v2u*)(YB + (r1_) * DM) + lane; \
          _Pragma("unroll") for (int j = 0; j < 4; ++j) { hw##row_[j] = hx##row_[64 * j]; P[j] = y0_[64 * j]; Q[j] = y1_[64 * j]; } \
          _Pragma("unroll") for (int j = 0; j < 4; ++j) { X[j].x = __uint_as_float(hw##row_[j].x << 16); X[j].y = __uint_as_float(hw##row_[j].x & 0xffff0000u); X[j].z = __uint_as_float(hw##row_[j].y << 16); X[j].w = __uint_as_float(hw##row_[j].y & 0xffff0000u); } }
#define FIN_SPLIT(r_, P) do { if ((r_) >= 65536) { const GAS v2u* z_ = (const GAS v2u*)((const bf16*)(ws + WS_YP) + ((r_) - 65536) * DM) + lane; \
          _Pragma("unroll") for (int j = 0; j < 4; ++j) { f32x4 t_ = {0.f, 0.f, 0.f, 0.f}; \
            _Pragma("unroll") for (int kh = 0; kh < YP_SPLIT; ++kh) { const v2u w_ = z_[(size_t)kh * 7 * 256 * (DM / 4) + 64 * j]; t_.x += bf2f(w_.x & 0xffffu); t_.y += __uint_as_float(w_.x & 0xffff0000u); t_.z += bf2f(w_.y & 0xffffu); t_.w += __uint_as_float(w_.y & 0xffff0000u); } \
            v2u o_; o_.x = pk2bf(t_.x, t_.y); o_.y = pk2bf(t_.z, t_.w); P[j] = o_; } } } while (0)
#define FIN_COMBINE(X, P, Q, g0_, S) do { const float g1_ = 1.f - (g0_); S = 0.f; \
          _Pragma("unroll") for (int j = 0; j < 4; ++j) { f32x4 x = X[j]; const v2u p = P[j], q = Q[j]; \
            x.x += (g0_) * bf2f(p.x & 0xffffu) + g1_ * bf2f(q.x & 0xffffu); x.y += (g0_) * __uint_as_float(p.x & 0xffff0000u) + g1_ * __uint_as_float(q.x & 0xffff0000u); \
            x.z += (g0_) * bf2f(p.y & 0xffffu) + g1_ * bf2f(q.y & 0xffffu); x.w += (g0_) * __uint_as_float(p.y & 0xffff0000u) + g1_ * __uint_as_float(q.y & 0xffff0000u); \
            X[j] = x; S += (x.x * x.x + x.y * x.y) + (x.z * x.z + x.w * x.w); } } while (0)
        { struct FinRaw { v2u h[4], p[4], q[4]; };
          const int4 tk_ = TOK[r0_ + WPB * (lane < 2 * NIT_ ? lane : 0)];
#define FIN_TOK(j_) make_int4(__builtin_amdgcn_readlane(tk_.x, j_), __builtin_amdgcn_readlane(tk_.y, j_), __builtin_amdgcn_readlane(tk_.z, j_), __builtin_amdgcn_readlane(tk_.w, j_))
#define FIN_ISSUE(R, row_, s0_, s1_) do { const GAS v2u* hx_ = (const GAS v2u*)h3row(ws, row_) + lane; const GAS v2u* y0_ = (const GAS v2u*)(YB + (s0_) * DM) + lane; const GAS v2u* y1_ = (const GAS v2u*)(YB + (s1_) * DM) + lane; \
            _Pragma("unroll") for (int j = 0; j < 4; ++j) { R.h[j] = hx_[64 * j]; R.p[j] = y0_[64 * j]; R.q[j] = y1_[64 * j]; } } while (0)
#define FIN_UNPACK(R, X, P, Q) do { _Pragma("unroll") for (int j = 0; j < 4; ++j) { X[j].x = __uint_as_float(R.h[j].x << 16); X[j].y = __uint_as_float(R.h[j].x & 0xffff0000u); X[j].z = __uint_as_float(R.h[j].y << 16); X[j].w = __uint_as_float(R.h[j].y & 0xffff0000u); P[j] = R.p[j]; Q[j] = R.q[j]; } } while (0)
          FinRaw ca, cb, na, nb; int4 tia = FIN_TOK(0), tib = FIN_TOK(1);
          { FIN_ADDR(tia, fa0, fa1, gfa); FIN_ADDR(tib, fb0, fb1, gfb); FIN_ISSUE(ca, r0_, fa0, fa1); FIN_ISSUE(cb, r0_ + WPB, fb0, fb1); }
          f32x4 gg[4];
#pragma unroll
          for (int j = 0; j < 4; ++j) gg[j] = *((const GAS f32x4*)A->in[I_LN_FINAL] + lane + 64 * j);
          for (int it_ = 0, row = r0_; it_ < NIT_; ++it_, row += 2 * WPB) { const int rowb = row + WPB; const bool more = it_ + 1 < NIT_; int4 tna = tia, tnb = tib;
            if (more) { tna = FIN_TOK(2 * it_ + 2); tnb = FIN_TOK(2 * it_ + 3); FIN_ADDR(tna, na0, na1, gna); FIN_ADDR(tnb, nb0, nb1, gnb); FIN_ISSUE(na, row + 2 * WPB, na0, na1); FIN_ISSUE(nb, rowb + 2 * WPB, nb0, nb1); }
            FIN_ADDR(tia, ra0, ra1, ga); FIN_ADDR(tib, rb0, rb1, gb);
            f32x4 xa[4], xb[4]; v2u pa[4], qa[4], pb[4], qb[4];
            FIN_UNPACK(ca, xa, pa, qa); FIN_UNPACK(cb, xb, pb, qb);
            FIN_SPLIT(ra0, pa); FIN_SPLIT(ra1, qa); FIN_SPLIT(rb0, pb); FIN_SPLIT(rb1, qb);
            float sa, sb; FIN_COMBINE(xa, pa, qa, ga, sa); FIN_COMBINE(xb, pb, qb, gb, sb);
#pragma unroll
            for (int o = 1; o < 64; o <<= 1) { sa += __shfl_xor(sa, o); sb += __shfl_xor(sb, o); }
            const float rsa = 1.f / sqrtf(sa * (1.f / 1024.f) + EPS), rsb = 1.f / sqrtf(sb * (1.f / 1024.f) + EPS);
            GAS f32x4* xrrow = (GAS f32x4*)(A->out + (size_t)row * DM) + lane; GAS f32x4* xrrowb = (GAS f32x4*)(A->out + (size_t)rowb * DM) + lane;
#pragma unroll
            for (int j = 0; j < 4; ++j) { xrrow[64 * j] = xa[j] * rsa * gg[j]; xrrowb[64 * j] = xb[j] * rsb * gg[j]; }
            if (more) { ca = na; cb = nb; tia = tna; tib = tnb; }
          }
#undef FIN_TOK
#undef FIN_ISSUE
#undef FIN_UNPACK
        }
#undef FIN_ADDR
#undef FIN_LOADS
#undef FIN_SPLIT
#undef FIN_COMBINE
    }
#undef IN
#undef SEAM
#undef TB_OF
#undef LOAD_TB
#undef CHUNK_RANGE
#undef TOK
#undef XS8
#undef YB
#undef PH
#undef PH_TABLES
}

#ifndef MK_PER_PHASE
#define MK_PER_PHASE 0
#endif
extern "C" void kernel_launch(void* const* d_in, const int* in_sizes, int n_in, void* d_out, int out_size, void* d_ws, size_t ws_size, hipStream_t stream) {
    static int grid = 0;
    if (grid == 0) {
        if (n_in != 28 || in_sizes[0] != NTOK * DM || out_size != NTOK * DM || ws_size < WS_END) { fprintf(stderr, "kernel_launch: unexpected shapes / workspace (n_in %d, ws %zu, need %zu); nothing launched\n", n_in, ws_size, (size_t)WS_END); grid = -1; return; }
        int dev = 0, cus = 0;
        if (hipGetDevice(&dev) != hipSuccess || hipDeviceGetAttribute(&cus, hipDeviceAttributeMultiprocessorCount, dev) != hipSuccess) { grid = -1; return; }
        if (hipFuncSetAttribute((const void*)hybrid_fwd, hipFuncAttributeMaxDynamicSharedMemorySize, LDS_BYTES) != hipSuccess) { fprintf(stderr, "kernel_launch: hipFuncSetAttribute failed\n"); grid = -1; return; }
        int per_cu = 0;
        if (hipOccupancyMaxActiveBlocksPerMultiprocessor(&per_cu, (const void*)hybrid_fwd, NWAVES * 64, LDS_BYTES) != hipSuccess || per_cu < 1) fprintf(stderr, "kernel_launch: occupancy query says %d\n", per_cu);
        (void)hipGetLastError();
        if (cus != 256) { fprintf(stderr, "kernel_launch: built for 256 CUs (unit dealing), found %d; nothing launched\n", cus); grid = -1; return; }
        grid = cus;
    }
    if (grid < 0) return;
    if (hipMemsetAsync((char*)d_ws + WS_CTL, 0, CTL_ZERO_BYTES, stream) != hipSuccess) return;
    Args ha{};
    for (int i = 0; i < 28; ++i) ha.in[i] = (const float*)d_in[i];
    ha.out = (float*)d_out; ha.ws = (unsigned char*)d_ws;
#if MK_PER_PHASE
    for (int p = 0; p < N_PHASES; ++p) {
        if (p == 15) { for (int c = 0; c < MOE_NCHUNK; ++c) { ha.lo = 15; ha.hi = 16; ha.clo = c; ha.chi = c + 1; hipLaunchKernelGGL(hybrid_fwd, dim3(grid), dim3(NWAVES * 64), LDS_BYTES, stream, ha);
                                                               ha.lo = 16; ha.hi = 17; hipLaunchKernelGGL(hybrid_fwd, dim3(grid), dim3(NWAVES * 64), LDS_BYTES, stream, ha); } ++p; continue; }
        ha.lo = p; ha.hi = p + 1; ha.clo = 0; ha.chi = 0;
        hipLaunchKernelGGL(hybrid_fwd, dim3(grid), dim3(NWAVES * 64), LDS_BYTES, stream, ha);
    }
#else
    ha.lo = 0; ha.hi = N_PHASES; ha.clo = 0; ha.chi = MOE_NCHUNK;
    hipLaunchKernelGGL(hybrid_fwd, dim3(grid), dim3(NWAVES * 64), LDS_BYTES, stream, ha);
#endif
}
```

```cpp
#include <hip/hip_runtime.h>
#include <cstdio>
#include <cstdint>
#include <cmath>
namespace pg8 {
#define PG8_LAS __attribute__((address_space(3)))
typedef unsigned short bf16_t;
typedef short bf16x8 __attribute__((ext_vector_type(8)));
typedef float f32x4 __attribute__((ext_vector_type(4)));
typedef unsigned u32x4 __attribute__((ext_vector_type(4)));
typedef int v4i_t __attribute__((ext_vector_type(4))); typedef int v8i_t __attribute__((ext_vector_type(8)));
constexpr int BM = 256, BK = 64, HALF = 128, HTB = HALF * BK * 2  , STAGE_BYTES = 8 * HTB, NXCD = 8, WGM = 8;

__host__ __device__ __forceinline__ int lds_byte(int r, int c) { const int st = (r >> 4) * 2 + (c >> 5), rr = r & 15, cc = c & 31, ob = rr * 64 + cc * 2; return st * 1024 + (ob ^ (((ob >> 9) & 1) << 5)); }
__host__ __device__ __forceinline__ void stage_rc(int b, int& R, int& C) { const int st = b / 1024, sb = b % 1024, swz = sb ^ (((sb >> 9) & 1) << 5); R = (st >> 1) * 16 + swz / 64; C = (st & 1) * 32 + (swz % 64) / 2; }
__host__ __device__ __forceinline__ int perm32(int rho) { const int n = rho >> 4, i = rho & 15; return 8 * (i >> 2) + 4 * n + (i & 3); }

struct Unit { int pm, pn; };
struct Gemm { const bf16_t* A; const bf16_t* Bt; int M, N, K; int ld; const bf16_t* A2; int splitA; };

struct StaticOrder {
    int nM, nN, nwg, G, c;
    __host__ __device__ void init(int M, int N, int G_, int c_) { nM = M / BM; nN = N / BM; nwg = nM * nN; G = G_; c = c_; }
    __host__ __device__ bool next(int i, Unit& u) const {
        const long L = (long)i * G + c; if (L >= nwg) return false;
        int wgid = (int)L; { const int q = nwg / NXCD, r = nwg % NXCD, xcd = wgid % NXCD, off = wgid / NXCD; wgid = (xcd < r ? xcd * (q + 1) : r * (q + 1) + (xcd - r) * q) + off; }
        const int nig = WGM * nN, gid = wgid / nig, fm = gid * WGM, gsz = (nM - fm) < WGM ? (nM - fm) : WGM;
        u.pm = fm + ((wgid % nig) % gsz); u.pn = (wgid % nig) / gsz; return true;
    }
    __device__ __forceinline__ void a_ready(const Unit&) const {}
    __device__ __forceinline__ void done(const Unit&) const {}
    __device__ __forceinline__ int kshift(const Unit&) const { return 0; }
};

__device__ __forceinline__ unsigned cvt_pk_bf16(float lo, float hi) { unsigned r; asm volatile("v_cvt_pk_bf16_f32 %0, %1, %2" : "=v"(r) : "v"(lo), "v"(hi)); return r; }
typedef float f32x2 __attribute__((ext_vector_type(2)));
constexpr int I8_SCALE_OFF = 131072 + 320 + 1024;
template <class Epi, class Sched, bool ALIGN_EPI = false, bool SP2 = false, bool FP8 = false, bool I8 = false, bool GATHER = false>
__device__ __forceinline__ void gemm_phase(PG8_LAS unsigned char* lds, const Gemm g, const Sched& S, const Epi& E) {
    int tid_ = threadIdx.x; asm volatile("" : "+v"(tid_));
    const int tid = tid_, wid = __builtin_amdgcn_readfirstlane(tid >> 6), lane = tid & 63, wr = wid >> 2, wc = wid & 3, fr = lane & 15, fq = lane >> 4;
    const int K = g.K, nt = K / BK, LD = g.ld ? g.ld : g.K;
    unsigned voffA[2], voffB[2];
#pragma unroll
    for (int i = 0; i < 2; ++i) { int R, C; stage_rc(tid * 16 + i * 8192, R, C); const int Rb = Epi::PERM ? ((R & ~31) + perm32(R & 31)) : R;
        voffA[i] = (unsigned)(R * LD + C) * 2u; voffB[i] = (unsigned)(Rb * LD + C) * 2u; }
    const size_t kstep = (size_t)(BK * 2);
    const size_t hstep = (size_t)HALF * LD * 2;
    const size_t tstep = 2 * hstep;
    static_assert(!GATHER || SP2, "GATHER is written for the SP2 schedule");
    const size_t hstepA = GATHER ? 0 : hstep;
    unsigned gcur[2] = {0u, 0u}, gnxt[2] = {0u, 0u}; int gR0 = 0, gC0 = 0; unsigned gcoff = 0u; int gwid = 0;
    if constexpr (GATHER) { int tidg = tid; asm volatile("" : "+v"(tidg));
        stage_rc(tidg * 16, gR0, gC0); gcoff = (unsigned)(gC0 * 2); gwid = __builtin_amdgcn_readfirstlane(tidg >> 6); }
    constexpr int GATHER_OFF = I8_SCALE_OFF + 4096;
#define PG8_GDMA(unit) do { const int* gp_ = S.gbase(unit); _Pragma("unroll") for (int j_ = 0; j_ < 4; ++j_) \
        __builtin_amdgcn_global_load_lds((const unsigned*)(gp_ + (j_ >> 1) * HALF + gR0 + (j_ & 1) * 64), (PG8_LAS unsigned*)(lds + GATHER_OFF + j_ * 2048 + gwid * 256), 4, 0, 0); } while (0)
#define PG8_GREAD(dst) do { const PG8_LAS unsigned* gl_ = (const PG8_LAS unsigned*)(lds + GATHER_OFF + gwid * 256) + lane; const unsigned i0_ = gl_[0], i1_ = gl_[512], i2_ = gl_[1024], i3_ = gl_[1536]; \
        dst[0] = i0_ | (i1_ << 16); dst[1] = i2_ | (i3_ << 16); } while (0)
#define PG8_STAGEA(bufoff, gbase, h, nx) do { if constexpr (GATHER) { const unsigned p_ = (nx) ? gnxt[h] : gcur[h]; unsigned vo_[2]; vo_[0] = (p_ & 0xffffu) * (unsigned)(LD * 2) + gcoff; vo_[1] = (p_ >> 16) * (unsigned)(LD * 2) + gcoff; \
            PG8_STAGE(bufoff, gbase, vo_); } \
        else PG8_STAGE(bufoff, gbase, voffA); } while (0)
    const unsigned ldsw = (unsigned)wid * 1024u;
    const int aoff = lds_byte(wr * 64 + fr, fq * 8), boff = lds_byte(wc * 32 + fr, fq * 8);
#define PG8_SA(b, h) (((b) * 2 + (h)) * HTB)
#define PG8_SB(b, h) ((4 + (b) * 2 + (h)) * HTB)
#define PG8_STAGE(bufoff, gbase, voff) do { _Pragma("unroll") for (int _i = 0; _i < 2; ++_i) \
        __builtin_amdgcn_global_load_lds((const unsigned*)((const char*)(gbase) + (voff)[_i]), (PG8_LAS unsigned*)(lds + (bufoff) + ldsw + _i * 8192), 16, 0, 0); } while (0)
#define PG8_LDA(dst, b, h) do { if constexpr (FP8) { _Pragma("unroll") for (int m = 0; m < 4; ++m) { const v4i_t lo_ = *(const PG8_LAS v4i_t*)(lds + PG8_SA(b, h) + aoff + m * 2048), hi_ = *(const PG8_LAS v4i_t*)(lds + PG8_SA(b, h) + aoff + m * 2048 + 1024); dst##8[m] = __builtin_shufflevector(lo_, hi_, 0, 1, 2, 3, 4, 5, 6, 7); } } \
        else { _Pragma("unroll") for (int m = 0; m < 4; ++m) _Pragma("unroll") for (int k = 0; k < 2; ++k) dst[m][k] = *(const PG8_LAS bf16x8*)(lds + PG8_SA(b, h) + aoff + m * 2048 + k * 1024); } } while (0)
#define PG8_LDB(dst, b, h) do { if constexpr (FP8) { _Pragma("unroll") for (int n = 0; n < 2; ++n) { const v4i_t lo_ = *(const PG8_LAS v4i_t*)(lds + PG8_SB(b, h) + boff + n * 2048), hi_ = *(const PG8_LAS v4i_t*)(lds + PG8_SB(b, h) + boff + n * 2048 + 1024); dst##8[n] = __builtin_shufflevector(lo_, hi_, 0, 1, 2, 3, 4, 5, 6, 7); } } \
        else { _Pragma("unroll") for (int n = 0; n < 2; ++n) _Pragma("unroll") for (int k = 0; k < 2; ++k) dst[n][k] = *(const PG8_LAS bf16x8*)(lds + PG8_SB(b, h) + boff + n * 2048 + k * 1024); } } while (0)
#define PG8_CAT8(lo, hi) __builtin_shufflevector(__builtin_bit_cast(v4i_t, lo), __builtin_bit_cast(v4i_t, hi), 0, 1, 2, 3, 4, 5, 6, 7)
#define PG8_MMA(ai, bj, At, Bt) do { __builtin_amdgcn_s_setprio(1); \
        if constexpr (FP8) { _Pragma("unroll") for (int m = 0; m < 4; ++m) _Pragma("unroll") for (int n = 0; n < 2; ++n) \
            asm volatile("v_mfma_scale_f32_16x16x128_f8f6f4 %0, %1, %2, %0, %3, %3 op_sel_hi:[0,0,0]" : "+v"(acc[ai][bj][m][n]) : "v"(Bt##8[n]), "v"(At##8[m]), "v"(one_scale)); }   \
        else if constexpr (I8) { _Pragma("unroll") for (int m = 0; m < 4; ++m) _Pragma("unroll") for (int n = 0; n < 2; ++n) _Pragma("unroll") for (int k = 0; k < 2; ++k) \
            asm volatile("v_mfma_i32_16x16x64_i8 %0, %1, %2, %0" : "+v"(acc[ai][bj][m][n]) : "v"(Bt[n][k]), "v"(At[m][k])); }   \
        else { _Pragma("unroll") for (int m = 0; m < 4; ++m) _Pragma("unroll") for (int n = 0; n < 2; ++n) _Pragma("unroll") for (int k = 0; k < 2; ++k) \
            acc[ai][bj][m][n] = __builtin_amdgcn_mfma_f32_16x16x32_bf16(Bt[n][k], At[m][k], acc[ai][bj][m][n], 0, 0, 0); } \
        __builtin_amdgcn_s_setprio(0); } while (0)
#define PG8_WAIT_V(n) asm volatile("s_waitcnt vmcnt(" #n ")" ::: "memory")
#define PG8_WAIT_L(n) asm volatile("s_waitcnt lgkmcnt(" #n ")" ::: "memory")
#define PG8_BAR __builtin_amdgcn_s_barrier()
#define PG8_SCHED __builtin_amdgcn_sched_barrier(0)
    Unit cur, nxt; int ui = 0;
    if (!S.next(0, cur)) return;
    f32x4 acc[2][2][4][2];
#pragma unroll
    for (int a = 0; a < 2; ++a)
#pragma unroll
        for (int b = 0; b < 2; ++b)
#pragma unroll
            for (int m = 0; m < 4; ++m)
#pragma unroll
                for (int n = 0; n < 2; ++n) acc[a][b][m][n] = (f32x4){0.f, 0.f, 0.f, 0.f};
    int one_scale = 0x7F7F7F7F; asm volatile("" : "+v"(one_scale));
    bf16x8 At[4][2], B0[2][2], B1[2][2]; v8i_t At8[4], B08[2], B18[2];
#define PG8_ABASE(pm_) ((g.splitA != 0 && (pm_) >= g.splitA) ? (const char*)g.A2 + (size_t)((pm_) - g.splitA) * tstep : (const char*)g.A + (size_t)(pm_) * tstep)
    const char* cA = (GATHER ? (const char*)g.A : PG8_ABASE(cur.pm)) + S.kshift(cur); const char* cB = (const char*)g.Bt + (size_t)cur.pn * tstep + S.kshift(cur);
    if constexpr (GATHER) { const int* gp_ = S.gbase(cur); const unsigned i0_ = (unsigned)gp_[gR0], i1_ = (unsigned)gp_[gR0 + 64], i2_ = (unsigned)gp_[HALF + gR0], i3_ = (unsigned)gp_[HALF + gR0 + 64];
        gcur[0] = i0_ | (i1_ << 16); gcur[1] = i2_ | (i3_ << 16); }
    S.a_ready(cur);
    if constexpr (SP2) {
        PG8_STAGE(PG8_SB(0, 0), cB, voffB); PG8_STAGE(PG8_SB(0, 1), cB + hstep, voffB); PG8_STAGEA(PG8_SA(0, 0), cA, 0, false); PG8_STAGEA(PG8_SA(0, 1), cA + hstepA, 1, false);
        if (wr == 1) PG8_BAR;
        PG8_WAIT_V(2); PG8_BAR;
        PG8_STAGE(PG8_SB(1, 0), cB + kstep, voffB); PG8_STAGEA(PG8_SA(1, 0), cA + kstep, 0, false); PG8_STAGE(PG8_SB(1, 1), cB + hstep + kstep, voffB);
        PG8_WAIT_V(6); PG8_BAR;
    } else {
        PG8_STAGE(PG8_SB(0, 0), cB, voffB); PG8_STAGE(PG8_SA(0, 0), cA, voffA); PG8_STAGE(PG8_SB(0, 1), cB + hstep, voffB); PG8_STAGE(PG8_SA(0, 1), cA + hstep, voffA);
        if (wr == 1) PG8_BAR;
        PG8_WAIT_V(4); PG8_BAR;
        PG8_STAGE(PG8_SB(1, 0), cB + kstep, voffB); PG8_STAGE(PG8_SA(1, 0), cA + kstep, voffA); PG8_STAGE(PG8_SB(1, 1), cB + hstep + kstep, voffB);
        PG8_WAIT_V(6); PG8_BAR;
    }
    for (;;) {
        const bool has_next = S.next(ui + 1, nxt);
        const char* nA = (has_next && !GATHER) ? PG8_ABASE(nxt.pm) + S.kshift(nxt) : cA; const char* nB = has_next ? (const char*)g.Bt + (size_t)nxt.pn * tstep + S.kshift(nxt) : cB;
        if constexpr (GATHER) { if (has_next) PG8_GDMA(nxt); }
        if constexpr (I8) E.prefetch(lds, cur, ui & 1, wid, lane);
        for (int t = 0; t < nt; t += 2) {
            const bool last = (t == nt - 2);
            const char* a1 = cA + (size_t)(t + 1) * kstep;
            const char* a2 = last ? nA : cA + (size_t)(t + 2) * kstep; const char* b2 = last ? nB : cB + (size_t)(t + 2) * kstep;
            const char* a3 = a2 + kstep; const char* b3 = b2 + kstep;
            if (last && has_next) S.a_ready(nxt);
            const bool nx = last && has_next; (void)nx;
            if constexpr (GATHER) { if (nx) PG8_GREAD(gnxt); }
            if constexpr (SP2) {
            PG8_LDB(B0, 0, 0); PG8_LDB(B1, 0, 1); PG8_SCHED; PG8_LDA(At, 0, 0); PG8_STAGEA(PG8_SA(1, 1), a1 + hstepA, 1, false);
            PG8_WAIT_V(8); PG8_WAIT_L(0); PG8_BAR; PG8_MMA(0, 0, At, B0); PG8_MMA(0, 1, At, B1); PG8_BAR; PG8_SCHED;
            PG8_LDA(At, 0, 1); PG8_STAGE(PG8_SB(0, 0), b2, voffB); PG8_STAGE(PG8_SB(0, 1), b2 + hstep, voffB); PG8_STAGEA(PG8_SA(0, 0), a2, 0, nx);
            PG8_WAIT_V(8); PG8_WAIT_L(0); PG8_BAR; PG8_MMA(1, 0, At, B0); PG8_MMA(1, 1, At, B1); PG8_BAR; PG8_SCHED;
            PG8_LDB(B0, 1, 0); PG8_LDB(B1, 1, 1); PG8_SCHED; PG8_LDA(At, 1, 0); PG8_STAGEA(PG8_SA(0, 1), a2 + hstepA, 1, nx);
            PG8_WAIT_V(8); PG8_WAIT_L(0); PG8_BAR; PG8_MMA(0, 0, At, B0); PG8_MMA(0, 1, At, B1); PG8_BAR; PG8_SCHED;
            PG8_LDA(At, 1, 1); PG8_STAGE(PG8_SB(1, 0), b3, voffB); PG8_STAGE(PG8_SB(1, 1), b3 + hstep, voffB); PG8_STAGEA(PG8_SA(1, 0), a3, 0, nx);
            PG8_WAIT_V(8); PG8_WAIT_L(0); PG8_BAR; PG8_MMA(1, 0, At, B0); PG8_MMA(1, 1, At, B1); PG8_BAR; PG8_SCHED;
            } else {
            PG8_LDB(B0, 0, 0); PG8_SCHED; PG8_LDA(At, 0, 0); PG8_STAGE(PG8_SA(1, 1), a1 + hstep, voffA);
            PG8_WAIT_L(8); PG8_BAR; PG8_WAIT_L(0); PG8_MMA(0, 0, At, B0); PG8_BAR; PG8_SCHED;
            PG8_LDB(B1, 0, 1); PG8_STAGE(PG8_SB(0, 0), b2, voffB);
            PG8_BAR; PG8_WAIT_L(0); PG8_MMA(0, 1, At, B1); PG8_BAR;
            PG8_LDA(At, 0, 1); PG8_STAGE(PG8_SA(0, 0), a2, voffA);
            PG8_BAR; PG8_WAIT_L(0); PG8_MMA(1, 0, At, B0); PG8_BAR; PG8_SCHED;
            PG8_STAGE(PG8_SB(0, 1), b2 + hstep, voffB);
            PG8_WAIT_V(6); PG8_BAR; PG8_MMA(1, 1, At, B1); PG8_BAR;
            PG8_LDB(B0, 1, 0); PG8_SCHED; PG8_LDA(At, 1, 0); PG8_STAGE(PG8_SA(0, 1), a2 + hstep, voffA);
            PG8_WAIT_L(8); PG8_BAR; PG8_WAIT_L(0); PG8_MMA(0, 0, At, B0); PG8_BAR; PG8_SCHED;
            PG8_LDB(B1, 1, 1); PG8_STAGE(PG8_SB(1, 0), b3, voffB);
            PG8_BAR; PG8_WAIT_L(0); PG8_MMA(0, 1, At, B1); PG8_BAR;
            PG8_LDA(At, 1, 1); PG8_STAGE(PG8_SA(1, 0), a3, voffA);
            PG8_BAR; PG8_WAIT_L(0); PG8_MMA(1, 0, At, B0); PG8_BAR; PG8_SCHED;
            PG8_STAGE(PG8_SB(1, 1), b3 + hstep, voffB);
            PG8_WAIT_V(6); PG8_BAR; PG8_MMA(1, 1, At, B1); PG8_BAR;
            }
        }
        if constexpr (ALIGN_EPI) { if (wr == 0) PG8_BAR; }
        if constexpr (FP8 || I8) asm volatile("s_nop 15\n\ts_nop 15" ::: "memory");
        if constexpr (!Epi::AFTER_DRAIN) { Unit cu_ = cur; int wr_ = wr, wc_ = wc, fr_ = fr, fq_ = fq;
            asm volatile("" : "+v"(cu_.pm), "+v"(cu_.pn), "+v"(wr_), "+v"(wc_), "+v"(fr_), "+v"(fq_));
            cu_.pm = __builtin_amdgcn_readfirstlane(cu_.pm); cu_.pn = __builtin_amdgcn_readfirstlane(cu_.pn); wr_ = __builtin_amdgcn_readfirstlane(wr_); wc_ = __builtin_amdgcn_readfirstlane(wc_);
            if constexpr (I8) E(acc, cu_, wr_, wc_, fr_, fq_, lds + I8_SCALE_OFF + (ui & 1) * 2048); else E(acc, cu_, wr_, wc_, fr_, fq_);
            S.done(cur); }
        if (!has_next) break;
#pragma unroll
        for (int a = 0; a < 2; ++a)
#pragma unroll
            for (int b = 0; b < 2; ++b)
#pragma unroll
                for (int m = 0; m < 4; ++m)
#pragma unroll
                    for (int n = 0; n < 2; ++n) acc[a][b][m][n] = (f32x4){0.f, 0.f, 0.f, 0.f};
        if constexpr (GATHER) { gcur[0] = gnxt[0]; gcur[1] = gnxt[1]; }
        cur = nxt; cA = nA; cB = nB; ++ui;
        if constexpr (ALIGN_EPI) { if (wr == 1) PG8_BAR; }
    }
    PG8_WAIT_V(0);
    if constexpr (!ALIGN_EPI) { if (wr == 0) PG8_BAR; }
    PG8_BAR;
    if constexpr (Epi::AFTER_DRAIN) { E.fused(acc, cur, wr, wc, fr, fq, lds, wid, lane); S.done(cur); }
#undef PG8_SA
#undef PG8_SB
#undef PG8_STAGE
#undef PG8_ABASE
#undef PG8_STAGEA
#undef PG8_GDMA
#undef PG8_GREAD
#undef PG8_LDA
#undef PG8_LDB
#undef PG8_MMA
#undef PG8_CAT8
#undef PG8_WAIT_V
#undef PG8_WAIT_L
#undef PG8_BAR
#undef PG8_SCHED
}
typedef float f32x2e __attribute__((ext_vector_type(2))); typedef __bf16 bf16x2e __attribute__((ext_vector_type(2)));
__device__ __forceinline__ unsigned pk2bf(float lo, float hi) { f32x2e v = {lo, hi}; bf16x2e b = __builtin_convertvector(v, bf16x2e); return __builtin_bit_cast(unsigned, b); }
__device__ __forceinline__ u32x4 pack8(const f32x4 v0, const f32x4 v1) { u32x4 w; w.x = pk2bf(v0[0], v0[1]); w.y = pk2bf(v0[2], v0[3]); w.z = pk2bf(v1[0], v1[1]); w.w = pk2bf(v1[2], v1[3]); return w; }
__device__ __forceinline__ int row_pos(int row) { return row < 32768 ? 16 + (row & 4095) : row - 32768; }

__device__ __forceinline__ void i8_scale_prefetch(PG8_LAS unsigned char* lds, const float* rs, const float* cs, int pm, int pn, int buf, int wid, int lane) {
    const float* src = wid < 4 ? rs + pm * 256 + wid * 64 + lane : cs + pn * 256 + (wid - 4) * 64 + lane;
    __builtin_amdgcn_global_load_lds((const unsigned*)src, (PG8_LAS unsigned*)(lds + I8_SCALE_OFF + buf * 2048 + wid * 256), 4, 0, 0);
}
struct EpiIn0 { static constexpr bool PERM = true, AFTER_DRAIN = false;
    bf16_t* sb; bf16_t* cm;
    __device__ __forceinline__ void operator()(const f32x4 (&acc)[2][2][4][2], const Unit& u, int wr, int wc, int fr, int fq) const {
        const int row0 = u.pm * BM + wr * 64 + fr;
        bf16_t* base; int ldc, colt;
        if (u.pn < 6) { base = sb; ldc = 1536; colt = u.pn * 256; } else { base = cm; ldc = 512; colt = (u.pn - 6) * 256; }
        const int col0 = colt + wc * 32 + 8 * fq;
#pragma unroll
        for (int ai = 0; ai < 2; ++ai)
#pragma unroll
            for (int m = 0; m < 4; ++m) { bf16_t* rowp = base + (size_t)(row0 + ai * HALF + m * 16) * ldc + col0;
#pragma unroll
                for (int bj = 0; bj < 2; ++bj) *(u32x4*)(rowp + bj * HALF) = pack8(acc[ai][bj][m][0], acc[ai][bj][m][1]); }
    }
};
struct EpiIn0I8 { static constexpr bool PERM = true, AFTER_DRAIN = false;
    bf16_t* sb; bf16_t* cm; const float* rs; const float* cs;
    __device__ __forceinline__ void prefetch(PG8_LAS unsigned char* lds, const Unit& u, int buf, int wid, int lane) const { i8_scale_prefetch(lds, rs, cs, u.pm, u.pn, buf, wid, lane); }
    __device__ __forceinline__ void operator()(const f32x4 (&acc)[2][2][4][2], const Unit& u, int wr, int wc, int fr, int fq, const PG8_LAS unsigned char* sc) const {
        const int row0 = u.pm * BM + wr * 64 + fr; const PG8_LAS float* sl = (const PG8_LAS float*)sc;
        bf16_t* base; int ldc, colt;
        if (u.pn < 6) { base = sb; ldc = 1536; colt = u.pn * 256; } else { base = cm; ldc = 512; colt = (u.pn - 6) * 256; }
        const int col0 = colt + wc * 32 + 8 * fq; const PG8_LAS float* cp = sl + 256 + wc * 32 + 8 * fq;
        f32x4 cc[2][2];
#pragma unroll
        for (int bj = 0; bj < 2; ++bj) { cc[bj][0] = *(const PG8_LAS f32x4*)(cp + bj * HALF); cc[bj][1] = *(const PG8_LAS f32x4*)(cp + bj * HALF + 4); }
#pragma unroll
        for (int ai = 0; ai < 2; ++ai)
#pragma unroll
            for (int m = 0; m < 4; ++m) { const int row = row0 + ai * HALF + m * 16; bf16_t* rowp = base + (size_t)row * ldc + col0; const float r = sl[wr * 64 + fr + ai * HALF + m * 16];
#pragma unroll
                for (int bj = 0; bj < 2; ++bj) { f32x4 v0, v1;
#pragma unroll
                    for (int e = 0; e < 4; ++e) { const float a0 = acc[ai][bj][m][0][e], a1 = acc[ai][bj][m][1][e]; v0[e] = (float)__float_as_int(a0) * (r * cc[bj][0][e]); v1[e] = (float)__float_as_int(a1) * (r * cc[bj][1][e]); }
                    *(u32x4*)(rowp + bj * HALF) = pack8(v0, v1); } }
    }
};
struct EpiPlain { static constexpr bool PERM = true, AFTER_DRAIN = false;
    bf16_t* O; int ldc; int nmod; float sc;
    __device__ __forceinline__ void operator()(const f32x4 (&acc)[2][2][4][2], const Unit& u, int wr, int wc, int fr, int fq) const {
        const int row0 = u.pm * BM + wr * 64 + fr; const int col0 = (u.pn % nmod) * 256 + wc * 32 + 8 * fq;
#pragma unroll
        for (int ai = 0; ai < 2; ++ai)
#pragma unroll
            for (int m = 0; m < 4; ++m) { bf16_t* rowp = O + (size_t)(row0 + ai * HALF + m * 16) * ldc + col0;
#pragma unroll
                for (int bj = 0; bj < 2; ++bj) *(u32x4*)(rowp + bj * HALF) = pack8(acc[ai][bj][m][0] * sc, acc[ai][bj][m][1] * sc); }
    }
};
struct EpiUqkv { static constexpr bool PERM = true, AFTER_DRAIN = false;
    bf16_t *q, *kc, *vc; const float* cosM; const float* sinM; int pn_off;
    __device__ __forceinline__ void operator()(const f32x4 (&acc)[2][2][4][2], const Unit& u, int wr, int wc, int fr, int fq) const {
        const int row0 = u.pm * BM + wr * 64 + fr; const int upn = u.pn + pn_off;
#pragma unroll
        for (int bj = 0; bj < 2; ++bj) {
            if (upn < 3) {
                const int gidx = 8 * upn + 4 * bj + wc; const bool rope = (gidx % 3) == 2; const int col = 32 * gidx + 8 * fq;
#pragma unroll
                for (int ai = 0; ai < 2; ++ai)
#pragma unroll
                    for (int m = 0; m < 4; ++m) { const int row = row0 + ai * HALF + m * 16; f32x4 v0 = acc[ai][bj][m][0], v1 = acc[ai][bj][m][1];
                        if (rope) { const int pos = row_pos(row); const float* cp = cosM + pos * 16 + 8 * (fq & 1); const float* sp = sinM + pos * 16 + 8 * (fq & 1);
                            const f32x4 c0 = *(const f32x4*)cp, c1 = *(const f32x4*)(cp + 4), s0 = *(const f32x4*)sp, s1 = *(const f32x4*)(sp + 4);
#pragma unroll
                            for (int e = 0; e < 4; ++e) { const float o0 = __shfl_xor(v0[e], 32), o1 = __shfl_xor(v1[e], 32);
                                v0[e] = (fq < 2) ? v0[e] * c0[e] - o0 * s0[e] : v0[e] * c0[e] + o0 * s0[e];
                                v1[e] = (fq < 2) ? v1[e] * c1[e] - o1 * s1[e] : v1[e] * c1[e] + o1 * s1[e]; } }
                        *(u32x4*)(q + (size_t)row * 768 + col) = pack8(v0, v1); }
            } else {
                const int head = 2 * (upn - 3) + bj, within = 32 * wc + 8 * fq; bf16_t* base; int ldc, c;
                if (wc < 2) { base = kc; ldc = 768; c = head * 96 + within; } else { base = vc; ldc = 512; c = head * 64 + within - 64; }
#pragma unroll
                for (int ai = 0; ai < 2; ++ai)
#pragma unroll
                    for (int m = 0; m < 4; ++m) { const int row = row0 + ai * HALF + m * 16; *(u32x4*)(base + (size_t)row * ldc + c) = pack8(acc[ai][bj][m][0], acc[ai][bj][m][1]); }
            }
        }
    }
};
struct EpiIn1 { static constexpr bool PERM = true, AFTER_DRAIN = false;
    bf16_t* o; const float* cosD; const float* sinD;
    __device__ __forceinline__ void operator()(const f32x4 (&acc)[2][2][4][2], const Unit& u, int wr, int wc, int fr, int fq) const {
        const int row0 = u.pm * BM + wr * 64 + fr; const int col0 = u.pn * 256 + wc * 32 + 8 * fq; const bool ropew = (u.pn < 4) && ((wc & 1) == 0);
#pragma unroll
        for (int ai = 0; ai < 2; ++ai)
#pragma unroll
            for (int m = 0; m < 4; ++m) { const int row = row0 + ai * HALF + m * 16; bf16_t* rowp = o + (size_t)row * 3072 + col0;
                f32x4 c0 = {1.f, 1.f, 1.f, 1.f}, c1 = c0, s0 = {0.f, 0.f, 0.f, 0.f}, s1 = s0;
                if (ropew) { const int pos = row_pos(row); c0 = *(const f32x4*)(cosD + pos * 8); c1 = *(const f32x4*)(cosD + pos * 8 + 4); s0 = *(const f32x4*)(sinD + pos * 8); s1 = *(const f32x4*)(sinD + pos * 8 + 4); }
#pragma unroll
                for (int bj = 0; bj < 2; ++bj) { f32x4 v0 = acc[ai][bj][m][0], v1 = acc[ai][bj][m][1];
                    if (ropew) {
#pragma unroll
                        for (int e = 0; e < 4; ++e) { const float o0 = __shfl_xor(v0[e], 16), o1 = __shfl_xor(v1[e], 16);
                            if (fq == 0) { v0[e] = v0[e] * c0[e] - o0 * s0[e]; v1[e] = v1[e] * c1[e] - o1 * s1[e]; }
                            else if (fq == 1) { v0[e] = v0[e] * c0[e] + o0 * s0[e]; v1[e] = v1[e] * c1[e] + o1 * s1[e]; } } }
                    *(u32x4*)(rowp + bj * HALF) = pack8(v0, v1); } }
    }
};
struct EpiIn1I8 { static constexpr bool PERM = true, AFTER_DRAIN = false;
    bf16_t* o; const float* cosD; const float* sinD; const float* rs; const float* cs; unsigned* kn;
    __device__ __forceinline__ void prefetch(PG8_LAS unsigned char* lds, const Unit& u, int buf, int wid, int lane) const { i8_scale_prefetch(lds, rs, cs, u.pm, u.pn, buf, wid, lane); }
    __device__ __forceinline__ void operator()(const f32x4 (&acc)[2][2][4][2], const Unit& u, int wr, int wc, int fr, int fq, const PG8_LAS unsigned char* sc) const {
        const int row0 = u.pm * BM + wr * 64 + fr; const int col0 = u.pn * 256 + wc * 32 + 8 * fq; const bool ropew = (u.pn < 4) && ((wc & 1) == 0); const bool kcol = (u.pn == 8) || (u.pn == 9);
        float knm[2] = {0.f, 0.f}; const PG8_LAS float* sl = (const PG8_LAS float*)sc; const PG8_LAS float* cp = sl + 256 + wc * 32 + 8 * fq;
        f32x4 cc[2][2];
#pragma unroll
        for (int bj = 0; bj < 2; ++bj) { cc[bj][0] = *(const PG8_LAS f32x4*)(cp + bj * HALF); cc[bj][1] = *(const PG8_LAS f32x4*)(cp + bj * HALF + 4); }
#pragma unroll
        for (int ai = 0; ai < 2; ++ai)
#pragma unroll
            for (int m = 0; m < 4; ++m) { const int row = row0 + ai * HALF + m * 16; bf16_t* rowp = o + (size_t)row * 3072 + col0; const float r = sl[wr * 64 + fr + ai * HALF + m * 16];
                f32x4 c0 = {1.f, 1.f, 1.f, 1.f}, c1 = c0, s0 = {0.f, 0.f, 0.f, 0.f}, s1 = s0;
                if (ropew) { const int pos = row_pos(row); c0 = *(const f32x4*)(cosD + pos * 8); c1 = *(const f32x4*)(cosD + pos * 8 + 4); s0 = *(const f32x4*)(sinD + pos * 8); s1 = *(const f32x4*)(sinD + pos * 8 + 4); }
#pragma unroll
                for (int bj = 0; bj < 2; ++bj) { f32x4 v0, v1;
#pragma unroll
                    for (int e = 0; e < 4; ++e) { const float a0 = acc[ai][bj][m][0][e], a1 = acc[ai][bj][m][1][e]; v0[e] = (float)__float_as_int(a0) * (r * cc[bj][0][e]); v1[e] = (float)__float_as_int(a1) * (r * cc[bj][1][e]); }
                    if (ropew) {
#pragma unroll
                        for (int e = 0; e < 4; ++e) { const float o0 = __shfl_xor(v0[e], 16), o1 = __shfl_xor(v1[e], 16);
                            if (fq == 0) { v0[e] = v0[e] * c0[e] - o0 * s0[e]; v1[e] = v1[e] * c1[e] - o1 * s1[e]; }
                            else if (fq == 1) { v0[e] = v0[e] * c0[e] + o0 * s0[e]; v1[e] = v1[e] * c1[e] + o1 * s1[e]; } } }
                    if (kcol) { float ss = (v0[0] * v0[0] + v0[1] * v0[1]) + (v0[2] * v0[2] + v0[3] * v0[3]) + (v1[0] * v1[0] + v1[1] * v1[1]) + (v1[2] * v1[2] + v1[3] * v1[3]);
                        ss += __shfl_xor(ss, 16); ss += __shfl_xor(ss, 32); knm[bj] = fmaxf(knm[bj], ss); }
                    *(u32x4*)(rowp + bj * HALF) = pack8(v0, v1); } }
        if (kcol) {
#pragma unroll
            for (int bj = 0; bj < 2; ++bj) { float m = knm[bj];
#pragma unroll
                for (int o_ = 1; o_ < 16; o_ <<= 1) m = fmaxf(m, __shfl_xor(m, o_));
                const int colk = u.pn * 256 + bj * HALF + wc * 32 - 2048;
                if (fr == 0 && fq == 0) atomicMax(kn + ((u.pm >> 4) * 8 + (colk >> 6)) * 2 + ((colk >> 5) & 1), __float_as_uint(m)); } }
    }
};
struct EpiResid { static constexpr bool PERM = false, AFTER_DRAIN = false;
    const float* rr; float* dr; const float* rm; float* dm;
    __device__ __forceinline__ void operator()(const f32x4 (&acc)[2][2][4][2], const Unit& u, int wr, int wc, int fr, int fq) const {
        const int col0 = u.pn * BM + wc * 32 + 4 * fq;
#pragma unroll
        for (int ai = 0; ai < 2; ++ai)
#pragma unroll
            for (int m = 0; m < 4; ++m) { const int rl = ai * HALF + wr * 64 + m * 16 + fr; const float* rp; float* dp; bool ok = true;
                if (u.pm < 128) { const size_t off = (size_t)(u.pm * BM + rl) * 1024; rp = rr + off; dp = dr + off; } else { ok = rl < 16; rp = rm + (size_t)rl * 1024; dp = dm + (size_t)rl * 1024; }
                if (ok) {
#pragma unroll
                    for (int bj = 0; bj < 2; ++bj)
#pragma unroll
                        for (int n = 0; n < 2; ++n) { const int c = col0 + bj * HALF + n * 16; *(f32x4*)(dp + c) = *(const f32x4*)(rp + c) + acc[ai][bj][m][n]; } } }
    }
};
template <bool RB, bool OB> struct EpiResidP { static constexpr bool PERM = true, AFTER_DRAIN = false;
    const void* rr; void* dr; void* dr2; int split; float sc = 1.f;
    __device__ __forceinline__ void operator()(const f32x4 (&acc)[2][2][4][2], const Unit& u, int wr, int wc, int fr, int fq) const {
        const int row0 = u.pm * BM + wr * 64 + fr; const int col0 = u.pn * 256 + wc * 32 + 8 * fq;
        unsigned char* const dbase = u.pm < split ? (unsigned char*)dr : (unsigned char*)dr2 - (size_t)split * BM * 1024 * (OB ? 2 : 4);
#pragma unroll
        for (int ai = 0; ai < 2; ++ai)
#pragma unroll
            for (int m = 0; m < 4; ++m) { const size_t off = (size_t)(row0 + ai * HALF + m * 16) * 1024 + col0;
#pragma unroll
                for (int bj = 0; bj < 2; ++bj) { f32x4 r0, r1;
                    if constexpr (RB) { const u32x4 w = *(const u32x4*)((const bf16_t*)rr + off + bj * HALF);
                        r0[0] = __uint_as_float(w.x << 16); r0[1] = __uint_as_float(w.x & 0xffff0000u); r0[2] = __uint_as_float(w.y << 16); r0[3] = __uint_as_float(w.y & 0xffff0000u);
                        r1[0] = __uint_as_float(w.z << 16); r1[1] = __uint_as_float(w.z & 0xffff0000u); r1[2] = __uint_as_float(w.w << 16); r1[3] = __uint_as_float(w.w & 0xffff0000u); }
                    else { const float* p_ = (const float*)rr + off + bj * HALF; r0 = *(const f32x4*)p_; r1 = *(const f32x4*)(p_ + 4); }
                    r0 += acc[ai][bj][m][0] * sc; r1 += acc[ai][bj][m][1] * sc;
                    if constexpr (OB) *(u32x4*)((bf16_t*)dbase + off + bj * HALF) = pack8(r0, r1);
                    else { float* q_ = (float*)dbase + off + bj * HALF; *(f32x4*)q_ = r0; *(f32x4*)(q_ + 4) = r1; } } }
    }
};
struct EpiSwiglu { static constexpr bool PERM = true, AFTER_DRAIN = false;
    bf16_t* O; int ldc; int nmod; float sc; int out8;
    unsigned char* O2; int split;
    __device__ __forceinline__ void operator()(const f32x4 (&acc)[2][2][4][2], const Unit& u, int wr, int wc, int fr, int fq) const {
        const int row0 = u.pm * BM + wr * 64 + fr; const int col0 = (u.pn % nmod) * 128 + wc * 32 + 8 * fq;
        const float k1_ = -1.4426950408889634f * sc, isc2_ = 1.f / (sc * sc);
#pragma unroll
        for (int ai = 0; ai < 2; ++ai)
#pragma unroll
            for (int m = 0; m < 4; ++m) { f32x4 a[2];
#pragma unroll
                for (int n = 0; n < 2; ++n)
#pragma unroll
                    for (int e = 0; e < 4; ++e) { const float G_ = acc[ai][0][m][n][e], U_ = acc[ai][1][m][n][e];
                        a[n][e] = (G_ * U_) * __builtin_amdgcn_rcpf(__builtin_fmaf(__builtin_amdgcn_exp2f(k1_ * G_), isc2_, isc2_)); }
                if (out8) { typedef unsigned u32x2 __attribute__((ext_vector_type(2))); u32x2 w8; int t_ = 0; t_ = __builtin_amdgcn_cvt_pk_fp8_f32(a[0][0], a[0][1], t_, false); t_ = __builtin_amdgcn_cvt_pk_fp8_f32(a[0][2], a[0][3], t_, true); w8.x = (unsigned)t_;
                    t_ = 0; t_ = __builtin_amdgcn_cvt_pk_fp8_f32(a[1][0], a[1][1], t_, false); t_ = __builtin_amdgcn_cvt_pk_fp8_f32(a[1][2], a[1][3], t_, true); w8.y = (unsigned)t_;
                    unsigned char* const ob_ = (split != 0 && u.pm >= split) ? O2 - (size_t)split * BM * ldc : (unsigned char*)O;
                    *(u32x2*)(ob_ + (size_t)(row0 + ai * HALF + m * 16) * ldc + col0) = w8; }
                else *(u32x4*)(O + (size_t)(row0 + ai * HALF + m * 16) * ldc + col0) = pack8(a[0], a[1]); }
    }
};
struct EpiSwigluI8 { static constexpr bool PERM = true, AFTER_DRAIN = false;
    bf16_t* O; int ldc; const float* rs; const float* cs; int out8 = 0;
    __device__ __forceinline__ void prefetch(PG8_LAS unsigned char* lds, const Unit& u, int buf, int wid, int lane) const { i8_scale_prefetch(lds, rs, cs, u.pm, u.pn, buf, wid, lane); }
    __device__ __forceinline__ void operator()(const f32x4 (&acc)[2][2][4][2], const Unit& u, int wr, int wc, int fr, int fq, const PG8_LAS unsigned char* sc) const {
        const int row0 = u.pm * BM + wr * 64 + fr; const int col0 = u.pn * 128 + wc * 32 + 8 * fq; const PG8_LAS float* sl = (const PG8_LAS float*)sc;
        const PG8_LAS float* cp = sl + 256 + wc * 32 + 8 * fq;
        f32x4 cg[2], cu[2]; cg[0] = *(const PG8_LAS f32x4*)cp; cg[1] = *(const PG8_LAS f32x4*)(cp + 4); cu[0] = *(const PG8_LAS f32x4*)(cp + 128); cu[1] = *(const PG8_LAS f32x4*)(cp + 132);
        f32x4 c1[2], icgu[2];
#pragma unroll
        for (int n = 0; n < 2; ++n)
#pragma unroll
            for (int e = 0; e < 4; ++e) { c1[n][e] = -1.4426950408889634f * cg[n][e]; icgu[n][e] = __builtin_amdgcn_rcpf(cg[n][e] * cu[n][e]); }
#pragma unroll
        for (int ai = 0; ai < 2; ++ai)
#pragma unroll
            for (int m = 0; m < 4; ++m) { f32x4 a[2]; const int row = row0 + ai * HALF + m * 16; const float r = sl[wr * 64 + fr + ai * HALF + m * 16]; const float ir2 = __builtin_amdgcn_rcpf(r * r);
#pragma unroll
                for (int n = 0; n < 2; ++n)
#pragma unroll
                    for (int e = 0; e < 4; ++e) { const float gf = acc[ai][0][m][n][e], uf = acc[ai][1][m][n][e];
                        const float G_ = (float)__float_as_int(gf), U_ = (float)__float_as_int(uf), is2 = ir2 * icgu[n][e];
                        a[n][e] = (G_ * U_) * __builtin_amdgcn_rcpf(__builtin_fmaf(__builtin_amdgcn_exp2f(G_ * (r * c1[n][e])), is2, is2)); }
                if (out8) { typedef unsigned u32x2 __attribute__((ext_vector_type(2))); u32x2 w8; int t_ = 0; t_ = __builtin_amdgcn_cvt_pk_fp8_f32(a[0][0], a[0][1], t_, false); t_ = __builtin_amdgcn_cvt_pk_fp8_f32(a[0][2], a[0][3], t_, true); w8.x = (unsigned)t_;
                    t_ = 0; t_ = __builtin_amdgcn_cvt_pk_fp8_f32(a[1][0], a[1][1], t_, false); t_ = __builtin_amdgcn_cvt_pk_fp8_f32(a[1][2], a[1][3], t_, true); w8.y = (unsigned)t_;
                    *(u32x2*)((unsigned char*)O + (size_t)row * ldc + col0) = w8; }
                else *(u32x4*)(O + (size_t)row * ldc + col0) = pack8(a[0], a[1]); }
    }
};
struct MoeOrder { StaticOrder so; int tb1, tb2, tb3, tb4, tb5, tb6, tb7; int t0; int nper;
    __device__ __forceinline__ bool next(int i, Unit& u) const { if (!so.next(i, u)) return false; const int T = t0 + u.pm;
        const int e = (T >= tb1) + (T >= tb2) + (T >= tb3) + (T >= tb4) + (T >= tb5) + (T >= tb6) + (T >= tb7); u.pn += e * nper; return true; }
    __device__ __forceinline__ void a_ready(const Unit&) const {}
    __device__ __forceinline__ void done(const Unit&) const {}
    __device__ __forceinline__ int kshift(const Unit&) const { return 0; }
    const int* glist;
    __device__ __forceinline__ const int* gbase(const Unit& u) const { const int T = t0 + u.pm;
        const int e = (T >= tb1) + (T >= tb2) + (T >= tb3) + (T >= tb4) + (T >= tb5) + (T >= tb6) + (T >= tb7);
        const int tbe = e == 0 ? 0 : e == 1 ? tb1 : e == 2 ? tb2 : e == 3 ? tb3 : e == 4 ? tb4 : e == 5 ? tb5 : e == 6 ? tb6 : tb7;
        return glist + e * 32768 + (T - tbe) * 256; }
};
struct UqkvOrder { StaticOrder so;
    __device__ __forceinline__ bool next(int i, Unit& u) const { return so.next(i, u); }
    __device__ __forceinline__ void a_ready(const Unit&) const {}
    __device__ __forceinline__ void done(const Unit&) const {}
    __device__ __forceinline__ int kshift(const Unit& u) const { return u.pn >= 3 ? 256 : 0; }
};
}
#define GAS __attribute__((address_space(1)))
#define LAS __attribute__((address_space(3)))
typedef unsigned short bf16;
typedef unsigned v4u __attribute__((ext_vector_type(4)));
typedef float f32x4 __attribute__((ext_vector_type(4)));
typedef short bf16x8 __attribute__((ext_vector_type(8)));
typedef GAS unsigned gu32;
typedef GAS unsigned long long gu64;
#define RLX_AGENT __ATOMIC_RELAXED, __HIP_MEMORY_SCOPE_AGENT
#define LDS_WAIT() asm volatile("s_waitcnt lgkmcnt(0)" ::: "memory")
#define VM_WAIT() asm volatile("s_waitcnt vmcnt(0)" ::: "memory")
__device__ __forceinline__ unsigned long long rt() { return __builtin_amdgcn_s_memrealtime(); }
__device__ __forceinline__ unsigned f2bf(float f) { unsigned u = __builtin_bit_cast(unsigned, f); return (u + 0x7fffu + ((u >> 16) & 1u)) >> 16; }
__device__ __forceinline__ unsigned pk2(float lo, float hi) { return f2bf(lo) | (f2bf(hi) << 16); }

#define XB_TMO      128
#define XB_XCNT(j)  (256  + 64 * (j))
#define XB_XSUB(j)  (1280 + 64 * (j))
#define XB_XGEN(j)  (2304 + 64 * (j))
#define XB_TOP      3328
#define XB_TOPGEN   3392
#define XCD_BAR_WORDS 3456
#define XB_SPIN_CAP (1u << 18)

__device__ __forceinline__ unsigned xb_ld(unsigned* p)              { return __hip_atomic_load(p, __ATOMIC_RELAXED, __HIP_MEMORY_SCOPE_AGENT); }
__device__ __forceinline__ unsigned xb_add(unsigned* p, unsigned v) { return __hip_atomic_fetch_add(p, v, __ATOMIC_RELAXED, __HIP_MEMORY_SCOPE_AGENT); }
__device__ __forceinline__ unsigned xb_xcc_id() { return (unsigned)__builtin_amdgcn_s_getreg((3 << 11) | 20) & 0xFu; }
#define XB_SPIN(cond, bar) do { unsigned _sp = 0; while (cond) { __builtin_amdgcn_s_sleep(1); \
    if ((++_sp & 255u) == 0u) { if (xb_ld(&(bar)[XB_TMO])) break; if (_sp > XB_SPIN_CAP) { atomicAdd(&(bar)[XB_TMO], 1u); break; } } } } while (0)

struct XcdBarrier {
    unsigned* bar; unsigned x;
    volatile LAS unsigned* st;
};

__device__ __forceinline__ XcdBarrier xcd_barrier_post(unsigned* bar, volatile LAS unsigned* st) {
    XcdBarrier b; b.bar = bar; b.x = xb_xcc_id(); b.st = st;
    if (threadIdx.x == 0) (void)xb_add(&bar[XB_XCNT(b.x)], 1u);
    return b;
}
__device__ __forceinline__ void xcd_barrier_complete(unsigned* bar, unsigned x, unsigned& nloc, unsigned& nx) {
    const unsigned G = gridDim.x * gridDim.y * gridDim.z;
    unsigned sum, cnt, mine, sp = 0u;
    for (;;) {
        sum = 0u; cnt = 0u; mine = 0u;
#pragma unroll
        for (unsigned j = 0; j < 16; ++j) { const unsigned c = xb_ld(&bar[XB_XCNT(j)]); sum += c; cnt += (c > 0u) ? 1u : 0u; mine = (j == x) ? c : mine; }
        if (sum == G) break;
        __builtin_amdgcn_s_sleep(1);
        if ((++sp & 255u) == 0u) { if (xb_ld(&bar[XB_TMO])) break; if (sp > XB_SPIN_CAP) { atomicAdd(&bar[XB_TMO], 1u); break; } }
    }
    nloc = mine > 0u ? mine : 1u; nx = cnt > 0u ? cnt : 1u;
}

__device__ __forceinline__ void xcd_barrier(const XcdBarrier& b) {
    asm volatile("s_waitcnt vmcnt(0)" ::: "memory");
    __syncthreads();
    if (threadIdx.x == 0) {
        unsigned* bar = b.bar;
        __builtin_amdgcn_s_waitcnt(0);
        unsigned nloc = b.st[0], nx = b.st[1];
        if (nloc == 0u) { xcd_barrier_complete(bar, b.x, nloc, nx); b.st[0] = nloc; b.st[1] = nx; }
        const unsigned old = xb_add(&bar[XB_XSUB(b.x)], 1u);
        const unsigned gen = old / nloc;
        if (old + 1u == (gen + 1u) * nloc) {
            __builtin_amdgcn_fence(__ATOMIC_RELEASE, "agent");
            asm volatile("s_waitcnt vmcnt(0)" ::: "memory");
            const unsigned og = xb_add(&bar[XB_TOP], 1u);
            const unsigned tg = og / nx;
            if (og + 1u == (tg + 1u) * nx) xb_add(&bar[XB_TOPGEN], 1u);
            else XB_SPIN(xb_ld(&bar[XB_TOPGEN]) == tg, bar);
            __builtin_amdgcn_fence(__ATOMIC_ACQUIRE, "agent");
            xb_add(&bar[XB_XGEN(b.x)], 1u);
            asm volatile("s_waitcnt vmcnt(0)" ::: "memory");
        } else {
            XB_SPIN(xb_ld(&bar[XB_XGEN(b.x)]) == gen, bar);
            __builtin_amdgcn_fence(__ATOMIC_ACQUIRE, "agent");
            asm volatile("s_waitcnt vmcnt(0)" ::: "memory");
        }
    }
    __syncthreads();
}
typedef unsigned short bf16;
typedef unsigned v4u __attribute__((ext_vector_type(4)));
typedef unsigned v2u __attribute__((ext_vector_type(2)));
typedef float f32x4 __attribute__((ext_vector_type(4)));
typedef float f32x16 __attribute__((ext_vector_type(16)));
typedef short bf16x8 __attribute__((ext_vector_type(8)));
typedef short s16x4 __attribute__((ext_vector_type(4)));
using pg8::pk2bf;
using pg8::row_pos;

constexpr int NWAVES = 8;
constexpr int DM = 1024, NB = 8, SEQ = 4096, NTOK = NB * SEQ  , MR = NTOK + 256  , META0 = NTOK;
constexpr float EPS = 1e-6f, LOG2E = 1.4426950408889634f, LN2 = 0.6931471805599453f;
constexpr int DFF = 2816, DFE = 3584, NEXP = 8;
constexpr int MOE_ROWS = 264 * 256, MOE_CT = 264  , MOE_NCHUNK = 1, MOE_CT_MAX = 264, ACT_SPLIT = 136  ;

constexpr size_t MiB = 1u << 20;
constexpr size_t WS_CTL = 0, CTL_ZERO_BYTES = 2 * MiB;
constexpr int CW_BAR = 4096;
constexpr int CW_CNT = 16384;
constexpr int CW_KN = 40000;
constexpr int FOX_FLAG_OFF = 49152;
constexpr size_t WS_COSM = 5 * MiB + 128 * 1024, WS_SINM = WS_COSM + 4352 * 16 * 4, WS_COSD = WS_SINM + 4352 * 16 * 4, WS_SIND = WS_COSD + 4352 * 8 * 4;
constexpr size_t WS_HMETA = 2 * MiB;
constexpr size_t WS_CFOX = 3 * MiB;
constexpr size_t WS_CMETA = 4 * MiB;
constexpr size_t WS_LF = 4 * MiB + 65536;
constexpr size_t WS_TOK = 6 * MiB;
constexpr size_t WS_WIN0 = 8 * MiB, WS_WUQKV = 12 * MiB, WS_WOUT0 = 13 * MiB + 512 * 1024, WS_WGU0 = 15 * MiB + 512 * 1024, WS_WDN0 = 26 * MiB + 512 * 1024, WS_WIN1 = 32 * MiB, WS_WOUT1 = 38 * MiB;
constexpr size_t WS_WDN0F8 = 8 * MiB;
constexpr size_t WS_HN = 40 * MiB;
constexpr size_t WS_R = 104 * MiB + 512 * 1024;
constexpr size_t WS_SB = WS_R, WS_CM = WS_SB + (size_t)MR * 1536 * 2, WS_CQKV = WS_CM + (size_t)MR * 512 * 2;
constexpr size_t WS_ACT0 = WS_R, WS_PROJ1 = WS_R;
constexpr size_t WS_XS8 = 166 * MiB;
constexpr size_t WS_Y = 247 * MiB;
constexpr size_t WS_YP = 198 * MiB; constexpr int YP_SPLIT = 7;
constexpr size_t WS_ACTC = 40 * MiB;
constexpr size_t WS_WM = 380 * MiB, WS_WMG = WS_WM  , WS_WMD = WS_WM + (size_t)NEXP * 7168 * 1024  ;
constexpr float WMG_SCALE = 64.f;
constexpr size_t WS_QMLA = 258 * MiB, WS_KC = 307 * MiB, WS_VC = WS_CM;
constexpr size_t WS_CSC = 6 * MiB + 512 * 1024;
constexpr size_t WS_RSC = 6 * MiB + 640 * 1024;
constexpr size_t WS_WGU0Q = 494 * MiB;
constexpr size_t WS_CMAXP = 510 * MiB; constexpr int CMAX_LD = 5632;
constexpr size_t WS_CMAXP0 = 511 * MiB + 512 * 1024, WS_CSC0 = 6 * MiB + 560 * 1024, WS_WIN0Q = 504 * MiB;
constexpr size_t WS_CMAXP1 = 511 * MiB, WS_CSC1 = 6 * MiB + 544 * 1024, WS_WIN1Q = 500 * MiB;
constexpr size_t WS_H16 = 300 * MiB;
constexpr size_t WS_H3A = 464 * MiB, WS_H3B = 160 * MiB; constexpr int H3_SPLIT = 31744;
constexpr size_t WS_ELIST = 1 * MiB;
constexpr size_t WS_END = 526 * MiB;
static_assert(WS_CQKV + (size_t)MR * 384 * 2 <= WS_WM && WS_ACT0 + (size_t)MR * DFF * 2 <= WS_WM && WS_PROJ1 + (size_t)MR * 3072 * 2 <= WS_WM, "R region");
static_assert(WS_ACTC + (size_t)ACT_SPLIT * 256 * DFE <= WS_H3B && (size_t)(MOE_CT_MAX - ACT_SPLIT) * 256 * DFE <= (size_t)NTOK * DM * 4 && WS_Y + (size_t)MOE_ROWS * 1024 * 2 <= WS_WM, "MoE buffers");
static_assert(WS_XS8 + (size_t)NTOK * 1024 <= WS_YP && WS_YP + (size_t)YP_SPLIT * 7 * 256 * 1024 * 2 <= WS_Y, "YP");
static_assert(WS_CQKV + (size_t)MR * 384 * 2 <= WS_QMLA && WS_QMLA + (size_t)MR * 768 * 2 <= WS_KC && WS_KC + (size_t)MR * 768 * 2 <= WS_WM && WS_WMD + (size_t)NEXP * 1024 * DFE * 2 <= WS_END, "tail region");
static_assert(WS_WOUT1 + 2 * MiB <= WS_HN && WS_HN + (size_t)MR * 1024 * 2 <= WS_R && WS_SIND + 4352 * 8 * 4 <= WS_TOK && WS_LF + (size_t)MR * 32 <= WS_COSM && WS_LF + (size_t)MR * 32 <= WS_TOK, "head region");

constexpr int RING_OFF = 0, RING_BYTES = 131072, LDSCTL_OFF = RING_BYTES, MISC_OFF = LDSCTL_OFF + 320, LDS_BYTES = 147456;

__device__ __forceinline__ float wave_sum(float v) {
#pragma unroll
    for (int o = 1; o < 64; o <<= 1) v += __shfl_xor(v, o);
    return v;
}
__device__ __forceinline__ float bf2f(unsigned b) { return __uint_as_float(b << 16); }
__device__ __forceinline__ unsigned pk4fp8(float a, float b, float c, float d) { int w = 0; w = __builtin_amdgcn_cvt_pk_fp8_f32(a, b, w, false); w = __builtin_amdgcn_cvt_pk_fp8_f32(c, d, w, true); return (unsigned)w; }
#define LDS_WAIT() asm volatile("s_waitcnt lgkmcnt(0)" ::: "memory")

struct Frame {
    LAS unsigned char* lds;
    unsigned* ctl;
    unsigned char* ws;
    int tid, lane, wave, vcu, G;
};

__device__ __forceinline__ void tr_item(const float* W, int ldw, int ncol0, bf16* WT, int Kd, int koff, int drow0, float scale, LAS float* scr, int k0, int n0, int lane) {
    const int rg = lane >> 3, c4 = lane & 7; f32x4 v[8];
#pragma unroll
    for (int i = 0; i < 8; ++i) v[i] = *(const GAS f32x4*)(W + (size_t)(k0 + 8 * i + rg) * ldw + ncol0 + n0 + 4 * c4);
#pragma unroll
    for (int i = 0; i < 8; ++i) { LAS float* d = scr + (8 * i + rg) * 33 + 4 * c4; d[0] = v[i].x * scale; d[1] = v[i].y * scale; d[2] = v[i].z * scale; d[3] = v[i].w * scale; }
    LDS_WAIT(); asm volatile("" ::: "memory");
    const int c = lane & 7;
#pragma unroll
    for (int j = 0; j < 4; ++j) { const int n = (lane >> 3) + 8 * j; const LAS float* s = scr + (8 * c) * 33 + n;
        v4u o; o.x = pk2bf(s[0 * 33], s[1 * 33]); o.y = pk2bf(s[2 * 33], s[3 * 33]); o.z = pk2bf(s[4 * 33], s[5 * 33]); o.w = pk2bf(s[6 * 33], s[7 * 33]);
        *(GAS v4u*)(WT + (size_t)(drow0 + n) * Kd + koff + k0 + 8 * c) = o; }
    LDS_WAIT(); asm volatile("" ::: "memory");
}
__device__ __forceinline__ void tr_load(const float* W, int ldw, int k0, int n0, int lane, f32x4 (&v)[8]) {
    const int rg = lane >> 3, c4 = lane & 7;
#pragma unroll
    for (int i = 0; i < 8; ++i) v[i] = *(const GAS f32x4*)(W + (size_t)(k0 + 8 * i + rg) * ldw + n0 + 4 * c4);
}
__device__ __forceinline__ void tr_finish(const f32x4 (&v)[8], bf16* WT, int Kd, int drow0, int k0, LAS float* scr, int lane, bool fp8 = false) {
    const int rg = lane >> 3, c4 = lane & 7;
#pragma unroll
    for (int i = 0; i < 8; ++i) { LAS float* d = scr + (8 * i + rg) * 33 + 4 * c4; d[0] = v[i].x; d[1] = v[i].y; d[2] = v[i].z; d[3] = v[i].w; }
    LDS_WAIT(); asm volatile("" ::: "memory");
    const int c = lane & 7;
#pragma unroll
    for (int j = 0; j < 4; ++j) { const int n = (lane >> 3) + 8 * j; const LAS float* s = scr + (8 * c) * 33 + n;
        v4u o; o.x = pk2bf(s[0 * 33], s[1 * 33]); o.y = pk2bf(s[2 * 33], s[3 * 33]); o.z = pk2bf(s[4 * 33], s[5 * 33]); o.w = pk2bf(s[6 * 33], s[7 * 33]);
        if (fp8) { v2u o8; o8.x = pk4fp8(s[0 * 33] * WMG_SCALE, s[1 * 33] * WMG_SCALE, s[2 * 33] * WMG_SCALE, s[3 * 33] * WMG_SCALE); o8.y = pk4fp8(s[4 * 33] * WMG_SCALE, s[5 * 33] * WMG_SCALE, s[6 * 33] * WMG_SCALE, s[7 * 33] * WMG_SCALE);
            *(GAS v2u*)((unsigned char*)WT + (size_t)(drow0 + n) * Kd + k0 + 8 * c) = o8; }
        else *(GAS v4u*)(WT + (size_t)(drow0 + n) * Kd + k0 + 8 * c) = o; }
    LDS_WAIT(); asm volatile("" ::: "memory");
}
__device__ __forceinline__ unsigned pk4i8(float a, float b, float c, float d) { const int x = __float2int_rn(a), y = __float2int_rn(b), z = __float2int_rn(c), w = __float2int_rn(d);
    return __builtin_amdgcn_perm((unsigned)y, (unsigned)x, 0x0c0c0400u) | __builtin_amdgcn_perm((unsigned)w, (unsigned)z, 0x04000c0cu); }
__device__ __forceinline__ void colmax_job(const float* W, int ldw, int ncols, int cb, int kc, float* cmax, int cld, int mapup, int lane) {
    const int c = 256 * cb + 4 * lane; if (c >= ncols) return; const GAS f32x4* p = (const GAS f32x4*)(W + (size_t)(32 * kc) * ldw + c); f32x4 m = {0.f, 0.f, 0.f, 0.f};
    f32x4 vv[32];
#pragma unroll
    for (int k = 0; k < 32; ++k) vv[k] = *(const GAS f32x4*)((const GAS float*)p + (size_t)k * ldw);
#pragma unroll
    for (int k = 0; k < 32; ++k) { const f32x4 v = vv[k]; m.x = fmaxf(m.x, fabsf(v.x)); m.y = fmaxf(m.y, fabsf(v.y)); m.z = fmaxf(m.z, fabsf(v.z)); m.w = fmaxf(m.w, fabsf(v.w)); }
    *(GAS f32x4*)(cmax + (size_t)kc * cld + (mapup < 0 ? c : mapup + 256 * (c / 128) + (c % 128))) = m;
}
__device__ __forceinline__ void tr_item_q8(const float* W, int ldw, unsigned char* WT8, int Kd, int drow0, const float* cmax, int cld, float* cs, float csmul, LAS float* scr, int k0, int n0, int lane) {
    const int rg = lane >> 3, c4 = lane & 7; f32x4 v[8];
#pragma unroll
    for (int i = 0; i < 8; ++i) v[i] = *(const GAS f32x4*)(W + (size_t)(k0 + 8 * i + rg) * ldw + n0 + 4 * c4);
#pragma unroll
    for (int i = 0; i < 8; ++i) { LAS float* d = scr + (8 * i + rg) * 33 + 4 * c4; d[0] = v[i].x; d[1] = v[i].y; d[2] = v[i].z; d[3] = v[i].w; }
    LDS_WAIT(); asm volatile("" ::: "memory");
    const int c = lane & 7;
#pragma unroll
    for (int j = 0; j < 4; ++j) { const int n = (lane >> 3) + 8 * j; const LAS float* s = scr + (8 * c) * 33 + n;
        float mx = fmaxf(fmaxf(cmax[(size_t)(4 * c) * cld + drow0 + n], cmax[(size_t)(4 * c + 1) * cld + drow0 + n]), fmaxf(cmax[(size_t)(4 * c + 2) * cld + drow0 + n], cmax[(size_t)(4 * c + 3) * cld + drow0 + n]));
        mx = fmaxf(mx, __shfl_xor(mx, 1)); mx = fmaxf(mx, __shfl_xor(mx, 2)); mx = fmaxf(mx, __shfl_xor(mx, 4));
        const float inv = mx > 0.f ? 127.f / mx : 0.f;
        v2u o8; o8.x = pk4i8(s[0 * 33] * inv, s[1 * 33] * inv, s[2 * 33] * inv, s[3 * 33] * inv); o8.y = pk4i8(s[4 * 33] * inv, s[5 * 33] * inv, s[6 * 33] * inv, s[7 * 33] * inv);
        *(GAS v2u*)(WT8 + (size_t)(drow0 + n) * Kd + k0 + 8 * c) = o8;
        if (k0 == 0 && c == 0) cs[drow0 + n] = mx * (1.f / 127.f) * csmul; }
    LDS_WAIT(); asm volatile("" ::: "memory");
}
constexpr int MOE_CONV_PER = 1792, MOE_CONV_ITEMS = NEXP * 3 * MOE_CONV_PER;
struct MoeConv { const float* wg; const float* wu; const float* wd; bf16* dg; bf16* dd; };
struct ConvItem { const float* W; bf16* WT; int ldw, Kd, drow0, k0, n0; bool fp8; };
__device__ __forceinline__ ConvItem moe_conv_item(int it, const MoeConv& C) {
    ConvItem r; const int e = it / (3 * MOE_CONV_PER), rr = it % (3 * MOE_CONV_PER), kind = rr / MOE_CONV_PER, j = rr % MOE_CONV_PER;
    r.fp8 = true;
    if (kind < 2) { r.W = (kind == 0 ? C.wg : C.wu) + (size_t)e * 1024 * DFE; r.ldw = DFE; r.WT = (bf16*)((unsigned char*)C.dg + (size_t)e * 7168 * 1024); r.Kd = 1024;   const int kb = j / (DFE / 32), nb = j % (DFE / 32);
        r.n0 = nb * 32; r.k0 = kb * 64; r.drow0 = (kind == 1 ? 128 : 0) + 256 * (r.n0 / 128) + (r.n0 % 128); }
    else { r.W = C.wd + (size_t)e * DFE * 1024; r.ldw = 1024; r.WT = (bf16*)((unsigned char*)C.dd + (size_t)e * 1024 * DFE); r.Kd = DFE;   const int kb = j / 32, nb = j % 32; r.n0 = nb * 32; r.k0 = kb * 64; r.drow0 = r.n0; }
    return r;
}
template <int MAP> __device__ __forceinline__ void tr_job(int it, const float* W, int K, int ldw, int c0, int nc, bf16* WT, int Kd, int koff, int rbase, float scale, LAS float* scr, int lane) {
    const int nblk = nc / 32, kb = it / nblk, nb = it % nblk, n0 = nb * 32;
    const int drow0 = MAP == 0 ? rbase + n0 : rbase + 256 * (n0 / 128) + (n0 % 128);
    tr_item(W, ldw, c0, WT, Kd, koff, drow0, scale, scr, kb * 64, n0, lane);
}

__device__ __forceinline__ void rms_row(const float* xrow, const float* g, bf16* orow, int lane, f32x4 (&v)[4]) {
    const GAS f32x4* xr = (const GAS f32x4*)xrow + lane; float s = 0.f;
#pragma unroll
    for (int j = 0; j < 4; ++j) { v[j] = xr[64 * j]; s += (v[j].x * v[j].x + v[j].y * v[j].y) + (v[j].z * v[j].z + v[j].w * v[j].w); }
    const float rstd = 1.f / sqrtf(wave_sum(s) * (1.f / 1024.f) + EPS);
    GAS v2u* o8 = (GAS v2u*)orow + lane;
#pragma unroll
    for (int j = 0; j < 4; ++j) { const f32x4 gg = *((const GAS f32x4*)g + lane + 64 * j); v[j] = v[j] * rstd * gg; v2u w; w.x = pk2bf(v[j].x, v[j].y); w.y = pk2bf(v[j].z, v[j].w); o8[64 * j] = w; }
}
__device__ __forceinline__ void rms_row_q(const float* xrow, const float* g, bf16* orow, unsigned char* o8, float* rs, int lane, f32x4 (&v)[4]) {
    rms_row(xrow, g, orow, lane, v); float m = 0.f;
#pragma unroll
    for (int j = 0; j < 4; ++j) m = fmaxf(fmaxf(m, fmaxf(fabsf(v[j].x), fabsf(v[j].y))), fmaxf(fabsf(v[j].z), fabsf(v[j].w)));
#pragma unroll
    for (int o = 1; o < 64; o <<= 1) m = fmaxf(m, __shfl_xor(m, o));
    const float inv = m > 0.f ? 127.f / m : 0.f; GAS unsigned* q = (GAS unsigned*)o8 + lane;
#pragma unroll
    for (int j = 0; j < 4; ++j) q[64 * j] = pk4i8(v[j].x * inv, v[j].y * inv, v[j].z * inv, v[j].w * inv);
    if (lane == 0) *rs = m * (1.f / 127.f);
}
__device__ __forceinline__ void rms_row2(const float* xa, const float* xb, const float* g, bf16* oa, bf16* ob, int lane, f32x4 (&va)[4], f32x4 (&vb)[4]) {
    const GAS f32x4* pa = (const GAS f32x4*)xa + lane; const GAS f32x4* pb = (const GAS f32x4*)xb + lane; float sa = 0.f, sb = 0.f;
#pragma unroll
    for (int j = 0; j < 4; ++j) { va[j] = pa[64 * j]; vb[j] = pb[64 * j]; }
#pragma unroll
    for (int j = 0; j < 4; ++j) { sa += (va[j].x * va[j].x + va[j].y * va[j].y) + (va[j].z * va[j].z + va[j].w * va[j].w); sb += (vb[j].x * vb[j].x + vb[j].y * vb[j].y) + (vb[j].z * vb[j].z + vb[j].w * vb[j].w); }
#pragma unroll
    for (int o = 1; o < 64; o <<= 1) { sa += __shfl_xor(sa, o); sb += __shfl_xor(sb, o); }
    const float ra = 1.f / sqrtf(sa * (1.f / 1024.f) + EPS), rb = 1.f / sqrtf(sb * (1.f / 1024.f) + EPS);
    GAS v2u* qa = (GAS v2u*)oa + lane; GAS v2u* qb = (GAS v2u*)ob + lane;
#pragma unroll
    for (int j = 0; j < 4; ++j) { const f32x4 gg = *((const GAS f32x4*)g + lane + 64 * j); va[j] = va[j] * ra * gg; vb[j] = vb[j] * rb * gg;
        v2u w; w.x = pk2bf(va[j].x, va[j].y); w.y = pk2bf(va[j].z, va[j].w); qa[64 * j] = w; w.x = pk2bf(vb[j].x, vb[j].y); w.y = pk2bf(vb[j].z, vb[j].w); qb[64 * j] = w; }
}
template <bool XB> struct RowRaw;
template <> struct RowRaw<true> { v2u w[4]; };
template <> struct RowRaw<false> { f32x4 w[4]; };
template <bool XB> __device__ __forceinline__ void row_raw_load(const void* x, int lane, RowRaw<XB>& r) {
    if constexpr (XB) { const GAS v2u* p_ = (const GAS v2u*)x + lane;
#pragma unroll
        for (int j = 0; j < 4; ++j) r.w[j] = p_[64 * j]; }
    else { const GAS f32x4* p_ = (const GAS f32x4*)x + lane;
#pragma unroll
        for (int j = 0; j < 4; ++j) r.w[j] = p_[64 * j]; }
}
template <bool XB> __device__ __forceinline__ void row_raw_cvt(const RowRaw<XB>& r, f32x4 (&v)[4]) {
#pragma unroll
    for (int j = 0; j < 4; ++j) { if constexpr (XB) { v[j].x = __uint_as_float(r.w[j].x << 16); v[j].y = __uint_as_float(r.w[j].x & 0xffff0000u); v[j].z = __uint_as_float(r.w[j].y << 16); v[j].w = __uint_as_float(r.w[j].y & 0xffff0000u); } else v[j] = r.w[j]; }
}
__device__ __forceinline__ const bf16* h3row(const unsigned char* ws, int row) { return row < H3_SPLIT ? (const bf16*)(ws + WS_H3A) + (size_t)row * DM : (const bf16*)(ws + WS_H3B) + (size_t)(row - H3_SPLIT) * DM; }
template <bool XB = false>
__device__ __forceinline__ void rms_row2_f8(const RowRaw<XB>& xa, const RowRaw<XB>& xb, const float* g, unsigned char* oa, unsigned char* ob, int lane, f32x4 (&va)[4], f32x4 (&vb)[4]) {
    float sa = 0.f, sb = 0.f; row_raw_cvt<XB>(xa, va); row_raw_cvt<XB>(xb, vb);
#pragma unroll
    for (int j = 0; j < 4; ++j) { sa += (va[j].x * va[j].x + va[j].y * va[j].y) + (va[j].z * va[j].z + va[j].w * va[j].w); sb += (vb[j].x * vb[j].x + vb[j].y * vb[j].y) + (vb[j].z * vb[j].z + vb[j].w * vb[j].w); }
#pragma unroll
    for (int o = 1; o < 64; o <<= 1) { sa += __shfl_xor(sa, o); sb += __shfl_xor(sb, o); }
    const float ra = 1.f / sqrtf(sa * (1.f / 1024.f) + EPS), rb = 1.f / sqrtf(sb * (1.f / 1024.f) + EPS);
    GAS unsigned* qa = (GAS unsigned*)oa + lane; GAS unsigned* qb = (GAS unsigned*)ob + lane;
#pragma unroll
    for (int j = 0; j < 4; ++j) { const f32x4 gg = *((const GAS f32x4*)g + lane + 64 * j); va[j] = va[j] * ra * gg; vb[j] = vb[j] * rb * gg;
        qa[64 * j] = pk4fp8(va[j].x, va[j].y, va[j].z, va[j].w); qb[64 * j] = pk4fp8(vb[j].x, vb[j].y, vb[j].z, vb[j].w); }
}
template <bool XB = false>
__device__ __forceinline__ void rms_row2_i8(const RowRaw<XB>& xa, const RowRaw<XB>& xb, const float* g, unsigned char* oa, unsigned char* ob, float* rsa, float* rsb, int lane, f32x4 (&va)[4], f32x4 (&vb)[4]) {
    float sa = 0.f, sb = 0.f; row_raw_cvt<XB>(xa, va); row_raw_cvt<XB>(xb, vb);
#pragma unroll
    for (int j = 0; j < 4; ++j) { sa += (va[j].x * va[j].x + va[j].y * va[j].y) + (va[j].z * va[j].z + va[j].w * va[j].w); sb += (vb[j].x * vb[j].x + vb[j].y * vb[j].y) + (vb[j].z * vb[j].z + vb[j].w * vb[j].w); }
#pragma unroll
    for (int o = 1; o < 64; o <<= 1) { sa += __shfl_xor(sa, o); sb += __shfl_xor(sb, o); }
    const float ra = 1.f / sqrtf(sa * (1.f / 1024.f) + EPS), rb = 1.f / sqrtf(sb * (1.f / 1024.f) + EPS);
    float ma = 0.f, mb = 0.f;
#pragma unroll
    for (int j = 0; j < 4; ++j) { const f32x4 gg = *((const GAS f32x4*)g + lane + 64 * j); va[j] = va[j] * ra * gg; vb[j] = vb[j] * rb * gg;
        ma = fmaxf(fmaxf(ma, fmaxf(fabsf(va[j].x), fabsf(va[j].y))), fmaxf(fabsf(va[j].z), fabsf(va[j].w))); mb = fmaxf(fmaxf(mb, fmaxf(fabsf(vb[j].x), fabsf(vb[j].y))), fmaxf(fabsf(vb[j].z), fabsf(vb[j].w))); }
#pragma unroll
    for (int o = 1; o < 64; o <<= 1) { ma = fmaxf(ma, __shfl_xor(ma, o)); mb = fmaxf(mb, __shfl_xor(mb, o)); }
    const float ia = ma > 0.f ? 127.f / ma : 0.f, ib = mb > 0.f ? 127.f / mb : 0.f;
    GAS unsigned* qa = (GAS unsigned*)oa + lane; GAS unsigned* qb = (GAS unsigned*)ob + lane;
#pragma unroll
    for (int j = 0; j < 4; ++j) { qa[64 * j] = pk4i8(va[j].x * ia, va[j].y * ia, va[j].z * ia, va[j].w * ia); qb[64 * j] = pk4i8(vb[j].x * ib, vb[j].y * ib, vb[j].z * ib, vb[j].w * ib); }
    if (lane == 0) { *rsa = ma * (1.f / 127.f); *rsb = mb * (1.f / 127.f); }
}
__device__ __forceinline__ void zero_row(bf16* orow, int lane) {
    GAS v2u* o8 = (GAS v2u*)orow + lane; const v2u z = {0u, 0u};
#pragma unroll
    for (int j = 0; j < 4; ++j) o8[64 * j] = z;
}
__device__ __forceinline__ void row_dot8(const f32x4 (&v)[4], const LAS float* wl, int lane, float (&d)[8]) {
#pragma unroll
    for (int e = 0; e < 8; ++e) d[e] = 0.f;
#pragma unroll
    for (int j = 0; j < 4; ++j)
#pragma unroll
        for (int t = 0; t < 4; ++t) { const int c = 4 * lane + 256 * j + t; const LAS f32x4* wp = (const LAS f32x4*)(wl + c * 8); const f32x4 w0 = wp[0], w1 = wp[1]; const float x = v[j][t];
            d[0] += x * w0.x; d[1] += x * w0.y; d[2] += x * w0.z; d[3] += x * w0.w; d[4] += x * w1.x; d[5] += x * w1.y; d[6] += x * w1.z; d[7] += x * w1.w; }
#pragma unroll
    for (int e = 0; e < 8; ++e) d[e] = wave_sum(d[e]);
}

struct W8 { f32x4 w[4][4][2]; };
__device__ __forceinline__ void w8_load(W8& W, const float* base, int pitch, int lane) {
#pragma unroll
    for (int j = 0; j < 4; ++j)
#pragma unroll
        for (int t = 0; t < 4; ++t) { const float* p_ = base + (size_t)(4 * lane + 256 * j + t) * pitch; W.w[j][t][0] = *(const GAS f32x4*)p_; W.w[j][t][1] = *(const GAS f32x4*)(p_ + 4); }
}
__device__ __forceinline__ float dot8_reduce(const f32x4 (&v)[4], const W8& W, int lane) {
    float d[8];
#pragma unroll
    for (int e = 0; e < 8; ++e) d[e] = 0.f;
#pragma unroll
    for (int j = 0; j < 4; ++j)
#pragma unroll
        for (int t = 0; t < 4; ++t) { const f32x4 w0 = W.w[j][t][0], w1 = W.w[j][t][1]; const float x = v[j][t];
            d[0] += x * w0.x; d[1] += x * w0.y; d[2] += x * w0.z; d[3] += x * w0.w; d[4] += x * w1.x; d[5] += x * w1.y; d[6] += x * w1.z; d[7] += x * w1.w; }
    const bool b0 = (lane & 1) != 0, b1 = (lane & 2) != 0, b2 = (lane & 4) != 0; float a[4], b[2];
#pragma unroll
    for (int i = 0; i < 4; ++i) { const float send = b0 ? d[i] : d[i + 4], keep = b0 ? d[i + 4] : d[i]; a[i] = keep + __shfl_xor(send, 1); }
#pragma unroll
    for (int i = 0; i < 2; ++i) { const float send = b1 ? a[i] : a[i + 2], keep = b1 ? a[i + 2] : a[i]; b[i] = keep + __shfl_xor(send, 2); }
    float c; { const float send = b2 ? b[0] : b[1], keep = b2 ? b[1] : b[0]; c = keep + __shfl_xor(send, 4); }
    c += __shfl_xor(c, 8); c += __shfl_xor(c, 16); c += __shfl_xor(c, 32);
    return c;
}
__device__ __forceinline__ int bitrev3(int x) { return ((x & 1) << 2) | (x & 2) | ((x & 4) >> 2); }
#define MFMA16(a, b, c) __builtin_amdgcn_mfma_f32_16x16x32_bf16((a), (b), (c), 0, 0, 0)
__device__ __forceinline__ void mini_pair(const bf16* A, int K, int nsplit, const bf16* Bt, int rb0, int rb1, int lane, int wave, LAS float* red, f32x4& c0, f32x4& c1) {
    const int n = lane & 15, kq = lane >> 4, ks = K / nsplit;
    const bf16* ap = A + (size_t)n * K + 8 * kq; const bf16* b0 = Bt + (size_t)(rb0 + n) * K + 8 * kq; const bf16* b1 = Bt + (size_t)(rb1 + n) * K + 8 * kq;
    c0 = (f32x4){0.f, 0.f, 0.f, 0.f}; c1 = c0;
    if (wave < nsplit) {
#pragma unroll 4
        for (int k0 = wave * ks; k0 < (wave + 1) * ks; k0 += 32) { const bf16x8 a = *(const GAS bf16x8*)(ap + k0), x0 = *(const GAS bf16x8*)(b0 + k0), x1 = *(const GAS bf16x8*)(b1 + k0);
            c0 = MFMA16(x0, a, c0); c1 = MFMA16(x1, a, c1); }
    }
    *(LAS f32x4*)(red + (wave * 64 + lane) * 8) = c0; *(LAS f32x4*)(red + (wave * 64 + lane) * 8 + 4) = c1;
    __syncthreads();
    if (wave == 0) {
#pragma unroll
        for (int w = 1; w < 8; ++w) { c0 += *(const LAS f32x4*)(red + (w * 64 + lane) * 8); c1 += *(const LAS f32x4*)(red + (w * 64 + lane) * 8 + 4); }
    }
    __syncthreads();
}
__device__ __forceinline__ void mini_pair_i8(const unsigned char* A8, int K, int nsplit, const unsigned char* Bt8, int rb0, int rb1, const float* rs, const float* cs, int lane, int wave, LAS float* red, f32x4& c0, f32x4& c1) {
    typedef int v4i_ __attribute__((ext_vector_type(4)));
    const int n = lane & 15, kq = lane >> 4, ks = K / nsplit;
    const unsigned char* ap = A8 + (size_t)n * K + 16 * kq; const unsigned char* b0 = Bt8 + (size_t)(rb0 + n) * K + 16 * kq; const unsigned char* b1 = Bt8 + (size_t)(rb1 + n) * K + 16 * kq;
    v4i_ i0 = {0, 0, 0, 0}, i1 = {0, 0, 0, 0};
    if (wave < nsplit) {
#pragma unroll 2
        for (int k0 = wave * ks; k0 < (wave + 1) * ks; k0 += 64) { const v4i_ a = *(const GAS v4i_*)(ap + k0), x0 = *(const GAS v4i_*)(b0 + k0), x1 = *(const GAS v4i_*)(b1 + k0);
            i0 = __builtin_amdgcn_mfma_i32_16x16x64_i8(x0, a, i0, 0, 0, 0); i1 = __builtin_amdgcn_mfma_i32_16x16x64_i8(x1, a, i1, 0, 0, 0); }
    }
    LAS v4i_* ri = (LAS v4i_*)red;
    ri[(wave * 64 + lane) * 2] = i0; ri[(wave * 64 + lane) * 2 + 1] = i1;
    __syncthreads();
    if (wave == 0) {
#pragma unroll
        for (int w = 1; w < 8; ++w) { i0 += ri[(w * 64 + lane) * 2]; i1 += ri[(w * 64 + lane) * 2 + 1]; }
        const float r = rs[n]; const f32x4 s0 = *(const GAS f32x4*)(cs + rb0 + 4 * kq), s1 = *(const GAS f32x4*)(cs + rb1 + 4 * kq);
#pragma unroll
        for (int e = 0; e < 4; ++e) { c0[e] = (float)i0[e] * (r * s0[e]); c1[e] = (float)i1[e] * (r * s1[e]); }
    }
    __syncthreads();
}
__device__ __forceinline__ void st4bf(bf16* dst, const f32x4 v) { v2u w; w.x = pk2bf(v[0], v[1]); w.y = pk2bf(v[2], v[3]); *(GAS v2u*)dst = w; }
__device__ __forceinline__ void zero_fill16(unsigned char* base, int nrows, size_t row_bytes, int col_byte0, int ncol_bytes, int gt, int NGT) {
    const int per = ncol_bytes / 16; const v4u z = {0u, 0u, 0u, 0u};
    for (int i = gt; i < nrows * per; i += NGT) *(GAS v4u*)(base + (size_t)(i / per) * row_bytes + col_byte0 + (size_t)(i % per) * 16) = z;
}

#define MFMA32(a, b, c) __builtin_amdgcn_mfma_f32_32x32x16_bf16((a), (b), (c), 0, 0, 0)
typedef short v4i16_t __attribute__((ext_vector_type(4)));
__device__ __forceinline__ s16x4 vtr(const LAS unsigned char* p) { return __builtin_bit_cast(s16x4, __builtin_amdgcn_ds_read_tr16_b64_v4i16((LAS v4i16_t*)p)); }
__device__ __forceinline__ float max3f(float a, float b, float c) { float r; asm("v_max3_f32 %0, %1, %2, %3" : "=v"(r) : "v"(a), "v"(b), "v"(c)); return r; }
__device__ __forceinline__ float max2f(float a, float b) { float r; asm("v_max_f32_e32 %0, %1, %2" : "=v"(r) : "v"(a), "v"(b)); return r; }
__device__ __forceinline__ int crow(int r, int hi) { return (r & 3) + 8 * (r >> 2) + 4 * hi; }
__device__ __forceinline__ int chunk_of(int p) { return p < 16 ? 0 : 1 + ((p - 16) >> 6); }
constexpr int KPOS_BAD = 1 << 29;

template <int DQK, int DV> struct AttnCarry { bf16x8 qf[DQK / 16]; v4u k[(64 * (DQK / 8) + 511) / 512]; v4u v[(64 * (DV / 8)) / 512]; float b; bool valid; };
struct AttnNext { const bf16* qrow; const bf16* Kg; const bf16* Vg; const float* cb_real; const float* cb_meta; int kv_row0, first_tile; bool has; };
template <int DQK, int DV, bool CAUSAL, bool BIAS, bool BACKWARD, bool LMFMA, bool CONV, int VPRE = 0>
__device__ __forceinline__ void attn_pass(LAS unsigned char* lds, const bf16* qrow, const bf16* Kg, int kpitch, const bf16* Vg, int vpitch, int kv_row0, int NT,
                                          int qp, int qp_lo, int qp_hi, const float* cb_real, const float* cb_meta, f32x16 (&o)[DV / 32], float& linv,
                                          int& cv_it, int cv_stride, const MoeConv& CV, LAS float* cscr, float kmax = 0.f, AttnCarry<DQK, DV>* cyp = nullptr, const AttnNext* nxp = nullptr) {
    constexpr int KP = DQK * 2 + 16, VP = DV * 2 + 64, KPC = DQK / 8, VPC = DV / 8, NK = (64 * KPC + 511) / 512, NV = (64 * VPC) / 512, NS = DQK / 16, ND = DV / 32;
    constexpr int OFF_V = 64 * KP, OFF_B = OFF_V + 64 * VP, STG = OFF_B + 256;
    const int tid = threadIdx.x, lane = tid & 63, r = lane & 31, h = lane >> 5;
    bf16x8 qf[NS]; const bool pre_ = cyp != nullptr && cyp->valid;
    if (pre_) {
#pragma unroll
        for (int st = 0; st < NS; ++st) qf[st] = cyp->qf[st]; }
    else {
#pragma unroll
        for (int st = 0; st < NS; ++st) qf[st] = *(const GAS bf16x8*)(qrow + st * 16 + h * 8); }
#pragma unroll
    for (int dt = 0; dt < ND; ++dt)
#pragma unroll
        for (int i = 0; i < 16; ++i) o[dt][i] = 0.f;
    f32x16 ol;
#pragma unroll
    for (int i = 0; i < 16; ++i) ol[i] = 0.f;
    const bf16x8 ones8 = {0x3F80, 0x3F80, 0x3F80, 0x3F80, 0x3F80, 0x3F80, 0x3F80, 0x3F80};
    float mref = 0.f, l_run = 0.f;
    f32x16 negm;
#pragma unroll
    for (int i = 0; i < 16; ++i) negm[i] = 0.f;
    const int cq = chunk_of(qp), cq_lo = chunk_of(qp_lo), cq_hi = chunk_of(qp_hi);
    float qbound = 0.f; const int wave_id = __builtin_amdgcn_readfirstlane(tid >> 6);
    if (BACKWARD) { float ss = 0.f;
#pragma unroll
        for (int st = 0; st < NS; ++st)
#pragma unroll
            for (int e = 0; e < 8; ++e) { const float x = __uint_as_float(((unsigned)(unsigned short)qf[st][e]) << 16); ss += x * x; }
        ss += __shfl_xor(ss, 32); qbound = sqrtf(ss) * kmax * 1.02f; }
    bool fin = false;
    v4u kreg[2][NK], vreg[2][NV]; float breg[2] = {0.f, 0.f};
#define ATT_LOAD(t, S) do { const int rowb_ = (t) == 0 ? META0 : kv_row0 + 64 * ((t) - 1); \
        _Pragma("unroll") for (int j_ = 0; j_ < NK; ++j_) { const int p_ = tid + 512 * j_; if (p_ < 64 * KPC) { const int key_ = p_ / KPC, pc_ = p_ % KPC; kreg[S][j_] = *(const GAS v4u*)(Kg + (size_t)(rowb_ + key_) * kpitch + pc_ * 8); } } \
        _Pragma("unroll") for (int j_ = 0; j_ < NV; ++j_) { const int p_ = tid + 512 * j_; const int key_ = p_ / VPC, pc_ = p_ % VPC; vreg[S][j_] = *(const GAS v4u*)(Vg + (size_t)(rowb_ + key_) * vpitch + pc_ * 8); } \
        if (BIAS) { if (tid < 64) breg[S] = (t) == 0 ? (tid < 16 ? cb_meta[tid] : 0.f) : cb_real[64 * ((t) - 1) + tid]; } } while (0)
#define ATT_STORE(buf, S) do { LAS unsigned char* sb_ = lds + (buf) * STG; \
        _Pragma("unroll") for (int j_ = 0; j_ < NK; ++j_) { const int p_ = tid + 512 * j_; if (p_ < 64 * KPC) { const int key_ = p_ / KPC, pc_ = p_ % KPC; *(LAS v4u*)(sb_ + key_ * KP + pc_ * 16) = kreg[S][j_]; } } \
        _Pragma("unroll") for (int j_ = 0; j_ < NV; ++j_) { const int p_ = tid + 512 * j_; const int key_ = p_ / VPC, pc_ = p_ % VPC; *(LAS v4u*)(sb_ + OFF_V + key_ * VP + pc_ * 16) = vreg[S][j_]; } \
        if (BIAS) { if (tid < 64) *(LAS float*)(sb_ + OFF_B + tid * 4) = -breg[S]; } } while (0)
#define ATT_BAR() asm volatile("s_waitcnt lgkmcnt(0)\n\ts_barrier" ::: "memory")
#define TILE(i) (BACKWARD ? NT - (i) : (i))
    bool started = false;
    if (pre_) {
#pragma unroll
        for (int j_ = 0; j_ < NK; ++j_) kreg[0][j_] = cyp->k[j_];
#pragma unroll
        for (int j_ = 0; j_ < NV; ++j_) vreg[0][j_] = cyp->v[j_];
        if (BIAS) breg[0] = cyp->b; }
    else { ATT_LOAD(TILE(0), 0); }
    ATT_STORE(0, 0); if (NT >= 1) ATT_LOAD(TILE(1), 1); ATT_BAR();
    const int q4 = (lane & 15) >> 2, p4 = lane & 3, blk = (lane >> 4) & 1;
    ConvItem ci = {}; f32x4 cvv[8]; bool cv_pend = false;
    for (int t2 = 0; t2 <= NT; t2 += 2) {
#pragma unroll
      for (int par = 0; par < 2; ++par) { const int step = t2 + par; if (step > NT) break; const int t = TILE(step);
        if (BACKWARD) { if (step >= 1) { const LAS int* fl = (const LAS int*)(lds + FOX_FLAG_OFF); int agree = 1;
#pragma unroll
            for (int w = 0; w < 8; ++w) agree &= (fl[w] == step) ? 1 : 0;
            if (__builtin_amdgcn_readfirstlane(agree)) { fin = true; break; } } }
        if (CONV) { if ((step & 3) == 0 && cv_it < MOE_CONV_ITEMS) { ci = moe_conv_item(cv_it, CV); tr_load(ci.W, ci.ldw, ci.k0, ci.n0, lane, cvv); cv_pend = true; asm volatile("" ::: "memory"); } }
        if (step + 2 <= NT) ATT_LOAD(TILE(step + 2), par);
        int status;
        if (t == 0) status = 2;
        else if (CAUSAL) { const int kp_lo = 16 + 64 * (t - 1), kp_hi = kp_lo + 63; status = kp_lo > qp_hi ? 0 : (kp_hi <= qp_lo ? 1 : 2); }
        else { status = t > cq_hi ? 0 : (t <= cq_lo ? 1 : 2); }
        if (status != 0) {
            const LAS unsigned char* sb = lds + par * STG;
            f32x16 s0, s1;
            __builtin_amdgcn_s_setprio(1);
#pragma unroll
            for (int st = 0; st < NS; ++st) { const bf16x8 k0 = *(const LAS bf16x8*)(sb + r * KP + st * 32 + h * 16), k1 = *(const LAS bf16x8*)(sb + (32 + r) * KP + st * 32 + h * 16);
                if (st == 0) { s0 = MFMA32(k0, qf[0], negm); s1 = MFMA32(k1, qf[0], negm); } else { s0 = MFMA32(k0, qf[st], s0); s1 = MFMA32(k1, qf[st], s1); } }
            __builtin_amdgcn_s_setprio(0);
            bf16x8 vfa[VPRE ? VPRE : 1][VPRE ? ND : 1];
            if constexpr (VPRE > 0) {
#pragma unroll
                for (int ks = 0; ks < VPRE; ++ks)
#pragma unroll
                    for (int dt = 0; dt < ND; ++dt) { const LAS unsigned char* vp = sb + OFF_V + (16 * ks + 4 * h + q4) * VP + (32 * dt + 16 * blk) * 2 + 8 * p4;
                        const s16x4 lo = vtr(vp), hi = vtr(vp + 8 * VP); vfa[ks][dt] = (bf16x8){lo[0], lo[1], lo[2], lo[3], hi[0], hi[1], hi[2], hi[3]}; }
            }
            if (BIAS) {
#pragma unroll
                for (int g = 0; g < 4; ++g) { const f32x4 b0 = *(const LAS f32x4*)(sb + OFF_B + (8 * g + 4 * h) * 4), b1 = *(const LAS f32x4*)(sb + OFF_B + (32 + 8 * g + 4 * h) * 4);
#pragma unroll
                    for (int e = 0; e < 4; ++e) { s0[4 * g + e] += b0[e]; s1[4 * g + e] += b1[e]; } }
            }
            if (status == 2) {
#pragma unroll
                for (int i = 0; i < 16; ++i) { const int k0 = crow(i, h), k1 = 32 + k0;
                    const int kp0 = t == 0 ? (k0 < 16 ? k0 : KPOS_BAD) : 16 + 64 * (t - 1) + k0, kp1 = t == 0 ? KPOS_BAD : 16 + 64 * (t - 1) + k1;
                    const bool v0 = CAUSAL ? (kp0 <= qp) : (kp0 < KPOS_BAD && chunk_of(kp0) <= cq), v1 = CAUSAL ? (kp1 <= qp) : (kp1 < KPOS_BAD && chunk_of(kp1) <= cq);
                    if (!v0) s0[i] = -INFINITY; if (!v1) s1[i] = -INFINITY; }
            }
            asm volatile("s_nop 15\n\ts_nop 7" : "+v"(s0), "+v"(s1));
            float mxa = max3f(s0[0], s0[1], s1[0]), mxb = max3f(s0[2], s0[3], s1[1]); mxa = max3f(mxa, s1[2], s1[3]);
#pragma unroll
            for (int i = 4; i < 16; i += 4) { mxa = max3f(mxa, s0[i], s0[i + 1]); mxb = max3f(mxb, s0[i + 2], s0[i + 3]); mxa = max3f(mxa, s1[i], s1[i + 1]); mxb = max3f(mxb, s1[i + 2], s1[i + 3]); }
            float mx = max2f(mxa, mxb);
            { asm volatile("s_nop 1" : "+v"(mx));
              const auto sw_ = __builtin_amdgcn_permlane32_swap(__float_as_uint(mx), __float_as_uint(mx), false, false);
              mx = max2f(__uint_as_float(sw_[0]), __uint_as_float(sw_[1])); }
            const bool first = !started; started = true;
            const bool upd = first || __any(mx > 6.f);
            if (upd) {
                float delta = first ? mx : fmaxf(mx, 0.f); delta = (delta == -INFINITY) ? 0.f : delta;
                mref += delta;
#pragma unroll
                for (int i = 0; i < 16; ++i) { s0[i] -= delta; s1[i] -= delta; negm[i] = -mref; }
                if (!first) { const float alpha = __builtin_amdgcn_exp2f(-delta); l_run *= alpha; if (LMFMA) ol[0] *= alpha;
#pragma unroll
                    for (int dt = 0; dt < ND; ++dt)
#pragma unroll
                        for (int i = 0; i < 16; ++i) o[dt][i] *= alpha; }
            }
            if (upd || !__all(mx < -40.f)) {
            if (LMFMA) {
#pragma unroll
                for (int i = 0; i < 16; ++i) { s0[i] = __builtin_amdgcn_exp2f(s0[i]); s1[i] = __builtin_amdgcn_exp2f(s1[i]); }
            } else { float psum = 0.f;
#pragma unroll
                for (int i = 0; i < 16; ++i) { s0[i] = __builtin_amdgcn_exp2f(s0[i]); s1[i] = __builtin_amdgcn_exp2f(s1[i]); psum += s0[i] + s1[i]; }
                l_run += psum; }
            bf16x8 pf[4];
            { v4u w;
              w.x = pk2bf(s0[0], s0[1]); w.y = pk2bf(s0[2], s0[3]); w.z = pk2bf(s0[4], s0[5]); w.w = pk2bf(s0[6], s0[7]); pf[0] = __builtin_bit_cast(bf16x8, w);
              w.x = pk2bf(s0[8], s0[9]); w.y = pk2bf(s0[10], s0[11]); w.z = pk2bf(s0[12], s0[13]); w.w = pk2bf(s0[14], s0[15]); pf[1] = __builtin_bit_cast(bf16x8, w);
              w.x = pk2bf(s1[0], s1[1]); w.y = pk2bf(s1[2], s1[3]); w.z = pk2bf(s1[4], s1[5]); w.w = pk2bf(s1[6], s1[7]); pf[2] = __builtin_bit_cast(bf16x8, w);
              w.x = pk2bf(s1[8], s1[9]); w.y = pk2bf(s1[10], s1[11]); w.z = pk2bf(s1[12], s1[13]); w.w = pk2bf(s1[14], s1[15]); pf[3] = __builtin_bit_cast(bf16x8, w); }
#pragma unroll
            for (int ks = 0; ks < 4; ++ks) { bf16x8 vf[ND];
#pragma unroll
                for (int dt = 0; dt < ND; ++dt) { if (VPRE > 0 && ks < VPRE) { vf[dt] = vfa[ks < VPRE ? ks : 0][dt]; } else { const LAS unsigned char* vp = sb + OFF_V + (16 * ks + 4 * h + q4) * VP + (32 * dt + 16 * blk) * 2 + 8 * p4;
                    const s16x4 lo = vtr(vp), hi = vtr(vp + 8 * VP);
                    vf[dt] = (bf16x8){lo[0], lo[1], lo[2], lo[3], hi[0], hi[1], hi[2], hi[3]}; } }
#pragma unroll
                for (int dt = 0; dt < ND; ++dt) o[dt] = MFMA32(vf[dt], pf[ks], o[dt]);
                if (LMFMA) ol = MFMA32(ones8, pf[ks], ol);
                if (ND > 2) __builtin_amdgcn_sched_barrier(0); }
            }
        }
        if (BACKWARD) { bool c = false;
            if (status != 0 && started && t != 0) { const float bt = *(const LAS float*)(lds + par * STG + OFF_B + 63 * 4); c = __all(qbound + bt - mref < -40.f); }
            if (lane == 0) ((LAS int*)(lds + FOX_FLAG_OFF))[wave_id] = c ? step + 1 : 0; }
        if (CONV) { if (cv_pend && ((step & 3) == 3 || step == NT)) { tr_finish(cvv, ci.WT, ci.Kd, ci.drow0, ci.k0, cscr, lane, ci.fp8); cv_it += cv_stride; cv_pend = false; } }
        if (step + 1 <= NT) ATT_STORE(par ^ 1, par ^ 1);
        ATT_BAR();
      }
      if (fin) break;
    }
#undef ATT_LOAD
#undef ATT_STORE
#undef ATT_BAR
#undef TILE
    if (cyp != nullptr) { const bool hn_ = nxp != nullptr && nxp->has; cyp->valid = hn_;
        if (hn_) {
#pragma unroll
            for (int st = 0; st < NS; ++st) cyp->qf[st] = *(const GAS bf16x8*)(nxp->qrow + st * 16 + h * 8);
            const int t_ = nxp->first_tile, rowb_ = t_ == 0 ? META0 : nxp->kv_row0 + 64 * (t_ - 1); cyp->b = 0.f;
#pragma unroll
            for (int j_ = 0; j_ < NK; ++j_) { const int p_ = tid + 512 * j_; cyp->k[j_] = (v4u){0u, 0u, 0u, 0u}; if (p_ < 64 * KPC) { const int key_ = p_ / KPC, pc_ = p_ % KPC; cyp->k[j_] = *(const GAS v4u*)(nxp->Kg + (size_t)(rowb_ + key_) * kpitch + pc_ * 8); } }
#pragma unroll
            for (int j_ = 0; j_ < NV; ++j_) { const int p_ = tid + 512 * j_; const int key_ = p_ / VPC, pc_ = p_ % VPC; cyp->v[j_] = *(const GAS v4u*)(nxp->Vg + (size_t)(rowb_ + key_) * vpitch + pc_ * 8); }
            if (BIAS) { if (tid < 64) cyp->b = t_ == 0 ? (tid < 16 ? nxp->cb_meta[tid] : 0.f) : nxp->cb_real[64 * (t_ - 1) + tid]; } }
        else {
#pragma unroll
            for (int st = 0; st < NS; ++st) cyp->qf[st] = (bf16x8){0, 0, 0, 0, 0, 0, 0, 0};
#pragma unroll
            for (int j_ = 0; j_ < NK; ++j_) cyp->k[j_] = (v4u){0u, 0u, 0u, 0u};
#pragma unroll
            for (int j_ = 0; j_ < NV; ++j_) cyp->v[j_] = (v4u){0u, 0u, 0u, 0u};
            cyp->b = 0.f; } }
    const float lt = LMFMA ? ol[0] : l_run + __shfl_xor(l_run, 32);
    linv = 1.f / lt;
}

__device__ __forceinline__ void st_pair16(bf16* base, v2u a, v2u b, int h, bool ok) {
    const auto rx = __builtin_amdgcn_permlane32_swap(a.x, b.x, false, false); const auto ry = __builtin_amdgcn_permlane32_swap(a.y, b.y, false, false);
    v4u w; w.x = rx[0]; w.y = ry[0]; w.z = rx[1]; w.w = ry[1];
    if (ok) *(GAS v4u*)(base + 8 * h) = w;
}
template <int DV> __device__ __forceinline__ void attn_store(const f32x16 (&o)[DV / 32], float linv, bf16* out_row, int h, bool ok) {
#pragma unroll
    for (int dt = 0; dt < DV / 32; ++dt)
#pragma unroll
        for (int g = 0; g < 4; g += 2) { v2u a, b;
            a.x = pk2bf(o[dt][4 * g] * linv, o[dt][4 * g + 1] * linv); a.y = pk2bf(o[dt][4 * g + 2] * linv, o[dt][4 * g + 3] * linv);
            b.x = pk2bf(o[dt][4 * g + 4] * linv, o[dt][4 * g + 5] * linv); b.y = pk2bf(o[dt][4 * g + 6] * linv, o[dt][4 * g + 7] * linv);
            st_pair16(out_row + 32 * dt + 8 * g, a, b, h, ok); }
}

__device__ __forceinline__ void sb_unit(LAS unsigned char* wl  , const bf16* Qg, const bf16* Kg, const bf16* Vg  ,
                                        int q_row0, int qp0, int ktop  , int kv_row0, bf16* out  , int nvalid_q, int lane) {
    constexpr int VP = 192, PITCH = 1536;
    const int r = lane & 31, h = lane >> 5, q4 = (lane & 15) >> 2, p4 = lane & 3, blk = (lane >> 4) & 1;
    const int qp = qp0 + r;
    bf16x8 qf[4];
#pragma unroll
    for (int st = 0; st < 4; ++st) qf[st] = *(const GAS bf16x8*)(Qg + (size_t)(q_row0 + r) * PITCH + st * 16 + h * 8);
    f32x16 o[2];
#pragma unroll
    for (int dt = 0; dt < 2; ++dt)
#pragma unroll
        for (int i = 0; i < 16; ++i) o[dt][i] = 0.f;
    float carry = 0.f;
    bf16x8 kn[4]; v4u vn[4];
#define SB_LOAD(tile_) do { const int rowb_ = (tile_) >= 0 ? kv_row0 + 32 * (tile_) : META0; \
        _Pragma("unroll") for (int st_ = 0; st_ < 4; ++st_) kn[st_] = *(const GAS bf16x8*)(Kg + (size_t)(rowb_ + r) * PITCH + st_ * 16 + h * 8); \
        _Pragma("unroll") for (int j_ = 0; j_ < 4; ++j_) { const int p_ = lane + 64 * j_; vn[j_] = *(const GAS v4u*)(Vg + (size_t)(rowb_ + (p_ >> 3)) * PITCH + (p_ & 7) * 8); } } while (0)
    SB_LOAD(ktop);
    for (int tile = ktop; tile >= -1; --tile) {
        const int kp0 = tile >= 0 ? 16 + 32 * tile : 0, nval = tile >= 0 ? 32 : 16;
        bf16x8 kf[4]; v4u vr[4];
#pragma unroll
        for (int st = 0; st < 4; ++st) kf[st] = kn[st];
#pragma unroll
        for (int j = 0; j < 4; ++j) vr[j] = vn[j];
        asm volatile("" ::: "memory");
        if (tile > -1) SB_LOAD(tile - 1);
        asm volatile("" ::: "memory");
#pragma unroll
        for (int j = 0; j < 4; ++j) { const int p = lane + 64 * j; *(LAS v4u*)(wl + (p >> 3) * VP + (p & 7) * 16) = vr[j]; }
        f32x16 z;
#pragma unroll
        for (int i = 0; i < 16; ++i) z[i] = 0.f;
#pragma unroll
        for (int st = 0; st < 4; ++st) z = MFMA32(kf[st], qf[st], z);
        LDS_WAIT(); asm volatile("" ::: "memory");
        bf16x8 vfs[2][2];
#pragma unroll
        for (int dt = 0; dt < 2; ++dt)
#pragma unroll
            for (int ks = 0; ks < 2; ++ks) { const LAS unsigned char* vp = wl + (16 * ks + 4 * h + q4) * VP + (32 * dt + 16 * blk) * 2 + 8 * p4;
                const s16x4 lo = vtr(vp), hi = vtr(vp + 8 * VP); vfs[dt][ks] = (bf16x8){lo[0], lo[1], lo[2], lo[3], hi[0], hi[1], hi[2], hi[3]}; }
        float L[16]; bool vis[16];
#pragma unroll
        for (int i = 0; i < 16; ++i) { const int k = crow(i, h); vis[i] = (k < nval) && (kp0 + k < qp);
            const float a = fabsf(z[i]); const float sp = fmaxf(z[i], 0.f) + LN2 * __builtin_amdgcn_logf(1.f + __builtin_amdgcn_exp2f(-a * LOG2E));
            L[i] = vis[i] ? -sp : 0.f; }
        float G[4], PG[4];
#pragma unroll
        for (int g = 0; g < 4; ++g) { G[g] = (L[4 * g] + L[4 * g + 1]) + (L[4 * g + 2] + L[4 * g + 3]); const auto sg_ = __builtin_amdgcn_permlane32_swap(__float_as_uint(G[g]), __float_as_uint(G[g]), false, false); PG[g] = __uint_as_float(h ? sg_[0] : sg_[1]); }
        float after[4]; float acc = 0.f;
#pragma unroll
        for (int g = 3; g >= 0; --g) { after[g] = acc + (h == 0 ? PG[g] : 0.f); acc += G[g] + PG[g]; }
        float w[16];
#pragma unroll
        for (int g = 0; g < 4; ++g) { float suf = 0.f;
#pragma unroll
            for (int e = 3; e >= 0; --e) { const int i = 4 * g + e; const float btw = carry + after[g] + suf; suf += L[i];
                w[i] = vis[i] ? __builtin_amdgcn_exp2f((z[i] + L[i] + btw) * LOG2E) : 0.f; } }
        carry += acc;
        bf16x8 pf[2];
        { v4u x;
          x.x = pk2bf(w[0], w[1]); x.y = pk2bf(w[2], w[3]); x.z = pk2bf(w[4], w[5]); x.w = pk2bf(w[6], w[7]); pf[0] = __builtin_bit_cast(bf16x8, x);
          x.x = pk2bf(w[8], w[9]); x.y = pk2bf(w[10], w[11]); x.z = pk2bf(w[12], w[13]); x.w = pk2bf(w[14], w[15]); pf[1] = __builtin_bit_cast(bf16x8, x); }
#pragma unroll
        for (int dt = 0; dt < 2; ++dt)
#pragma unroll
            for (int ks = 0; ks < 2; ++ks) o[dt] = MFMA32(vfs[dt][ks], pf[ks], o[dt]);
        LDS_WAIT(); asm volatile("" ::: "memory");
        if (__all(carry < -36.f)) break;
    }
#undef SB_LOAD
    attn_store<64>(o, 1.f, out + (size_t)(q_row0 + r) * 1024, h, r < nvalid_q);
}
struct Args { const float* in[28]; float* out; unsigned char* ws; int lo, hi, clo, chi; };
enum { I_X = 0, I_META, I_LN_MIX_E, I_W_IN_E, I_LN_Q, I_W_UQ, I_LN_KV, I_W_UKV, I_W_OUT_E, I_LN_FFN_E, I_W_GATE_E, I_W_UP_E, I_W_DOWN_E, I_LN_MIX_O, I_W_IN_O, I_B_FORGET,
       I_LQ1, I_LK1, I_LQ2, I_LK2, I_SUBLN, I_W_OUT_O, I_LN_FFN_O, I_W_ROUTER, I_W_MGATE, I_W_MUP, I_W_MDOWN, I_LN_FINAL };
constexpr int N_PHASES = 18;
constexpr float LAM_INIT = 0.35550906759096927f;
constexpr float SC_MLA = 0.10206207261596575f * LOG2E, SC_64 = 0.125f * LOG2E;

typedef const __attribute__((address_space(4))) Args* CArgs;
__device__ __forceinline__ CArgs fresh_args() { CArgs p = (CArgs)__builtin_amdgcn_kernarg_segment_ptr(); asm volatile("" : "+s"(p)); return p; }
#define PH() CArgs A = fresh_args(); unsigned char* const ws = A->ws; int tid = threadIdx.x; asm volatile("" : "+v"(tid)); \
    const int lane = tid & 63, wave = __builtin_amdgcn_readfirstlane(tid >> 6); const int G = gridDim.x, bx = blockIdx.x, vcu = (G % 8 == 0) ? (bx % 8) * (G / 8) + bx / 8 : bx; \
    const int gw = vcu * NWAVES + wave, NGW = G * NWAVES, gt = vcu * 512 + tid, NGT = G * 512; const int WPB = NGW >> 3, r0_ = (gw / WPB) * 4096 + gw % WPB, NIT_ = 2048 / WPB; LAS unsigned char* const lds = (LAS unsigned char*)lds_raw; \
    bf16* const HN = (bf16*)(ws + WS_HN); float* const HMETA = (float*)(ws + WS_HMETA); \
    (void)lane; (void)wave; (void)gw; (void)NGW; (void)gt; (void)NGT; (void)lds; (void)HN; (void)HMETA; (void)vcu
#define PH_TABLES() const float* cosM = (const float*)(ws + WS_COSM); const float* sinM = (const float*)(ws + WS_SINM); const float* cosD = (const float*)(ws + WS_COSD); const float* sinD = (const float*)(ws + WS_SIND); \
    (void)cosM; (void)sinM; (void)cosD; (void)sinD

__global__ void __launch_bounds__(NWAVES * 64, 2) hybrid_fwd(Args a_unused) {
    extern __shared__ __attribute__((aligned(16))) unsigned char lds_raw[];
    int lo, hi;
    XcdBarrier bar;
    { CArgs A = fresh_args(); lo = A->lo; hi = A->hi;
      LAS unsigned char* const lds = (LAS unsigned char*)lds_raw;
      for (int u = threadIdx.x; u < (LDS_BYTES - LDSCTL_OFF) / 4; u += NWAVES * 64) ((LAS unsigned*)(lds + LDSCTL_OFF))[u] = 0u;
      __syncthreads();
      bar = xcd_barrier_post((unsigned*)(A->ws + WS_CTL) + CW_BAR, (volatile LAS unsigned*)(lds + MISC_OFF) + 8); }
#ifndef PHMASK
#define PHMASK 0xFFFFFFFFu
#endif
#define IN(k) (((PHMASK >> (k)) & 1u) && lo <= (k) && (k) < hi)
#ifndef REPMASK
#define REPMASK 0u
#endif
#if REPMASK == 0u
#define PHASE(k) if (IN(k))
#else
#define PHASE(k) for (int rep_ = 0; rep_ < (IN(k) ? 1 + (int)((REPMASK >> (k)) & 1u) : 0); ++rep_)
#endif
#define SEAM(k) do { if (IN(k) && IN((k) + 1)) xcd_barrier(bar); } while (0)

    PHASE(0) { PH();
        LAS float* scr = (LAS float*)(lds + wave * 16384);
        RowRaw<false> ca, cb, na, nb; row_raw_load<false>(A->in[I_X] + (size_t)r0_ * DM, lane, ca); row_raw_load<false>(A->in[I_X] + (size_t)(r0_ + WPB) * DM, lane, cb);
        if (gw < 256) colmax_job(A->in[I_W_IN_E], 1952, 1952, gw % 8, gw / 8, (float*)(ws + WS_CMAXP0), 2048, -1, lane);
        else if (gw < 960) { const int it = gw - 256, mtx = it / 352, r_ = it % 352; colmax_job(A->in[mtx ? I_W_UP_E : I_W_GATE_E], DFF, DFF, r_ % 11, r_ / 11, (float*)(ws + WS_CMAXP), CMAX_LD, mtx * 128, lane); }
        else if (gw < 1344) { const int it = gw - 960; colmax_job(A->in[I_W_IN_O], 3080, 3072, it % 12, it / 12, (float*)(ws + WS_CMAXP1), 3072, -1, lane); }
        constexpr int C1 = 96, C2 = C1 + 64, C3 = C2 + 512, C4 = C3 + 1408, C5 = C4 + 512;
        for (int it = gw; it < C5; it += NGW) {
            if (it < C1) tr_job<0>(it, A->in[I_W_UQ], 256, 768, 0, 768, (bf16*)(ws + WS_WUQKV), 384, 0, 0, SC_MLA, scr, lane);
            else if (it < C2) tr_job<0>(it - C1, A->in[I_W_UKV], 128, 1024, 0, 1024, (bf16*)(ws + WS_WUQKV), 384, 256, 768, 1.f, scr, lane);
            else if (it < C3) tr_job<0>(it - C2, A->in[I_W_OUT_E], 1024, 1024, 0, 1024, (bf16*)(ws + WS_WOUT0), 1024, 0, 0, 1.f, scr, lane);
            else if (it < C4) { tr_job<0>(it - C3, A->in[I_W_DOWN_E], DFF, 1024, 0, 1024, (bf16*)(ws + WS_WDN0), DFF, 0, 0, 1.f, scr, lane);
                const int it2 = it - C3, kb2 = it2 / 32, n02 = 32 * (it2 % 32); f32x4 cv2[8]; tr_load(A->in[I_W_DOWN_E], 1024, kb2 * 64, n02, lane, cv2); tr_finish(cv2, (bf16*)(ws + WS_WDN0F8), DFF, n02, kb2 * 64, scr, lane, true); }
            else tr_job<0>(it - C4, A->in[I_W_OUT_O], 1024, 1024, 0, 1024, (bf16*)(ws + WS_WOUT1), 1024, 0, 0, 1.f, scr, lane);
        }
        { const v4u z = {0u, 0u, 0u, 0u};
          GAS v4u* wu = (GAS v4u*)(ws + WS_WUQKV);
          for (int i = gt; i < 768 * 16; i += NGT) wu[(size_t)(i >> 4) * 48 + 32 + (i & 15)] = z;
          for (int i = gt; i < 1024 * 32; i += NGT) wu[(size_t)(768 + (i >> 5)) * 48 + (i & 31)] = z; }
        { float* cM = (float*)(ws + WS_COSM); float* sM = (float*)(ws + WS_SINM); float* cD = (float*)(ws + WS_COSD); float* sD = (float*)(ws + WS_SIND);
          for (int idx = gt; idx < 4352 * 16; idx += NGT) { const int pos = idx >> 4, i = idx & 15; const float inv = __builtin_amdgcn_exp2f(-(float)i * (13.287712379549449f / 16.f));
              double rev = (double)pos * (double)inv * 0.15915494309189535; rev -= floor(rev); const float fr = (float)rev; cM[idx] = __builtin_amdgcn_cosf(fr); sM[idx] = __builtin_amdgcn_sinf(fr); }
          for (int idx = gt; idx < 4352 * 8; idx += NGT) { const int pos = idx >> 3, i = idx & 7; const float inv = __builtin_amdgcn_exp2f(-(float)i * (18.931568569324174f / 8.f));
              double rev = (double)pos * (double)inv * 0.15915494309189535; rev -= floor(rev); const float fr = (float)rev; cD[idx] = __builtin_amdgcn_cosf(fr); sD[idx] = __builtin_amdgcn_sinf(fr); } }
        {
          for (int it_ = 0, row = r0_; it_ < NIT_; ++it_, row += 2 * WPB) { f32x4 va[4], vb[4]; const int rb = row + WPB, nrow = row + 2 * WPB; const bool more = it_ + 1 < NIT_;
            if (more) { row_raw_load<false>(A->in[I_X] + (size_t)nrow * DM, lane, na); row_raw_load<false>(A->in[I_X] + (size_t)(nrow + WPB) * DM, lane, nb); }
            rms_row2_i8<false>(ca, cb, A->in[I_LN_MIX_E], ws + WS_HN + (size_t)row * DM, ws + WS_HN + (size_t)rb * DM, (float*)(ws + WS_RSC) + row, (float*)(ws + WS_RSC) + rb, lane, va, vb);
            if (more) { ca = na; cb = nb; } } }
        for (int row = NTOK + gw; row < MR; row += NGW) { f32x4 v[4];
            if (row - NTOK < 16) rms_row_q(A->in[I_META] + (size_t)(row - NTOK) * DM, A->in[I_LN_MIX_E], HN + (size_t)row * DM, ws + WS_HN + (size_t)row * DM, (float*)(ws + WS_RSC) + row, lane, v);
            else zero_row(HN + (size_t)row * DM, lane); }
        xcd_barrier(bar);
        for (int it = gw; it < 976; it += NGW) { const int kb = it / 61, n0 = 32 * (it % 61);
            tr_item_q8(A->in[I_W_IN_E], 1952, ws + WS_WIN0Q, 1024, n0, (const float*)(ws + WS_CMAXP0), 2048, (float*)(ws + WS_CSC0), n0 < 512 ? 0.125f : 1.f, scr, kb * 64, n0, lane); }
        { const v4u z = {0u, 0u, 0u, 0u}; GAS v4u* w0 = (GAS v4u*)(ws + WS_WIN0Q + (size_t)1952 * 1024);
          for (int i = gt; i < 96 * 64; i += NGT) w0[i] = z;
          for (int i = gt; i < 96; i += NGT) ((float*)(ws + WS_CSC0))[1952 + i] = 0.f; }
    }
    SEAM(0);
    PHASE(1) { PH(); PH_TABLES();
        for (int j = vcu; j < 64; j += G) { f32x4 c0, c1; mini_pair_i8(ws + WS_HN + (size_t)META0 * DM, 1024, 8, ws + WS_WIN0Q, 32 * j, 32 * j + 16, (const float*)(ws + WS_RSC) + META0, (const float*)(ws + WS_CSC0), lane, wave, (LAS float*)lds, c0, c1); if (wave != 0) continue;
            const int mrow = META0 + (lane & 15);
#pragma unroll
            for (int blk = 0; blk < 2; ++blk) { const int c = 32 * j + 16 * blk + 4 * (lane >> 4);
                bf16* dst = c < 1536 ? (bf16*)(ws + WS_SB) + (size_t)mrow * 1536 + c : (bf16*)(ws + WS_CM) + (size_t)mrow * 512 + (c - 1536); st4bf(dst, blk ? c1 : c0); } }
        zero_fill16(ws + WS_SB + (size_t)(META0 + 16) * 1536 * 2, 48, 1536 * 2, 512 * 2, 1024 * 2, gt, NGT);
        int k1 = 512; asm volatile("" : "+s"(k1));
        pg8::Gemm g{(const bf16*)(ws + WS_HN), (const bf16*)(ws + WS_WIN0Q), NTOK, 2048, k1}; pg8::StaticOrder S; S.init(NTOK, 2048, G, (int)blockIdx.x);
        pg8::EpiIn0I8 E{(bf16*)(ws + WS_SB), (bf16*)(ws + WS_CM), (const float*)(ws + WS_RSC), (const float*)(ws + WS_CSC0)};
        pg8::gemm_phase<pg8::EpiIn0I8, pg8::StaticOrder, true, true, false, true>(lds + RING_OFF, g, S, E);
    }
    SEAM(1);
    PHASE(2) { PH(); PH_TABLES();
        const bf16* CM = (const bf16*)(ws + WS_CM); bf16* CQ = (bf16*)(ws + WS_CQKV); bf16* KC = (bf16*)(ws + WS_KC);
        const float* gq = A->in[I_LN_Q]; const float* gkv = A->in[I_LN_KV];
        for (int ph = 0; ph < 2; ++ph) {
        if ((ph == 0) == (wave < 4)) {
        const bf16* SBQ = (const bf16*)(ws + WS_SB);
        LAS unsigned char* wl = lds + wave * 6144;
#pragma unroll 1
        for (int ku = 0; ku <= 1024 / WPB; ++ku) { const int u = ku < 1024 / WPB ? (gw / WPB) * 1024 + gw % WPB + WPB * ku : 8192 + gw; if (u >= 8192 + 8) break;
            const bool mt = u >= 8192; const int bh = mt ? 0 : (u >> 7), qt = u & 127, b = bh >> 3, hh = mt ? (u - 8192) : (bh & 7);
            sb_unit(wl, SBQ + hh * 64, SBQ + 512 + hh * 64, SBQ + 1024 + hh * 64, mt ? META0 : b * SEQ + 32 * qt, mt ? 0 : 16 + 32 * qt, mt ? -1 : qt, b * SEQ, HN + hh * 64, mt ? 16 : 32, lane);
        }
        } else {
        const f32x4 g4 = *(const GAS f32x4*)(gq + 4 * lane); const float gk0 = gkv[2 * lane], gk1 = gkv[2 * lane + 1]; const int ri = lane & 15, part = lane >> 4;
#define PREP_LOAD(row_, S) const bf16* cm##S = CM + (size_t)(row_) * 512; const v2u raw##S = *(const GAS v2u*)(cm##S + 4 * lane); const unsigned rw2##S = *(const GAS unsigned*)(cm##S + 256 + 2 * lane); \
            const int pos##S = row_pos(row_); const bf16 ra1##S = cm##S[384 + ri], ra2##S = cm##S[400 + ri]; const float co##S = cosM[pos##S * 16 + ri], si##S = sinM[pos##S * 16 + ri]
#define PREP_SUMS(S) const float x0##S = bf2f(raw##S.x & 0xffffu), x1##S = __uint_as_float(raw##S.x & 0xffff0000u), x2##S = bf2f(raw##S.y & 0xffffu), x3##S = __uint_as_float(raw##S.y & 0xffff0000u); \
            const float y0##S = bf2f(rw2##S & 0xffffu), y1##S = __uint_as_float(rw2##S & 0xffff0000u); float sq##S = (x0##S * x0##S + x1##S * x1##S) + (x2##S * x2##S + x3##S * x3##S), sk##S = y0##S * y0##S + y1##S * y1##S
#define PREP_STORE(row_, S) do { const float rq_ = 1.f / sqrtf(sq##S * (1.f / 256.f) + EPS), rk_ = 1.f / sqrtf(sk##S * (1.f / 128.f) + EPS); \
            v2u w_; w_.x = pk2bf(x0##S * rq_ * g4.x, x1##S * rq_ * g4.y); w_.y = pk2bf(x2##S * rq_ * g4.z, x3##S * rq_ * g4.w); *(GAS v2u*)(CQ + (size_t)(row_) * 384 + 4 * lane) = w_; \
            *(GAS unsigned*)(CQ + (size_t)(row_) * 384 + 256 + 2 * lane) = pk2bf(y0##S * rk_ * gk0, y1##S * rk_ * gk1); \
            const float r1_ = bf2f(ra1##S), r2_ = bf2f(ra2##S); const unsigned pk_ = pk2bf(r1_ * co##S - r2_ * si##S, r2_ * co##S + r1_ * si##S); \
            bf16* kr_ = KC + (size_t)(row_) * 768 + (2 * part) * 96 + 64 + ri; kr_[0] = (bf16)(pk_ & 0xffffu); kr_[16] = (bf16)(pk_ >> 16); kr_[96] = (bf16)(pk_ & 0xffffu); kr_[96 + 16] = (bf16)(pk_ >> 16); } while (0)
        for (int it_ = 0, row = r0_; it_ < NIT_; ++it_, row += 2 * WPB) { const int rowb = row + WPB;
            PREP_LOAD(row, A_); PREP_LOAD(rowb, B_); PREP_SUMS(A_); PREP_SUMS(B_);
#pragma unroll
            for (int o = 1; o < 64; o <<= 1) { sqA_ += __shfl_xor(sqA_, o); skA_ += __shfl_xor(skA_, o); sqB_ += __shfl_xor(sqB_, o); skB_ += __shfl_xor(skB_, o); }
            PREP_STORE(row, A_); PREP_STORE(rowb, B_); }
        if (gw < 16) { const int row = NTOK + gw; PREP_LOAD(row, A_); PREP_SUMS(A_);
#pragma unroll
            for (int o = 1; o < 64; o <<= 1) { sqA_ += __shfl_xor(sqA_, o); skA_ += __shfl_xor(skA_, o); }
            PREP_STORE(row, A_); }
#undef PREP_LOAD
#undef PREP_SUMS
#undef PREP_STORE
        } }
    }
    SEAM(2);
    PHASE(3) { PH(); PH_TABLES();
        int k3 = 256; asm volatile("" : "+s"(k3));
        for (int j = vcu; j < 56; j += G) { f32x4 c0, c1; mini_pair((const bf16*)(ws + WS_CQKV) + (size_t)META0 * 384, 384, 4, (const bf16*)(ws + WS_WUQKV), 32 * j, 32 * j + 16, lane, wave, (LAS float*)lds, c0, c1); if (wave != 0) continue;
            const int m16 = lane & 15, mrow = META0 + m16, fq = lane >> 4;
            if (j < 24) {
                if (j % 3 == 2) { const f32x4 cc = *(const GAS f32x4*)(cosM + m16 * 16 + 4 * fq), ss = *(const GAS f32x4*)(sinM + m16 * 16 + 4 * fq);
#pragma unroll
                    for (int e = 0; e < 4; ++e) { const float x1 = c0[e], x2 = c1[e]; c0[e] = x1 * cc[e] - x2 * ss[e]; c1[e] = x2 * cc[e] + x1 * ss[e]; } }
                bf16* dst = (bf16*)(ws + WS_QMLA) + (size_t)mrow * 768 + 32 * j + 4 * fq; st4bf(dst, c0); st4bf(dst + 16, c1);
            } else {
#pragma unroll
                for (int blk = 0; blk < 2; ++blk) { const int cp = 32 * (j - 24) + 16 * blk + 4 * fq, head = cp >> 7, within = cp & 127;
                    bf16* dst = within < 64 ? (bf16*)(ws + WS_KC) + (size_t)mrow * 768 + head * 96 + within : (bf16*)(ws + WS_VC) + (size_t)mrow * 512 + head * 64 + within - 64; st4bf(dst, blk ? c1 : c0); }
            } }
        zero_fill16(ws + WS_KC + (size_t)(META0 + 16) * 768 * 2, 48, 768 * 2, 0, 768 * 2, gt, NGT);
        zero_fill16(ws + WS_VC + (size_t)(META0 + 16) * 512 * 2, 48, 512 * 2, 0, 512 * 2, gt, NGT);
        pg8::EpiUqkv E{(bf16*)(ws + WS_QMLA), (bf16*)(ws + WS_KC), (bf16*)(ws + WS_VC), cosM, sinM, 0};
        pg8::Gemm g{(const bf16*)(ws + WS_CQKV), (const bf16*)(ws + WS_WUQKV), NTOK, 1792, k3, 384}; pg8::UqkvOrder S; S.so.init(NTOK, 1792, G, (int)blockIdx.x);
        pg8::gemm_phase<pg8::EpiUqkv, pg8::UqkvOrder, true, true>(lds + RING_OFF, g, S, E);
    }
    SEAM(3);
    PHASE(4) { PH(); PH_TABLES();
        const bf16* QM = (const bf16*)(ws + WS_QMLA); const bf16* KC = (const bf16*)(ws + WS_KC); const bf16* VC = (const bf16*)(ws + WS_VC);
        const int v = vcu, r = lane & 31, h = lane >> 5;
        LAS float* cscr = (LAS float*)(lds + 61440 + wave * 8448);
        const MoeConv CV{A->in[I_W_MGATE], A->in[I_W_MUP], A->in[I_W_MDOWN], (bf16*)(ws + WS_WMG), (bf16*)(ws + WS_WMD)};
        int cv_it = gw;
        AttnCarry<96, 64> cy; cy.valid = false;
#pragma unroll 1
        for (int i = 0; i < 5; ++i) {
            int hh, q_row0, kv_row0, NT, qp0; bool meta = false;
            if (i < 4) { const int s = v & 3, bh = v >> 2, b = bh >> 3; hh = bh & 7; const int qb = i == 0 ? s : (i == 1 ? 15 - s : (i == 2 ? 4 + s : 11 - s));
                q_row0 = b * SEQ + 256 * qb; kv_row0 = b * SEQ; NT = 4 * qb + 4; qp0 = 16 + 256 * qb; }
            else { if (v >= 8) break; hh = v; q_row0 = META0; kv_row0 = 0; NT = 0; qp0 = 0; meta = true; }
            const int qrow = q_row0 + 32 * wave + r, qp_lo = qp0 + 32 * wave;
            f32x16 o[2]; float linv;
            AttnNext nx; nx.has = i < 3;
            { const int s_ = v & 3, qbn = i == 0 ? 15 - s_ : (i == 1 ? 4 + s_ : 11 - s_); nx.qrow = QM + (size_t)(kv_row0 + 256 * qbn + 32 * wave + r) * 768 + hh * 96; nx.Kg = KC + hh * 96; nx.Vg = VC + hh * 64; nx.cb_real = nullptr; nx.cb_meta = nullptr; nx.kv_row0 = kv_row0; nx.first_tile = 0; }
            attn_pass<96, 64, false, false, false, true, true, 0>(lds, QM + (size_t)qrow * 768 + hh * 96, KC + hh * 96, 768, VC + hh * 64, 512, kv_row0, NT, qp_lo + r, qp_lo, qp_lo + 31, nullptr, nullptr, o, linv, cv_it, NGW, CV, cscr, 0.f, &cy, &nx);
            attn_store<64>(o, linv, HN + (size_t)qrow * 1024 + 512 + hh * 64, h, !meta || (wave == 0 && r < 16));
        }
#pragma unroll 1
        for (; cv_it < MOE_CONV_ITEMS; cv_it += NGW) { const ConvItem ci = moe_conv_item(cv_it, CV); f32x4 cvv[8]; tr_load(ci.W, ci.ldw, ci.k0, ci.n0, lane, cvv); tr_finish(cvv, ci.WT, ci.Kd, ci.drow0, ci.k0, cscr, lane, ci.fp8); }
    }
    SEAM(4);
    PHASE(5) { PH(); PH_TABLES();
        for (int j = vcu; j < 32; j += G) { f32x4 c0, c1; mini_pair(HN + (size_t)META0 * DM, 1024, 8, (const bf16*)(ws + WS_WOUT0), 32 * j, 32 * j + 16, lane, wave, (LAS float*)lds, c0, c1); if (wave != 0) continue;
            const size_t off = (size_t)(lane & 15) * DM + 32 * j + 4 * (lane >> 4);
            *(GAS f32x4*)(HMETA + off) = *(const GAS f32x4*)(A->in[I_META] + off) + c0; *(GAS f32x4*)(HMETA + off + 16) = *(const GAS f32x4*)(A->in[I_META] + off + 16) + c1; }
        pg8::Gemm g{HN, (const bf16*)(ws + WS_WOUT0), NTOK, 1024, 1024}; pg8::StaticOrder S; S.init(NTOK, 1024, G, (int)blockIdx.x);
        pg8::EpiResidP<false, true> E{A->in[I_X], ws + WS_H16, nullptr, 1 << 20};
        pg8::gemm_phase<pg8::EpiResidP<false, true>, pg8::StaticOrder, true, true>(lds + RING_OFF, g, S, E);
    }
    SEAM(5);
    PHASE(6) { PH(); PH_TABLES();
        const bf16* H1 = (const bf16*)(ws + WS_H16); RowRaw<true> ca, cb, na, nb; row_raw_load<true>(H1 + (size_t)r0_ * DM, lane, ca); row_raw_load<true>(H1 + (size_t)(r0_ + WPB) * DM, lane, cb);
        { LAS float* scr = (LAS float*)(lds + wave * 16384);
          for (int it = gw; it < 2816; it += NGW) { const int mtx = it / 1408, j = it % 1408, kb = j / 88, n0 = 32 * (j % 88);
              tr_item_q8(A->in[mtx ? I_W_UP_E : I_W_GATE_E], DFF, ws + WS_WGU0Q, 1024, mtx * 128 + 256 * (n0 / 128) + (n0 % 128), (const float*)(ws + WS_CMAXP), CMAX_LD, (float*)(ws + WS_CSC), 1.f, scr, kb * 64, n0, lane); }
          for (int it = gw; it < 1536; it += NGW) { const int kb = it / 96, n0 = 32 * (it % 96); const bool qk = n0 < 512 || (n0 >= 1536 && n0 < 2048);
              tr_item_q8(A->in[I_W_IN_O], 3080, ws + WS_WIN1Q, 1024, n0, (const float*)(ws + WS_CMAXP1), 3072, (float*)(ws + WS_CSC1), qk ? SC_64 : 1.f, scr, kb * 64, n0, lane); } }
        { float* RS = (float*)(ws + WS_RSC);
          for (int it_ = 0, row = r0_; it_ < NIT_; ++it_, row += 2 * WPB) { const int rb = row + WPB, nrow = row + 2 * WPB; const bool more = it_ + 1 < NIT_; f32x4 va[4], vb[4];
            if (more) { row_raw_load<true>(H1 + (size_t)nrow * DM, lane, na); row_raw_load<true>(H1 + (size_t)(nrow + WPB) * DM, lane, nb); }
            rms_row2_i8<true>(ca, cb, A->in[I_LN_FFN_E], ws + WS_HN + (size_t)row * DM, ws + WS_HN + (size_t)rb * DM, RS + row, RS + rb, lane, va, vb);
            if (more) { ca = na; cb = nb; } } }
        for (int row = NTOK + gw; row < MR; row += NGW) { f32x4 v[4];
            if (row - NTOK < 16) rms_row_q(HMETA + (size_t)(row - NTOK) * DM, A->in[I_LN_FFN_E], HN + (size_t)row * DM, ws + WS_HN + (size_t)row * DM, (float*)(ws + WS_RSC) + row, lane, v);
            else zero_row(HN + (size_t)row * DM, lane); }
    }
    SEAM(6);
    PHASE(7) { PH(); PH_TABLES();
        for (int j = vcu; j < DFF / 16; j += G) { f32x4 c0, c1; const int cc = 16 * j, rb = 256 * (cc / 128) + (cc % 128);
            mini_pair_i8(ws + WS_HN + (size_t)META0 * DM, 1024, 8, ws + WS_WGU0Q, rb, rb + 128, (const float*)(ws + WS_RSC) + META0, (const float*)(ws + WS_CSC), lane, wave, (LAS float*)lds, c0, c1); if (wave != 0) continue;
            f32x4 act;
#pragma unroll
            for (int e = 0; e < 4; ++e) act[e] = c0[e] * __builtin_amdgcn_rcpf(1.f + __builtin_amdgcn_exp2f(-LOG2E * c0[e])) * c1[e];
            st4bf((bf16*)(ws + WS_ACT0) + (size_t)(META0 + (lane & 15)) * DFF + cc + 4 * (lane >> 4), act); }
        int k7 = 512; asm volatile("" : "+s"(k7));
        pg8::Gemm g{(const bf16*)(ws + WS_HN), (const bf16*)(ws + WS_WGU0Q), NTOK, 2 * DFF, k7}; pg8::StaticOrder S; S.init(NTOK, 2 * DFF, G, (int)blockIdx.x);
        pg8::EpiSwigluI8 E{(bf16*)(ws + WS_ACT0), DFF, (const float*)(ws + WS_RSC), (const float*)(ws + WS_CSC), 1};
        pg8::gemm_phase<pg8::EpiSwigluI8, pg8::StaticOrder, true, true, false, true>(lds + RING_OFF, g, S, E);
    }
    SEAM(7);
    PHASE(8) { PH(); PH_TABLES();
        for (int j = vcu; j < 32; j += G) { f32x4 c0, c1; mini_pair((const bf16*)(ws + WS_ACT0) + (size_t)META0 * DFF, DFF, 8, (const bf16*)(ws + WS_WDN0), 32 * j, 32 * j + 16, lane, wave, (LAS float*)lds, c0, c1); if (wave != 0) continue;
            const size_t off = (size_t)(lane & 15) * DM + 32 * j + 4 * (lane >> 4);
            *(GAS f32x4*)(HMETA + off) = *(const GAS f32x4*)(HMETA + off) + c0; *(GAS f32x4*)(HMETA + off + 16) = *(const GAS f32x4*)(HMETA + off + 16) + c1; }
        int k8 = DFF / 2; asm volatile("" : "+s"(k8));
        pg8::Gemm g{(const bf16*)(ws + WS_ACT0), (const bf16*)(ws + WS_WDN0F8), NTOK, 1024, k8}; pg8::StaticOrder S; S.init(NTOK, 1024, G, (int)blockIdx.x);
        pg8::EpiResidP<true, true> E{ws + WS_H16, ws + WS_H16, nullptr, 1 << 20, 1.f / WMG_SCALE};
        pg8::gemm_phase<pg8::EpiResidP<true, true>, pg8::StaticOrder, true, true, true>(lds + RING_OFF, g, S, E);
    }
    SEAM(8);
    PHASE(9) { PH(); PH_TABLES();
        W8 WF; w8_load(WF, A->in[I_W_IN_O] + 3072, 3080, lane);
        float* LF = (float*)(ws + WS_LF); const int fe_ = bitrev3(lane & 7); const float fb_ = A->in[I_B_FORGET][fe_];
#define LF_ROW(v_, row_) do { const float val_ = dot8_reduce(v_, WF, lane); \
            if (lane < 8) { const float f_ = val_ + fb_; LF[(size_t)(row_) * 8 + fe_] = fminf(f_, 0.f) - LN2 * __builtin_amdgcn_logf(1.f + __builtin_amdgcn_exp2f(-fabsf(f_) * LOG2E)); } } while (0)
        { const bf16* H2 = (const bf16*)(ws + WS_H16); RowRaw<true> ca, cb, na, nb; row_raw_load<true>(H2 + (size_t)r0_ * DM, lane, ca); row_raw_load<true>(H2 + (size_t)(r0_ + WPB) * DM, lane, cb);
          for (int it_ = 0, row = r0_; it_ < NIT_; ++it_, row += 2 * WPB) { f32x4 va[4], vb[4]; const int rb = row + WPB, nrow = row + 2 * WPB; const bool more = it_ + 1 < NIT_;
            if (more) { row_raw_load<true>(H2 + (size_t)nrow * DM, lane, na); row_raw_load<true>(H2 + (size_t)(nrow + WPB) * DM, lane, nb); }
            rms_row2_i8<true>(ca, cb, A->in[I_LN_MIX_O], ws + WS_HN + (size_t)row * DM, ws + WS_HN + (size_t)rb * DM, (float*)(ws + WS_RSC) + row, (float*)(ws + WS_RSC) + rb, lane, va, vb);
            LF_ROW(va, row); LF_ROW(vb, rb);
            if (more) { ca = na; cb = nb; } } }
        for (int row = NTOK + gw; row < MR; row += NGW) { f32x4 v[4];
            if (row - NTOK >= 16) { zero_row(HN + (size_t)row * DM, lane); continue; }
            rms_row_q(HMETA + (size_t)(row - NTOK) * DM, A->in[I_LN_MIX_O], HN + (size_t)row * DM, ws + WS_HN + (size_t)row * DM, (float*)(ws + WS_RSC) + row, lane, v);
            LF_ROW(v, row); }
#undef LF_ROW
        __syncthreads();
    }
    SEAM(9);
    PHASE(10) { PH(); PH_TABLES();
        if (vcu >= 128 && vcu < 192) {
            const float* LF = (const float*)(ws + WS_LF); float* CF = (float*)(ws + WS_CFOX); float* CMT = (float*)(ws + WS_CMETA);
            const int bh = vcu - 128, b = bh >> 3, hh = bh & 7; LAS float* wtot = (LAS float*)lds;
            if (wave == 0) { float mv = lane < 16 ? LF[(size_t)(META0 + lane) * 8 + hh] : 0.f;
#pragma unroll
                for (int o = 1; o < 16; o <<= 1) { const float t = __shfl_up(mv, o); if (lane >= o) mv += t; }
                if (b == 0 && lane < 16) CMT[hh * 64 + lane] = mv * LOG2E;
                if (lane == 15) wtot[8] = mv; }
            const float* src = LF + (size_t)(b * SEQ + 8 * tid) * 8 + hh; float v[8];
#pragma unroll
            for (int k = 0; k < 8; ++k) v[k] = src[k * 8];
#pragma unroll
            for (int k = 1; k < 8; ++k) v[k] += v[k - 1];
            const float tot = v[7]; float inc = tot;
#pragma unroll
            for (int o = 1; o < 64; o <<= 1) { const float t = __shfl_up(inc, o); if (lane >= o) inc += t; }
            if (lane == 63) wtot[wave] = inc;
            __syncthreads();
            float off = wtot[8] + (inc - tot);
#pragma unroll
            for (int w = 0; w < 7; ++w) off += (w < wave) ? wtot[w] : 0.f;
            float* dst = CF + (size_t)(b * 8 + hh) * SEQ + 8 * tid;
            f32x4 o0, o1; o0.x = (v[0] + off) * LOG2E; o0.y = (v[1] + off) * LOG2E; o0.z = (v[2] + off) * LOG2E; o0.w = (v[3] + off) * LOG2E; o1.x = (v[4] + off) * LOG2E; o1.y = (v[5] + off) * LOG2E; o1.z = (v[6] + off) * LOG2E; o1.w = (v[7] + off) * LOG2E;
            *(GAS f32x4*)dst = o0; *(GAS f32x4*)(dst + 4) = o1;
            __syncthreads();
        }
        for (int j = vcu; j < 96; j += G) { f32x4 c0, c1; mini_pair_i8(ws + WS_HN + (size_t)META0 * DM, 1024, 8, ws + WS_WIN1Q, 32 * j, 32 * j + 16, (const float*)(ws + WS_RSC) + META0, (const float*)(ws + WS_CSC1), lane, wave, (LAS float*)lds, c0, c1); if (wave != 0) continue;
            const int m16 = lane & 15, fq = lane >> 4;
            if (j < 32 && (j & 1) == 0) {
                const f32x4 cc = *(const GAS f32x4*)(cosD + m16 * 8 + 4 * (fq & 1)), ss = *(const GAS f32x4*)(sinD + m16 * 8 + 4 * (fq & 1));
#pragma unroll
                for (int e = 0; e < 4; ++e) { const float o = __shfl_xor(c0[e], 32); c0[e] = fq < 2 ? c0[e] * cc[e] - o * ss[e] : c0[e] * cc[e] + o * ss[e]; } }
            if (j >= 64 && j < 80) {
                float ss = (c0[0] * c0[0] + c0[1] * c0[1]) + (c0[2] * c0[2] + c0[3] * c0[3]) + (c1[0] * c1[0] + c1[1] * c1[1]) + (c1[2] * c1[2] + c1[3] * c1[3]);
                ss += __shfl_xor(ss, 16); ss += __shfl_xor(ss, 32);
#pragma unroll
                for (int o_ = 1; o_ < 16; o_ <<= 1) ss = fmaxf(ss, __shfl_xor(ss, o_));
                const int colk = 32 * j - 2048;
                if (lane < 8) atomicMax((unsigned*)(ws + WS_CTL) + CW_KN + (lane * 8 + (colk >> 6)) * 2 + ((colk >> 5) & 1), __float_as_uint(ss)); }
            bf16* dst = (bf16*)(ws + WS_PROJ1) + (size_t)(META0 + m16) * 3072 + 32 * j + 4 * fq; st4bf(dst, c0); st4bf(dst + 16, c1); }
        zero_fill16(ws + WS_PROJ1 + (size_t)(META0 + 16) * 3072 * 2, 48, 3072 * 2, 0, 3072 * 2, gt, NGT);
        int k10 = 512; asm volatile("" : "+s"(k10));
        pg8::Gemm g{(const bf16*)(ws + WS_HN), (const bf16*)(ws + WS_WIN1Q), NTOK, 3072, k10}; pg8::StaticOrder S; S.init(NTOK, 3072, G, (int)blockIdx.x);
        pg8::EpiIn1I8 E{(bf16*)(ws + WS_PROJ1), cosD, sinD, (const float*)(ws + WS_RSC), (const float*)(ws + WS_CSC1), (unsigned*)(ws + WS_CTL) + CW_KN};
        pg8::gemm_phase<pg8::EpiIn1I8, pg8::StaticOrder, true, true, false, true>(lds + RING_OFF, g, S, E);
    }
    SEAM(10);
    PHASE(11) { PH(); PH_TABLES();
        const bf16* P1 = (const bf16*)(ws + WS_PROJ1);
        const int v = vcu, r = lane & 31, h = lane >> 5;
        int cvd = MOE_CONV_ITEMS; const MoeConv CVD{nullptr, nullptr, nullptr, nullptr, nullptr};
        const float lam = __builtin_amdgcn_exp2f(wave_sum(A->in[I_LQ1][lane] * A->in[I_LK1][lane]) * LOG2E) - __builtin_amdgcn_exp2f(wave_sum(A->in[I_LQ2][lane] * A->in[I_LK2][lane]) * LOG2E) + LAM_INIT;
#pragma unroll 1
        for (int i = 0; i < 2; ++i) {
            const int s = v & 7, bh = v >> 3, b = bh >> 2, hh = bh & 3, qb = i == 0 ? s : 15 - s;
            const int q_row0 = b * SEQ + 256 * qb, NT = 4 * qb + 4, qp_lo = 16 + 256 * qb + 32 * wave, qrow = q_row0 + 32 * wave + r;
            bf16* orow = HN + (size_t)qrow * 1024 + hh * 128;
#pragma unroll 1
            for (int m = 0; m < 2; ++m) {
                f32x16 o[4]; float linv;
                attn_pass<64, 128, false, false, false, true, false>(lds, P1 + (size_t)qrow * 3072 + hh * 128 + m * 64, P1 + 512 + hh * 128 + m * 64, 3072, P1 + 1024 + hh * 128, 3072, b * SEQ, NT, qp_lo + r, qp_lo, qp_lo + 31, nullptr, nullptr, o, linv, cvd, 0, CVD, nullptr);
                if (m == 0) {
                    attn_store<128>(o, linv, orow, h, true);
                } else {
                    float ss = 0.f;
#pragma unroll
                    for (int dt = 0; dt < 4; ++dt)
#pragma unroll
                        for (int g2 = 0; g2 < 4; g2 += 2) { const v4u pw = *(const GAS v4u*)(orow + 32 * dt + 8 * g2 + 8 * h);
                            const auto rx = __builtin_amdgcn_permlane32_swap(pw.x, pw.z, false, false); const auto ry = __builtin_amdgcn_permlane32_swap(pw.y, pw.w, false, false);
#pragma unroll
                            for (int gg = 0; gg < 2; ++gg) { const int g = g2 + gg; v2u p1; p1.x = rx[gg]; p1.y = ry[gg];
                            const float a0 = bf2f(p1.x & 0xffffu) - lam * o[dt][4 * g] * linv, a1 = __uint_as_float(p1.x & 0xffff0000u) - lam * o[dt][4 * g + 1] * linv;
                            const float a2 = bf2f(p1.y & 0xffffu) - lam * o[dt][4 * g + 2] * linv, a3 = __uint_as_float(p1.y & 0xffff0000u) - lam * o[dt][4 * g + 3] * linv;
                            o[dt][4 * g] = a0; o[dt][4 * g + 1] = a1; o[dt][4 * g + 2] = a2; o[dt][4 * g + 3] = a3; ss += (a0 * a0 + a1 * a1) + (a2 * a2 + a3 * a3); } }
                    ss += __shfl_xor(ss, 32);
                    const float rstd = (1.f - LAM_INIT) / sqrtf(ss * (1.f / 128.f) + EPS);
#pragma unroll
                    for (int dt = 0; dt < 4; ++dt)
#pragma unroll
                        for (int g = 0; g < 4; g += 2) { const int d0 = 32 * dt + 8 * g + 4 * h; const f32x4 gs = *(const GAS f32x4*)(A->in[I_SUBLN] + d0), gt_ = *(const GAS f32x4*)(A->in[I_SUBLN] + d0 + 8);
                            v2u wa, wb; wa.x = pk2bf(o[dt][4 * g] * rstd * gs.x, o[dt][4 * g + 1] * rstd * gs.y); wa.y = pk2bf(o[dt][4 * g + 2] * rstd * gs.z, o[dt][4 * g + 3] * rstd * gs.w);
                            wb.x = pk2bf(o[dt][4 * g + 4] * rstd * gt_.x, o[dt][4 * g + 5] * rstd * gt_.y); wb.y = pk2bf(o[dt][4 * g + 6] * rstd * gt_.z, o[dt][4 * g + 7] * rstd * gt_.w);
                            st_pair16(orow + 32 * dt + 8 * g, wa, wb, h, true); }
                }
            }
        }
        const float* CF = (const float*)(ws + WS_CFOX); const float* CMT = (const float*)(ws + WS_CMETA);
        AttnCarry<64, 64> cyf; cyf.valid = false;
#pragma unroll 1
        for (int i = 0; i < 4; ++i) {
            const int b = v >> 5, w_ = v & 31, ha = w_ & 3, s = w_ >> 2, hh = i < 2 ? ha : 7 - ha, qb = (i & 1) ? 15 - s : s;
            const int q_row0 = b * SEQ + 256 * qb, NT = 4 * qb + 4, qp_lo = 16 + 256 * qb + 32 * wave, qrow = q_row0 + 32 * wave + r;
            const unsigned* KN = (const unsigned*)(ws + WS_CTL) + CW_KN + (b * 8 + hh) * 2; const float kmax = sqrtf(__uint_as_float(KN[0]) + __uint_as_float(KN[1]));
            AttnNext nxf; nxf.has = i < 3;
            { const int in_ = i + 1, hn_ = in_ < 2 ? ha : 7 - ha, qbn = (in_ & 1) ? 15 - s : s;
              nxf.qrow = P1 + (size_t)(b * SEQ + 256 * qbn + 32 * wave + r) * 3072 + 1536 + hn_ * 64; nxf.Kg = P1 + 2048 + hn_ * 64; nxf.Vg = P1 + 2560 + hn_ * 64;
              nxf.cb_real = CF + (size_t)(b * 8 + hn_) * SEQ; nxf.cb_meta = CMT + hn_ * 64; nxf.kv_row0 = b * SEQ; nxf.first_tile = 4 * qbn + 4; }
            f32x16 o[2]; float linv;
            attn_pass<64, 64, true, true, true, true, false, 4>(lds, P1 + (size_t)qrow * 3072 + 1536 + hh * 64, P1 + 2048 + hh * 64, 3072, P1 + 2560 + hh * 64, 3072, b * SEQ, NT, qp_lo + r, qp_lo, qp_lo + 31,
                                          CF + (size_t)(b * 8 + hh) * SEQ, CMT + hh * 64, o, linv, cvd, 0, CVD, nullptr, kmax, &cyf, &nxf);
            attn_store<64>(o, linv, HN + (size_t)qrow * 1024 + 512 + hh * 64, h, true);
        }
    }
    SEAM(11);
    PHASE(12) { PH(); PH_TABLES();
        pg8::Gemm g{HN, (const bf16*)(ws + WS_WOUT1), NTOK, 1024, 1024}; pg8::StaticOrder S; S.init(NTOK, 1024, G, (int)blockIdx.x);
        pg8::EpiResidP<true, true> E{ws + WS_H16, ws + WS_H3A, ws + WS_H3B, H3_SPLIT / 256};
        pg8::gemm_phase<pg8::EpiResidP<true, true>, pg8::StaticOrder, true, true>(lds + RING_OFF, g, S, E);
    }
    SEAM(12);
#define TOK ((int4*)(ws + WS_TOK))
#define XS8 ((unsigned char*)(ws + WS_XS8))
#define YB ((bf16*)(ws + WS_Y))
    PHASE(13) { PH(); PH_TABLES();
        LAS float* wl = (LAS float*)lds;
        LAS unsigned* lcnt = (LAS unsigned*)(lds + 32768); LAS unsigned* lbase = lcnt + 16; typedef int v4i_t __attribute__((ext_vector_type(4))); LAS v4i_t* rec = (LAS v4i_t*)(lds + 32768 + 256);
        W8 WR; w8_load(WR, A->in[I_W_ROUTER], 8, lane);
        if (tid < 8) lcnt[tid] = 0u;
        __syncthreads();
#define ROUTE_ROW(v_, k_) do { float d[8]; { const int val_ = __float_as_int(dot8_reduce(v_, WR, lane)); \
            d[0] = __int_as_float(__builtin_amdgcn_readlane(val_, 0)); d[1] = __int_as_float(__builtin_amdgcn_readlane(val_, 4)); d[2] = __int_as_float(__builtin_amdgcn_readlane(val_, 2)); d[3] = __int_as_float(__builtin_amdgcn_readlane(val_, 6)); \
            d[4] = __int_as_float(__builtin_amdgcn_readlane(val_, 1)); d[5] = __int_as_float(__builtin_amdgcn_readlane(val_, 5)); d[6] = __int_as_float(__builtin_amdgcn_readlane(val_, 3)); d[7] = __int_as_float(__builtin_amdgcn_readlane(val_, 7)); } \
            int e0 = 0; float v0 = d[0]; \
            _Pragma("unroll") for (int e = 1; e < 8; ++e) if (d[e] > v0) { v0 = d[e]; e0 = e; } \
            int e1 = -1; float v1 = -INFINITY; \
            _Pragma("unroll") for (int e = 0; e < 8; ++e) if (e != e0 && d[e] > v1) { v1 = d[e]; e1 = e; } \
            if (lane == 0) { const float g0 = 1.f / (1.f + __builtin_amdgcn_exp2f((v1 - v0) * LOG2E)); \
                const int p0 = (int)__hip_atomic_fetch_add(lcnt + e0, 1u, __ATOMIC_RELAXED, __HIP_MEMORY_SCOPE_WORKGROUP); \
                const int p1 = (int)__hip_atomic_fetch_add(lcnt + e1, 1u, __ATOMIC_RELAXED, __HIP_MEMORY_SCOPE_WORKGROUP); \
                rec[wave * 16 + (k_)] = (v4i_t){e0 | (e1 << 8), p0, p1, __float_as_int(g0)}; } } while (0)
        { int k = 0;
          RowRaw<true> ca, cb, na, nb; row_raw_load<true>(h3row(ws, r0_), lane, ca); row_raw_load<true>(h3row(ws, r0_ + WPB), lane, cb);
          for (int it_ = 0, row = r0_; it_ < NIT_; ++it_, row += 2 * WPB, k += 2) { f32x4 va[4], vb[4]; const int rb = row + WPB, nrow = row + 2 * WPB; const bool more = it_ + 1 < NIT_;
            if (more) { row_raw_load<true>(h3row(ws, nrow), lane, na); row_raw_load<true>(h3row(ws, nrow + WPB), lane, nb); }
            rms_row2_f8<true>(ca, cb, A->in[I_LN_FFN_O], XS8 + (size_t)row * DM, XS8 + (size_t)rb * DM, lane, va, vb);
            ROUTE_ROW(va, k); ROUTE_ROW(vb, k + 1);
            if (more) { ca = na; cb = nb; } } }
#undef ROUTE_ROW
        __syncthreads();
        if (tid < 8) lbase[tid] = __hip_atomic_fetch_add(((unsigned*)(ws + WS_CTL)) + CW_CNT + 64 * tid, lcnt[tid], __ATOMIC_RELAXED, __HIP_MEMORY_SCOPE_AGENT);
        __syncthreads();
        if (lane < 16) { const int row = r0_ + lane * WPB; if (lane < 2 * NIT_) { const v4i_t rc = rec[wave * 16 + lane]; const int e0 = rc.x & 255, e1 = rc.x >> 8;
            const int s0_ = (int)lbase[e0] + rc.y, s1_ = (int)lbase[e1] + rc.z; int* EL = (int*)(ws + WS_ELIST);
            TOK[row] = make_int4(rc.x, s0_, s1_, rc.w); EL[e0 * 32768 + s0_] = row; EL[e1 * 32768 + s1_] = row; } }
        __syncthreads();
    }
    SEAM(13);
#define LOAD_TB() int tb[9]; { unsigned* cnt_ = (unsigned*)(ws + WS_CTL) + CW_CNT; tb[0] = 0; \
        _Pragma("unroll") for (int e_ = 0; e_ < 8; ++e_) { const int c_ = (int)__hip_atomic_load(cnt_ + 64 * e_, __ATOMIC_RELAXED, __HIP_MEMORY_SCOPE_AGENT); tb[e_ + 1] = tb[e_] + ((c_ + 255) >> 8); } }
    int clo, chi; { CArgs A = fresh_args(); clo = A->clo; chi = A->chi; }
#define TB_OF(e) ((e) == 0 ? tb[0] : (e) == 1 ? tb[1] : (e) == 2 ? tb[2] : (e) == 3 ? tb[3] : (e) == 4 ? tb[4] : (e) == 5 ? tb[5] : (e) == 6 ? tb[6] : tb[7])
    for (int c = clo; c < chi; ++c) {
#define CHUNK_RANGE() const int t0 = c * MOE_CT; int nt = tb[8] - t0; nt = nt < 0 ? 0 : ((c + 1 < MOE_NCHUNK && nt > MOE_CT) ? MOE_CT : (nt > MOE_CT_MAX ? MOE_CT_MAX : nt))
        if (IN(15)) { PH(); PH_TABLES(); LOAD_TB(); CHUNK_RANGE();
            int k8 = 512; asm volatile("" : "+s"(k8));
            pg8::Gemm g{(const bf16*)XS8, (const bf16*)(ws + WS_WMG), nt * 256, 2 * DFE, k8};
            pg8::MoeOrder S; S.so.init(nt * 256, 2 * DFE, G, (int)blockIdx.x); S.tb1 = tb[1]; S.tb2 = tb[2]; S.tb3 = tb[3]; S.tb4 = tb[4]; S.tb5 = tb[5]; S.tb6 = tb[6]; S.tb7 = tb[7]; S.t0 = t0; S.nper = 28; S.glist = (const int*)(ws + WS_ELIST);
            pg8::EpiSwiglu E{(bf16*)(ws + WS_ACTC), DFE, 28, 1.f / WMG_SCALE, 1, (unsigned char*)A->out, ACT_SPLIT};
            pg8::gemm_phase<pg8::EpiSwiglu, pg8::MoeOrder, true, true, true, false, true>(lds + RING_OFF, g, S, E);
            if (IN(16)) xcd_barrier(bar);
        }
        if (IN(16)) { PH(); PH_TABLES(); LOAD_TB(); CHUNK_RANGE();
            const int ntm = (t0 + nt > 256) ? 256 - t0 : nt, ntr = nt - ntm;
            { int kf = DFE / 2; asm volatile("" : "+s"(kf));
              pg8::Gemm g{(const bf16*)(ws + WS_ACTC), (const bf16*)(ws + WS_WMD), ntm * 256, 1024, kf, 0, (const bf16*)A->out, ACT_SPLIT};
              pg8::MoeOrder S; S.so.init(ntm * 256, 1024, G, (int)blockIdx.x); S.tb1 = tb[1]; S.tb2 = tb[2]; S.tb3 = tb[3]; S.tb4 = tb[4]; S.tb5 = tb[5]; S.tb6 = tb[6]; S.tb7 = tb[7]; S.t0 = t0; S.nper = 4;
              pg8::EpiPlain E{YB + (size_t)t0 * 256 * DM, 1024, 4, 1.f / WMG_SCALE};
              pg8::gemm_phase<pg8::EpiPlain, pg8::MoeOrder, true, true, true>(lds + RING_OFF, g, S, E); }
            if (ntr > 0 && (int)blockIdx.x < 36 * YP_SPLIT) { const int kh = (int)blockIdx.x / 36; int kq = DFE / (2 * YP_SPLIT); asm volatile("" : "+s"(kq));
              pg8::Gemm g{(const bf16*)((const unsigned char*)A->out + (size_t)(t0 + ntm - ACT_SPLIT) * 256 * DFE + (size_t)kh * (DFE / YP_SPLIT)), (const bf16*)(ws + WS_WMD + (size_t)kh * (DFE / YP_SPLIT)), ntr * 256, 1024, kq, DFE / 2};
              pg8::MoeOrder S; S.so.init(ntr * 256, 1024, 36, (int)blockIdx.x % 36); S.tb1 = tb[1]; S.tb2 = tb[2]; S.tb3 = tb[3]; S.tb4 = tb[4]; S.tb5 = tb[5]; S.tb6 = tb[6]; S.tb7 = tb[7]; S.t0 = t0 + ntm; S.nper = 4;
              pg8::EpiPlain E{(bf16*)(ws + WS_YP) + (size_t)kh * 7 * 256 * DM, 1024, 4, 1.f / WMG_SCALE};
              pg8::gemm_phase<pg8::EpiPlain, pg8::MoeOrder, true, true, true>(lds + RING_OFF, g, S, E); }
            if ((c + 1 < chi) ? IN(15) : IN(17)) xcd_barrier(bar);
        }
    }
    if (IN(17)) { PH(); PH_TABLES(); LOAD_TB();
#define FIN_ADDR(ti_, r0_, r1_, g0_) const int e0##r0_ = ti_.x & 255, e1##r0_ = ti_.x >> 8; const float g0_ = __int_as_float(ti_.w); \
        const size_t r0_ = (size_t)TB_OF(e0##r0_) * 256 + ti_.y, r1_ = (size_t)TB_OF(e1##r0_) * 256 + ti_.z
#define FIN_LOADS(row_, r0_, r1_, X, P, Q) GAS f32x4* xr##row_ = (GAS f32x4*)(A->out + (size_t)(row_) * DM) + lane; const GAS v2u* hx##row_ = (const GAS v2u*)h3row(ws, row_) + lane; v2u hw##row_[4]; \
        { const GAS v2u* y0_ = (const GAS v2u*)(YB + (r0_) * DM) + lane; const GAS v2u* y1_ = (const GAS v2u*)(YB + (r1_) * DM) + lane; \
          _Pragma("unroll") for (int j = 0; j < 4; ++j) { hw##row_[j] = hx##row_[64 * j]; P[j] = y0_[64 * j]; Q[j] = y1_[64 * j]; } \
          _Pragma("unroll") for (int j = 0; j < 4; ++j) { X[j].x = __uint_as_float(hw##row_[j].x << 16); X[j].y = __uint_as_float(hw##row_[j].x & 0xffff0000u); X[j].z = __uint_as_float(hw##row_[j].y << 16); X[j].w = __uint_as_float(hw##row_[j].y & 0xffff0000u); } }
#define FIN_SPLIT(r_, P) do { if ((r_) >= 65536) { const GAS v2u* z_ = (const GAS v2u*)((const bf16*)(ws + WS_YP) + ((r_) - 65536) * DM) + lane; \
          _Pragma("unroll") for (int j = 0; j < 4; ++j) { f32x4 t_ = {0.f, 0.f, 0.f, 0.f}; \
            _Pragma("unroll") for (int kh = 0; kh < YP_SPLIT; ++kh) { const v2u w_ = z_[(size_t)kh * 7 * 256 * (DM / 4) + 64 * j]; t_.x += bf2f(w_.x & 0xffffu); t_.y += __uint_as_float(w_.x & 0xffff0000u); t_.z += bf2f(w_.y & 0xffffu); t_.w += __uint_as_float(w_.y & 0xffff0000u); } \
            v2u o_; o_.x = pk2bf(t_.x, t_.y); o_.y = pk2bf(t_.z, t_.w); P[j] = o_; } } } while (0)
#define FIN_COMBINE(X, P, Q, g0_, S) do { const float g1_ = 1.f - (g0_); S = 0.f; \
          _Pragma("unroll") for (int j = 0; j < 4; ++j) { f32x4 x = X[j]; const v2u p = P[j], q = Q[j]; \
            x.x += (g0_) * bf2f(p.x & 0xffffu) + g1_ * bf2f(q.x & 0xffffu); x.y += (g0_) * __uint_as_float(p.x & 0xffff0000u) + g1_ * __uint_as_float(q.x & 0xffff0000u); \
            x.z += (g0_) * bf2f(p.y & 0xffffu) + g1_ * bf2f(q.y & 0xffffu); x.w += (g0_) * __uint_as_float(p.y & 0xffff0000u) + g1_ * __uint_as_float(q.y & 0xffff0000u); \
            X[j] = x; S += (x.x * x.x + x.y * x.y) + (x.z * x.z + x.w * x.w); } } while (0)
        for (int it_ = 0, row = r0_; it_ < NIT_; ++it_, row += 2 * WPB) { const int rowb = row + WPB; const int4 tia = TOK[row], tib = TOK[rowb];
            FIN_ADDR(tia, ra0, ra1, ga); FIN_ADDR(tib, rb0, rb1, gb);
            f32x4 xa[4], xb[4]; v2u pa[4], qa[4], pb[4], qb[4];
            FIN_LOADS(row, ra0, ra1, xa, pa, qa); FIN_LOADS(rowb, rb0, rb1, xb, pb, qb);
            FIN_SPLIT(ra0, pa); FIN_SPLIT(ra1, qa); FIN_SPLIT(rb0, pb); FIN_SPLIT(rb1, qb);
            float sa, sb; FIN_COMBINE(xa, pa, qa, ga, sa); FIN_COMBINE(xb, pb, qb, gb, sb);
#pragma unroll
            for (int o = 1; o < 64; o <<= 1) { sa += __shfl_xor(sa, o); sb += __shfl_xor(sb, o); }
            const float rsa = 1.f / sqrtf(sa * (1.f / 1024.f) + EPS), rsb = 1.f / sqrtf(sb * (1.f / 1024.f) + EPS);
#pragma unroll
            for (int j = 0; j < 4; ++j) { const f32x4 gg = *((const GAS f32x4*)A->in[I_LN_FINAL] + lane + 64 * j); xrrow[64 * j] = xa[j] * rsa * gg; xrrowb[64 * j] = xb[j] * rsb * gg; }
        }
#undef FIN_ADDR
#undef FIN_LOADS
#undef FIN_SPLIT
#undef FIN_COMBINE
    }
#undef IN
#undef SEAM
#undef TB_OF
#undef LOAD_TB
#undef CHUNK_RANGE
#undef TOK
#undef XS8
#undef YB
#undef PH
#undef PH_TABLES
}

#ifndef MK_PER_PHASE
#define MK_PER_PHASE 0
#endif
extern "C" void kernel_launch(void* const* d_in, const int* in_sizes, int n_in, void* d_out, int out_size, void* d_ws, size_t ws_size, hipStream_t stream) {
    static int grid = 0;
    if (grid == 0) {
        if (n_in != 28 || in_sizes[0] != NTOK * DM || out_size != NTOK * DM || ws_size < WS_END) { fprintf(stderr, "kernel_launch: unexpected shapes / workspace (n_in %d, ws %zu, need %zu); nothing launched\n", n_in, ws_size, (size_t)WS_END); grid = -1; return; }
        int dev = 0, cus = 0;
        if (hipGetDevice(&dev) != hipSuccess || hipDeviceGetAttribute(&cus, hipDeviceAttributeMultiprocessorCount, dev) != hipSuccess) { grid = -1; return; }
        if (hipFuncSetAttribute((const void*)hybrid_fwd, hipFuncAttributeMaxDynamicSharedMemorySize, LDS_BYTES) != hipSuccess) { fprintf(stderr, "kernel_launch: hipFuncSetAttribute failed\n"); grid = -1; return; }
        int per_cu = 0;
        if (hipOccupancyMaxActiveBlocksPerMultiprocessor(&per_cu, (const void*)hybrid_fwd, NWAVES * 64, LDS_BYTES) != hipSuccess || per_cu < 1) fprintf(stderr, "kernel_launch: occupancy query says %d\n", per_cu);
        (void)hipGetLastError();
        if (cus != 256) { fprintf(stderr, "kernel_launch: built for 256 CUs (unit dealing), found %d; nothing launched\n", cus); grid = -1; return; }
        grid = cus;
    }
    if (grid < 0) return;
    if (hipMemsetAsync((char*)d_ws + WS_CTL, 0, CTL_ZERO_BYTES, stream) != hipSuccess) return;
    Args ha{};
    for (int i = 0; i < 28; ++i) ha.in[i] = (const float*)d_in[i];
    ha.out = (float*)d_out; ha.ws = (unsigned char*)d_ws;
#if MK_PER_PHASE
    for (int p = 0; p < N_PHASES; ++p) {
        if (p == 15) { for (int c = 0; c < MOE_NCHUNK; ++c) { ha.lo = 15; ha.hi = 16; ha.clo = c; ha.chi = c + 1; hipLaunchKernelGGL(hybrid_fwd, dim3(grid), dim3(NWAVES * 64), LDS_BYTES, stream, ha);
                                                               ha.lo = 16; ha.hi = 17; hipLaunchKernelGGL(hybrid_fwd, dim3(grid), dim3(NWAVES * 64), LDS_BYTES, stream, ha); } ++p; continue; }
        ha.lo = p; ha.hi = p + 1; ha.clo = 0; ha.chi = 0;
        hipLaunchKernelGGL(hybrid_fwd, dim3(grid), dim3(NWAVES * 64), LDS_BYTES, stream, ha);
    }
#else
    ha.lo = 0; ha.hi = N_PHASES; ha.clo = 0; ha.chi = MOE_NCHUNK;
    hipLaunchKernelGGL(hybrid_fwd, dim3(grid), dim3(NWAVES * 64), LDS_BYTES, stream, ha);
#endif
}
```
